# Optimizing an MI355X kernel written in HIP

```python
import functools
import jax, jax.numpy as jnp
from jax import lax
import numpy as np

D_MODEL = 2048
BATCH = 16
SEQ = 2048
DEPTH = 1
DEC_BATCH = 32
DEC_SEQ = 4
PAST_LEN = 16384
PAGE_SIZE = 128

ATT_HEADS = 8
KV_HEADS = 2
HEAD_DIM = 128
GROUP = ATT_HEADS // KV_HEADS
ROT_DIM = HEAD_DIM // 4
ROPE_THETA = 500000.0
IDX_HEADS = 16
IDX_DIM = 64
IDX_ROT_DIM = IDX_DIM // 4
IDX_SCALE = (IDX_HEADS ** -0.5) * (IDX_DIM ** -0.5)
TOPK_MAX = 256
Q_BLOCK = 128
SSM_WIDTH = 512
SSM_GROUP = 16
SSM_GROUPS = SSM_WIDTH // SSM_GROUP
SSM_STATE = 64
D_FF = 5504
CONV_W = 3
PLE_DIM = 256
EPS = 1e-6

ATT_Q_W = ATT_HEADS * HEAD_DIM
ATT_KV_W = KV_HEADS * HEAD_DIM
IDX_Q_W = IDX_HEADS * IDX_DIM
IN_SIZES = (ATT_Q_W, ATT_KV_W, ATT_KV_W, IDX_Q_W, IDX_DIM, IDX_HEADS, SSM_WIDTH, D_MODEL, D_MODEL)
IN_SPLITS = tuple(int(s) for s in np.cumsum(IN_SIZES)[:-1])
IN_WIDTH = int(sum(IN_SIZES))

kernel_name = "dsa_s5_gated_hybrid_step"

F32 = jnp.float32


def rmsnorm(x, g):
    xf = x.astype(F32)
    y = xf * lax.rsqrt(jnp.mean(xf * xf, axis=-1, keepdims=True) + EPS)
    return (y * g.astype(F32)).astype(x.dtype)


def partial_rope(x, pos, rot_dim):
    half = rot_dim // 2
    inv_freq = ROPE_THETA ** (-jnp.arange(half, dtype=F32) / half)
    ang = pos.astype(F32)[:, None] * inv_freq[None, :]
    cos = jnp.cos(ang)[:, None, :]
    sin = jnp.sin(ang)[:, None, :]
    xr = x[..., :rot_dim].astype(F32)
    x1, x2 = xr[..., :half], xr[..., half:]
    rot = jnp.concatenate([x1 * cos - x2 * sin, x2 * cos + x1 * sin], axis=-1).astype(x.dtype)
    return jnp.concatenate([rot, x[..., rot_dim:]], axis=-1)


def indexer_scores(iq, iw, ik):
    qk = jnp.einsum('bthd,bsd->bths', iq, ik, preferred_element_type=F32)
    return jnp.einsum('bth,bths->bts', iw.astype(F32), jax.nn.relu(qk))


def sparse_attend(q, k_sel, v_sel, valid):
    B, T = q.shape[0], q.shape[1]
    qg = q.reshape(B, T, KV_HEADS, GROUP, HEAD_DIM)
    s = jnp.einsum('btgrd,btkgd->btgrk', qg, k_sel, preferred_element_type=F32) * (HEAD_DIM ** -0.5)
    s = jnp.where(valid[:, :, None, None, :], s, -jnp.inf)
    p = jax.nn.softmax(s, axis=-1)
    o = jnp.einsum('btgrk,btkgd->btgrd', p.astype(v_sel.dtype), v_sel)
    return o.reshape(B, T, ATT_Q_W)


def gather_rows(src, idx):
    return jax.vmap(lambda s, i: s[i])(src, idx)


def prompt_sparse_attention(q, k, v, iq, ik, iw):
    B, T = q.shape[0], q.shape[1]
    topk = min(TOPK_MAX, T // 4)
    n_blk = T // Q_BLOCK
    key_pos = jnp.arange(T)

    def block(i):
        t0 = i * Q_BLOCK
        qb = lax.dynamic_slice_in_dim(q, t0, Q_BLOCK, axis=1)
        iqb = lax.dynamic_slice_in_dim(iq, t0, Q_BLOCK, axis=1)
        iwb = lax.dynamic_slice_in_dim(iw, t0, Q_BLOCK, axis=1)
        qpos = t0 + jnp.arange(Q_BLOCK)
        sc = indexer_scores(iqb, iwb, ik)
        sc = jnp.where((key_pos[None, :] <= qpos[:, None])[None], sc, -jnp.inf)
        _, idx = lax.top_k(sc, topk)
        valid = idx <= qpos[None, :, None]
        return sparse_attend(qb, gather_rows(k, idx), gather_rows(v, idx), valid)

    out = lax.map(block, jnp.arange(n_blk))
    return jnp.transpose(out, (1, 0, 2, 3)).reshape(B, T, ATT_Q_W)


def sample_sparse_attention(q, k, v, iq, ik, iw, cache_k, cache_v, cache_ik, page_table):
    B, T = q.shape[0], q.shape[1]
    past = page_table.shape[1] * PAGE_SIZE
    L = past + T
    topk = min(TOPK_MAX, L // 4)
    ik_past = cache_ik[page_table].reshape(B, past, IDX_DIM)
    ik_all = jnp.concatenate([ik_past, ik.astype(ik_past.dtype)], axis=1)
    qpos = past + jnp.arange(T)
    key_pos = jnp.arange(L)
    sc = indexer_scores(iq, iw, ik_all)
    sc = jnp.where((key_pos[None, :] <= qpos[:, None])[None], sc, -jnp.inf)
    _, idx = lax.top_k(sc, topk)
    valid = idx <= qpos[None, :, None]
    in_past = idx < past
    pidx = jnp.minimum(idx, past - 1)
    phys = jnp.take_along_axis(page_table, (pidx // PAGE_SIZE).reshape(B, -1), axis=1).reshape(pidx.shape)
    rows = phys * PAGE_SIZE + pidx % PAGE_SIZE
    flat_k = cache_k.reshape(-1, KV_HEADS, HEAD_DIM)
    flat_v = cache_v.reshape(-1, KV_HEADS, HEAD_DIM)
    nidx = jnp.clip(idx - past, 0, T - 1)
    sel = in_past[..., None, None]
    k_sel = jnp.where(sel, flat_k[rows], gather_rows(k, nidx).astype(flat_k.dtype))
    v_sel = jnp.where(sel, flat_v[rows], gather_rows(v, nidx).astype(flat_v.dtype))
    return sparse_attend(q.astype(k_sel.dtype), k_sel, v_sel, valid).astype(q.dtype)


def complex_affine_combine(e1, e2):
    a1r, a1i, b1r, b1i = e1
    a2r, a2i, b2r, b2i = e2
    ar = a2r * a1r - a2i * a1i
    ai = a2r * a1i + a2i * a1r
    br = a2r * b1r - a2i * b1i + b2r
    bi = a2r * b1i + a2i * b1r + b2i
    return (ar, ai, br, bi)


def s5_branch(u, s0_re, s0_im, lw):
    B, T = u.shape[0], u.shape[1]
    ug = u.reshape(B, T, SSM_GROUPS, SSM_GROUP).astype(F32)
    a_re = lw['ssm_a_re'].astype(F32)
    a_im = lw['ssm_a_im'].astype(F32)
    dt = jnp.exp(lw['ssm_log_dt'].astype(F32))[:, None]
    mag = jnp.exp(a_re * dt)
    ang = a_im * dt
    ab_re, ab_im = mag * jnp.cos(ang), mag * jnp.sin(ang)
    den = a_re * a_re + a_im * a_im
    f_re = ((ab_re - 1.0) * a_re + ab_im * a_im) / den
    f_im = (ab_im * a_re - (ab_re - 1.0) * a_im) / den
    b_re = lw['ssm_b_re'].astype(F32)
    b_im = lw['ssm_b_im'].astype(F32)
    bb_re = f_re[..., None] * b_re - f_im[..., None] * b_im
    bb_im = f_re[..., None] * b_im + f_im[..., None] * b_re
    bu_re = jnp.einsum('btgc,gnc->btgn', ug, bb_re)
    bu_im = jnp.einsum('btgc,gnc->btgn', ug, bb_im)
    a_seq_re = jnp.broadcast_to(ab_re[None, None], (1, T, SSM_GROUPS, SSM_STATE))
    a_seq_im = jnp.broadcast_to(ab_im[None, None], (1, T, SSM_GROUPS, SSM_STATE))
    acum_re, acum_im, s_re, s_im = lax.associative_scan(
        complex_affine_combine, (a_seq_re, a_seq_im, bu_re, bu_im), axis=1)
    x0r = s0_re.astype(F32)[:, None]
    x0i = s0_im.astype(F32)[:, None]
    s_re = s_re + acum_re * x0r - acum_im * x0i
    s_im = s_im + acum_re * x0i + acum_im * x0r
    y = (jnp.einsum('btgn,gcn->btgc', s_re, lw['ssm_c_re'].astype(F32))
         - jnp.einsum('btgn,gcn->btgc', s_im, lw['ssm_c_im'].astype(F32))
         + ug * lw['ssm_d'].astype(F32).reshape(SSM_GROUPS, SSM_GROUP))
    y = y.reshape(B, T, SSM_WIDTH).astype(u.dtype)
    z = jax.nn.gelu(y, approximate=True)
    z = z * jax.nn.sigmoid(z @ lw['w_glu'])
    return z, s_re[:, -1], s_im[:, -1]


def conv_ffn(h, conv0, lw):
    T = h.shape[1]
    up = h @ lw['w_up']
    ext = jnp.concatenate([conv0.astype(up.dtype), up], axis=1)
    cw = lw['conv_w']
    c = sum(ext[:, j:j + T] * cw[j] for j in range(CONV_W)) + lw['conv_b']
    gate, val = jnp.split(c, 2, axis=-1)
    out = (jax.nn.gelu(gate, approximate=True) * val) @ lw['w_down']
    return out, ext[:, -(CONV_W - 1):]


def decoder_layer(x, p, pos, attend, s0_re, s0_im, conv0, lw):
    B, T, _ = x.shape
    h = rmsnorm(x, lw['g_mix'])
    proj = h @ lw['w_in']
    q, k, v, iq, ik, iw, u, ga, gs = jnp.split(proj, IN_SPLITS, axis=-1)
    q = partial_rope(rmsnorm(q.reshape(B, T, ATT_HEADS, HEAD_DIM), lw['g_q']), pos, ROT_DIM)
    k = partial_rope(rmsnorm(k.reshape(B, T, KV_HEADS, HEAD_DIM), lw['g_k']), pos, ROT_DIM)
    v = v.reshape(B, T, KV_HEADS, HEAD_DIM)
    iq = partial_rope(iq.reshape(B, T, IDX_HEADS, IDX_DIM), pos, IDX_ROT_DIM)
    ik = partial_rope(ik.reshape(B, T, 1, IDX_DIM), pos, IDX_ROT_DIM).reshape(B, T, IDX_DIM)
    iw = iw * IDX_SCALE
    o_att = attend(q, k, v, iq, ik, iw)
    z, s_re, s_im = s5_branch(u, s0_re, s0_im, lw)
    merged = (jax.nn.sigmoid(ga) * (o_att @ lw['w_att_br'])
              + jax.nn.sigmoid(gs) * (z @ lw['w_ssm_br']))
    x = x + merged @ lw['w_o']
    f, conv_new = conv_ffn(rmsnorm(x, lw['g_ffn']), conv0, lw)
    x = x + f
    ple = rmsnorm(p @ lw['w_ple'], lw['g_ple'])
    x = x + jax.nn.sigmoid(rmsnorm(x, lw['g_pg']) @ lw['w_pg']) * ple
    return x, k, v, ik, s_re, s_im, conv_new


def setup_inputs(seed: int = 0) -> dict:
    key = jax.random.key(seed)
    ks = iter(jax.random.split(key, 48))

    def nrm(shape, scale):
        return jax.random.normal(next(ks), shape, F32) * scale

    n_pages = PAST_LEN // PAGE_SIZE
    n_pool = (DEC_BATCH * n_pages * 5) // 4
    page_table = jax.random.permutation(next(ks), n_pool)[:DEC_BATCH * n_pages]
    page_table = page_table.reshape(DEC_BATCH, n_pages).astype(jnp.int32)
    log_dt = jax.random.uniform(next(ks), (DEPTH, SSM_GROUPS), F32, float(np.log(1e-3)), float(np.log(1e-1)))
    a_im = jnp.pi * jnp.arange(SSM_STATE, dtype=F32)[None, None, :] + nrm((DEPTH, SSM_GROUPS, SSM_STATE), 0.01)
    return {
        'x_prompt': nrm((BATCH, SEQ, D_MODEL), 1.0),
        'x_sample': nrm((DEC_BATCH, DEC_SEQ, D_MODEL), 1.0),
        'cache_k': nrm((DEPTH, n_pool, PAGE_SIZE, KV_HEADS, HEAD_DIM), 1.0),
        'cache_v': nrm((DEPTH, n_pool, PAGE_SIZE, KV_HEADS, HEAD_DIM), 1.0),
        'cache_idx_k': nrm((DEPTH, n_pool, PAGE_SIZE, IDX_DIM), 1.0),
        'state_ssm_re': nrm((DEPTH, DEC_BATCH, SSM_GROUPS, SSM_STATE), 0.1),
        'state_ssm_im': nrm((DEPTH, DEC_BATCH, SSM_GROUPS, SSM_STATE), 0.1),
        'state_conv': nrm((DEPTH, DEC_BATCH, CONV_W - 1, 2 * D_FF), 0.5),
        'page_table': page_table,
        'p_prompt': nrm((DEPTH, BATCH, SEQ, PLE_DIM), 1.0),
        'p_sample': nrm((DEPTH, DEC_BATCH, DEC_SEQ, PLE_DIM), 1.0),
        'g_mix': 1.0 + nrm((DEPTH, D_MODEL), 0.05),
        'w_in': nrm((DEPTH, D_MODEL, IN_WIDTH), D_MODEL ** -0.5),
        'g_q': 1.0 + nrm((DEPTH, HEAD_DIM), 0.05),
        'g_k': 1.0 + nrm((DEPTH, HEAD_DIM), 0.05),
        'ssm_a_re': -0.5 + nrm((DEPTH, SSM_GROUPS, SSM_STATE), 0.01),
        'ssm_a_im': a_im,
        'ssm_log_dt': log_dt,
        'ssm_b_re': nrm((DEPTH, SSM_GROUPS, SSM_STATE, SSM_GROUP), (2 * SSM_GROUP) ** -0.5),
        'ssm_b_im': nrm((DEPTH, SSM_GROUPS, SSM_STATE, SSM_GROUP), (2 * SSM_GROUP) ** -0.5),
        'ssm_c_re': nrm((DEPTH, SSM_GROUPS, SSM_GROUP, SSM_STATE), (2 * SSM_STATE) ** -0.5),
        'ssm_c_im': nrm((DEPTH, SSM_GROUPS, SSM_GROUP, SSM_STATE), (2 * SSM_STATE) ** -0.5),
        'ssm_d': nrm((DEPTH, SSM_WIDTH), 1.0),
        'w_glu': nrm((DEPTH, SSM_WIDTH, SSM_WIDTH), SSM_WIDTH ** -0.5),
        'w_att_br': nrm((DEPTH, ATT_Q_W, D_MODEL), ATT_Q_W ** -0.5),
        'w_ssm_br': nrm((DEPTH, SSM_WIDTH, D_MODEL), SSM_WIDTH ** -0.5),
        'w_o': nrm((DEPTH, D_MODEL, D_MODEL), D_MODEL ** -0.5),
        'g_ffn': 1.0 + nrm((DEPTH, D_MODEL), 0.05),
        'w_up': nrm((DEPTH, D_MODEL, 2 * D_FF), D_MODEL ** -0.5),
        'conv_w': nrm((DEPTH, CONV_W, 2 * D_FF), CONV_W ** -0.5),
        'conv_b': nrm((DEPTH, 2 * D_FF), 0.02),
        'w_down': nrm((DEPTH, D_FF, D_MODEL), D_FF ** -0.5),
        'w_ple': nrm((DEPTH, PLE_DIM, D_MODEL), PLE_DIM ** -0.5),
        'g_ple': 1.0 + nrm((DEPTH, D_MODEL), 0.05),
        'g_pg': 1.0 + nrm((DEPTH, D_MODEL), 0.05),
        'w_pg': nrm((DEPTH, D_MODEL, D_MODEL), D_MODEL ** -0.5),
    }


def reference(x_prompt, x_sample, cache_k, cache_v, cache_idx_k, state_ssm_re, state_ssm_im, state_conv,
              page_table, p_prompt, p_sample, g_mix, w_in, g_q, g_k, ssm_a_re, ssm_a_im, ssm_log_dt,
              ssm_b_re, ssm_b_im, ssm_c_re, ssm_c_im, ssm_d, w_glu, w_att_br, w_ssm_br, w_o, g_ffn,
              w_up, conv_w, conv_b, w_down, w_ple, g_ple, g_pg, w_pg):
    Bp, Tp = x_prompt.shape[0], x_prompt.shape[1]
    Ts = x_sample.shape[1]
    past = page_table.shape[1] * PAGE_SIZE
    pos_prompt = jnp.arange(Tp)
    pos_sample = past + jnp.arange(Ts)
    xp, xs = x_prompt, x_sample
    kp, vp, ikp, srp, sip, cvp = [], [], [], [], [], []
    ks_, vs_, iks, srs, sis, cvs = [], [], [], [], [], []
    for i in range(DEPTH):
        lw = dict(g_mix=g_mix[i], w_in=w_in[i], g_q=g_q[i], g_k=g_k[i],
                  ssm_a_re=ssm_a_re[i], ssm_a_im=ssm_a_im[i], ssm_log_dt=ssm_log_dt[i],
                  ssm_b_re=ssm_b_re[i], ssm_b_im=ssm_b_im[i], ssm_c_re=ssm_c_re[i], ssm_c_im=ssm_c_im[i],
                  ssm_d=ssm_d[i], w_glu=w_glu[i], w_att_br=w_att_br[i], w_ssm_br=w_ssm_br[i], w_o=w_o[i],
                  g_ffn=g_ffn[i], w_up=w_up[i], conv_w=conv_w[i], conv_b=conv_b[i], w_down=w_down[i],
                  w_ple=w_ple[i], g_ple=g_ple[i], g_pg=g_pg[i], w_pg=w_pg[i])
        zs = jnp.zeros((Bp, SSM_GROUPS, SSM_STATE), F32)
        zc = jnp.zeros((Bp, CONV_W - 1, 2 * D_FF), xp.dtype)
        xp, k1, v1, ik1, sr1, si1, cv1 = decoder_layer(
            xp, p_prompt[i], pos_prompt, prompt_sparse_attention, zs, zs, zc, lw)
        kp.append(k1); vp.append(v1); ikp.append(ik1); srp.append(sr1); sip.append(si1); cvp.append(cv1)
        attend_s = functools.partial(sample_sparse_attention, cache_k=cache_k[i], cache_v=cache_v[i],
                                     cache_ik=cache_idx_k[i], page_table=page_table)
        xs, k2, v2, ik2, sr2, si2, cv2 = decoder_layer(
            xs, p_sample[i], pos_sample, attend_s, state_ssm_re[i], state_ssm_im[i], state_conv[i], lw)
        ks_.append(k2); vs_.append(v2); iks.append(ik2); srs.append(sr2); sis.append(si2); cvs.append(cv2)
    return (xp, xs,
            jnp.stack(kp, 0), jnp.stack(vp, 0), jnp.stack(ikp, 0),
            jnp.stack(srp, 0), jnp.stack(sip, 0), jnp.stack(cvp, 0),
            jnp.stack(ks_, 0), jnp.stack(vs_, 0), jnp.stack(iks, 0),
            jnp.stack(srs, 0), jnp.stack(sis, 0), jnp.stack(cvs, 0))
```

```cpp
#include <hip/hip_runtime.h>
#include <cstdio>
#include <cstdint>

#define LAS __attribute__((address_space(3)))
#define GAS __attribute__((address_space(1)))
typedef unsigned short bf16_t;
typedef short bf16x8 __attribute__((ext_vector_type(8)));
typedef short bf16x4 __attribute__((ext_vector_type(4)));
typedef float f32x4 __attribute__((ext_vector_type(4)));
typedef float f32x2 __attribute__((ext_vector_type(2)));
typedef float f32x16 __attribute__((ext_vector_type(16)));
typedef unsigned u32x4 __attribute__((ext_vector_type(4)));
typedef unsigned u32x2 __attribute__((ext_vector_type(2)));
typedef unsigned long long u64;

constexpr int DM = 2048, NB = 16, SEQ = 2048, DB = 32, DT = 4, PAST = 16384, PAGE = 128, NPG = 128;
constexpr int TP = NB * SEQ, TS = DB * DT, MR = TP + TS, MP = 33024;
constexpr int NH = 8, NKV = 2, HD = 128, IH = 16, IDD = 64;
constexpr int SSMW = 512, SG = 32, SN = 64;
constexpr int DFF = 5504, DFF2 = 11008, PLE = 256;
constexpr int INW = 7248, INWP = 7424;
constexpr int C_Q = 0, C_K = 1024, C_V = 1280, C_IQ = 1536, C_IK = 2560, C_IW = 2624, C_U = 2640, C_GA = 3152, C_GS = 5200;
constexpr float EPS = 1e-6f, IDX_SCALE = 0.03125f;
constexpr int SSM_L = 32, SSM_NCH = SEQ / SSM_L;
constexpr int SLEN = PAST + DT, SSTR = 16400;

constexpr size_t O_Y = 0;
constexpr size_t O_KP = (size_t)MR * DM;
constexpr size_t O_VP = O_KP + (size_t)TP * 256;
constexpr size_t O_IKP = O_VP + (size_t)TP * 256;
constexpr size_t O_SRP = O_IKP + (size_t)TP * 64;
constexpr size_t O_SIP = O_SRP + (size_t)NB * SG * SN;
constexpr size_t O_CVP = O_SIP + (size_t)NB * SG * SN;
constexpr size_t O_KS = O_CVP + (size_t)NB * 2 * DFF2;
constexpr size_t O_VS = O_KS + (size_t)TS * 256;
constexpr size_t O_IKS = O_VS + (size_t)TS * 256;
constexpr size_t O_SRS = O_IKS + (size_t)TS * 64;
constexpr size_t O_SIS = O_SRS + (size_t)DB * SG * SN;
constexpr size_t O_CVS = O_SIS + (size_t)DB * SG * SN;
constexpr size_t O_END = O_CVS + (size_t)DB * 2 * DFF2;
static_assert(O_END == 87572480, "output size");

constexpr size_t MiB = 1u << 20;
constexpr size_t al(size_t x) { return (x + MiB - 1) & ~(MiB - 1); }
constexpr size_t WS_CTL = 0, CTL_ZERO_BYTES = MiB;
constexpr size_t WS_RT = WS_CTL + MiB;
constexpr size_t WS_SSC = WS_RT + MiB;
constexpr size_t WS_WIN = WS_SSC + MiB;
constexpr size_t WS_WGLU = WS_WIN + al((size_t)INWP * DM * 2);
constexpr size_t WS_WATT = WS_WGLU + al((size_t)512 * 512 * 2);
constexpr size_t WS_WSSM = WS_WATT + al((size_t)DM * 1024 * 2);
constexpr size_t WS_WO = WS_WSSM + al((size_t)DM * 512 * 2);
constexpr size_t WS_WUP = WS_WO + al((size_t)DM * DM * 2);
constexpr size_t WS_WDN = WS_WUP + al((size_t)DFF2 * DM * 2);
constexpr size_t WS_WPLE = WS_WDN + al((size_t)DM * DFF * 2);
constexpr size_t WS_WPG = WS_WPLE + al((size_t)DM * PLE * 2);
constexpr size_t WS_H = WS_WPG + al((size_t)DM * DM * 2);
constexpr size_t WS_PBF = WS_H + al((size_t)MP * DM * 2);
constexpr size_t WS_PLER = WS_PBF + al((size_t)MP * PLE * 2);
constexpr size_t WS_RSP = WS_PLER + al((size_t)MP * DM * 2);
constexpr size_t WS_A0 = WS_RSP + MiB;
constexpr size_t WS_PROJ = WS_A0;
constexpr size_t WS_QN = WS_PROJ + al((size_t)MP * INWP * 2);
constexpr size_t WS_KN = WS_QN + al((size_t)MP * 1024 * 2);
constexpr size_t WS_VB = WS_KN + al((size_t)MP * 256 * 2);
constexpr size_t WS_IQ = WS_VB + al((size_t)MP * 256 * 2);
constexpr size_t WS_IKR = WS_IQ + al((size_t)MP * 1024 * 2);
constexpr size_t WS_IW = WS_IKR + al((size_t)MP * 64 * 2);
constexpr size_t WS_SC = WS_IW + al((size_t)MP * 16 * 4);
constexpr size_t WS_SSC2 = WS_SC + al((size_t)NB * SEQ * SEQ * 4);
constexpr size_t WS_BM = WS_SSC2 + al((size_t)TS * SSTR * 4);
constexpr size_t WS_SIDX = WS_BM + al((size_t)TP * 32 * 8);
constexpr size_t WS_OATT = WS_SIDX + MiB;
constexpr size_t WS_Z = WS_OATT + al((size_t)MP * 1024 * 2);
constexpr size_t WS_Z2 = WS_Z + al((size_t)MP * 512 * 2);
constexpr size_t WS_SE = WS_Z2 + al((size_t)MP * 512 * 2);
constexpr size_t WS_SIN = WS_SE + al((size_t)NB * SSM_NCH * SG * SN * 8);
constexpr size_t WS_MRG = WS_SIN + al((size_t)NB * SSM_NCH * SG * SN * 8);
constexpr size_t WS_A_END = WS_MRG + al((size_t)MP * DM * 2);
constexpr size_t WS_UP = WS_A0;
constexpr size_t WS_ACT = WS_UP + al((size_t)MP * DFF2 * 2);
constexpr size_t WS_B_END = WS_ACT + al((size_t)MP * DFF * 2);
constexpr size_t WS_END = WS_A_END > WS_B_END ? WS_A_END : WS_B_END;
static_assert(WS_END < (size_t)2600 * MiB, "d_ws map too large");
constexpr size_t SSC_ABAR = 0, SSC_A32 = 16384, SSC_BBT = 32768, SSC_CMT = 32768 + 131072, SSC_END = SSC_CMT + 131072;
static_assert(SSC_END <= MiB, "ssc");
constexpr int CW_BAR = 4096;

constexpr int RING_BYTES = 131072;
constexpr int LDSCTL_OFF = RING_BYTES, MISC_OFF = LDSCTL_OFF + 320;
constexpr int LDS_BYTES = 147456;
constexpr int NWAVES = 8;

__device__ __forceinline__ unsigned cvt_pk_bf16(float lo, float hi) { unsigned r; asm volatile("v_cvt_pk_bf16_f32 %0, %1, %2" : "=v"(r) : "v"(lo), "v"(hi)); return r; }
__device__ __forceinline__ float bf_lo(unsigned w) { return __uint_as_float(w << 16); }
__device__ __forceinline__ float bf_hi(unsigned w) { return __uint_as_float(w & 0xffff0000u); }
__device__ __forceinline__ float bf2f(bf16_t x) { return __uint_as_float(((unsigned)x) << 16); }
__device__ __forceinline__ float sigmoidf_(float x) { return __builtin_amdgcn_rcpf(1.0f + __expf(-x)); }
__device__ __forceinline__ float gelu_tanh(float y) { const float t = 1.5957691216057308f * (y + 0.044715f * y * y * y); return y * __builtin_amdgcn_rcpf(1.0f + __expf(-t)); }
__device__ __forceinline__ float wave_sum(float v) {
#pragma unroll
    for (int o = 1; o < 64; o <<= 1) v += __shfl_xor(v, o);
    return v;
}
#define LDS_WAIT() asm volatile("s_waitcnt lgkmcnt(0)" ::: "memory")
#define VM_WAIT() asm volatile("s_waitcnt vmcnt(0)" ::: "memory")
namespace pg8 {
#define PG8_LAS __attribute__((address_space(3)))
constexpr int BM = 256, BK = 64, HALF = 128, HTB = HALF * BK * 2  , STAGE_BYTES = 8 * HTB, NXCD = 8, WGM = 8;

__host__ __device__ __forceinline__ int lds_byte(int r, int c) { const int st = (r >> 4) * 2 + (c >> 5), rr = r & 15, cc = c & 31, ob = rr * 64 + cc * 2; return st * 1024 + (ob ^ (((ob >> 9) & 1) << 5)); }
__host__ __device__ __forceinline__ void stage_rc(int b, int& R, int& C) { const int st = b / 1024, sb = b % 1024, swz = sb ^ (((sb >> 9) & 1) << 5); R = (st >> 1) * 16 + swz / 64; C = (st & 1) * 32 + (swz % 64) / 2; }
__host__ __device__ __forceinline__ int perm32(int rho) { const int n = rho >> 4, i = rho & 15; return 8 * (i >> 2) + 4 * n + (i & 3); }

struct Unit { int pm, pn; };
struct Gemm { const bf16_t* A; const bf16_t* Bt; int M, N, K, lda; };

struct StaticOrder {
    int nM, nN, nwg, G, c;
    __host__ __device__ void init(int M, int N, int G_, int c_) { nM = M / BM; nN = N / BM; nwg = nM * nN; G = G_; c = c_; }
    __host__ __device__ bool next(int i, Unit& u) const {
        const long L = (long)i * G + c; if (L >= nwg) return false;
        int wgid = (int)L; { const int q = nwg / NXCD, r = nwg % NXCD, xcd = wgid % NXCD, off = wgid / NXCD; wgid = (xcd < r ? xcd * (q + 1) : r * (q + 1) + (xcd - r) * q) + off; }
        const int nig = WGM * nN, gid = wgid / nig, fm = gid * WGM, gsz = (nM - fm) < WGM ? (nM - fm) : WGM;
        u.pm = fm + ((wgid % nig) % gsz); u.pn = (wgid % nig) / gsz; return true;
    }
    __device__ __forceinline__ void a_ready(const Unit&) const {}
    __device__ __forceinline__ void done(const Unit&) const {}
};
template <class Epi, class Sched, bool ALIGN_EPI = false, bool SP2 = false>
__device__ __forceinline__ void gemm_phase(PG8_LAS unsigned char* lds, const Gemm g, const Sched& S, const Epi& E) {
    const int tid = threadIdx.x, wid = __builtin_amdgcn_readfirstlane(tid >> 6), lane = tid & 63, wr = wid >> 2, wc = wid & 3, fr = lane & 15, fq = lane >> 4;
    const int K = g.K, nt = K / BK;
    unsigned voffA[2], voffB[2];
#pragma unroll
    for (int i = 0; i < 2; ++i) { int R, C; stage_rc(tid * 16 + i * 8192, R, C); const int Rb = Epi::PERM ? ((R & ~31) + perm32(R & 31)) : R;
        voffA[i] = (unsigned)(R * g.lda + C) * 2u; voffB[i] = (unsigned)(Rb * K + C) * 2u; }
    const size_t kstep = (size_t)(BK * 2);
    const size_t hstepB = (size_t)HALF * K * 2, hstepA = (size_t)HALF * g.lda * 2;
    const size_t tstepB = 2 * hstepB, tstepA = 2 * hstepA;
    const unsigned ldsw = (unsigned)wid * 1024u;
    const int aoff = lds_byte(wr * 64 + fr, fq * 8), boff = lds_byte(wc * 32 + fr, fq * 8);
#define PG8_SA(b, h) (((b) * 2 + (h)) * HTB)
#define PG8_SB(b, h) ((4 + (b) * 2 + (h)) * HTB)
#define PG8_STAGE(bufoff, gbase, voff) do { _Pragma("unroll") for (int _i = 0; _i < 2; ++_i) \
        __builtin_amdgcn_global_load_lds((const unsigned*)((const char*)(gbase) + (voff)[_i]), (PG8_LAS unsigned*)(lds + (bufoff) + ldsw + _i * 8192), 16, 0, 0); } while (0)
#define PG8_LDA(dst, b, h) do { _Pragma("unroll") for (int m = 0; m < 4; ++m) _Pragma("unroll") for (int k = 0; k < 2; ++k) dst[m][k] = *(const PG8_LAS bf16x8*)(lds + PG8_SA(b, h) + aoff + m * 2048 + k * 1024); } while (0)
#define PG8_LDB(dst, b, h) do { _Pragma("unroll") for (int n = 0; n < 2; ++n) _Pragma("unroll") for (int k = 0; k < 2; ++k) dst[n][k] = *(const PG8_LAS bf16x8*)(lds + PG8_SB(b, h) + boff + n * 2048 + k * 1024); } while (0)
#define PG8_MMA(ai, bj, At, Bt) do { __builtin_amdgcn_s_setprio(1); _Pragma("unroll") for (int m = 0; m < 4; ++m) _Pragma("unroll") for (int n = 0; n < 2; ++n) _Pragma("unroll") for (int k = 0; k < 2; ++k) \
        acc[ai][bj][m][n] = __builtin_amdgcn_mfma_f32_16x16x32_bf16(Bt[n][k], At[m][k], acc[ai][bj][m][n], 0, 0, 0); __builtin_amdgcn_s_setprio(0); } while (0)
#define PG8_WAIT_V(n) asm volatile("s_waitcnt vmcnt(" #n ")" ::: "memory")
#define PG8_WAIT_L(n) asm volatile("s_waitcnt lgkmcnt(" #n ")" ::: "memory")
#define PG8_BAR __builtin_amdgcn_s_barrier()
#define PG8_SCHED __builtin_amdgcn_sched_barrier(0)
    Unit cur, nxt; int ui = 0;
    if (!S.next(0, cur)) return;
    f32x4 acc[2][2][4][2];
#pragma unroll
    for (int a = 0; a < 2; ++a)
#pragma unroll
        for (int b = 0; b < 2; ++b)
#pragma unroll
            for (int m = 0; m < 4; ++m)
#pragma unroll
                for (int n = 0; n < 2; ++n) acc[a][b][m][n] = (f32x4){0.f, 0.f, 0.f, 0.f};
    bf16x8 At[4][2], B0[2][2], B1[2][2];
    const char* cA = (const char*)g.A + (size_t)cur.pm * tstepA; const char* cB = (const char*)g.Bt + (size_t)cur.pn * tstepB;
    S.a_ready(cur);
    if constexpr (SP2) {
        PG8_STAGE(PG8_SB(0, 0), cB, voffB); PG8_STAGE(PG8_SB(0, 1), cB + hstepB, voffB); PG8_STAGE(PG8_SA(0, 0), cA, voffA); PG8_STAGE(PG8_SA(0, 1), cA + hstepA, voffA);
        if (wr == 1) PG8_BAR;
        PG8_WAIT_V(2); PG8_BAR;
        PG8_STAGE(PG8_SB(1, 0), cB + kstep, voffB); PG8_STAGE(PG8_SA(1, 0), cA + kstep, voffA); PG8_STAGE(PG8_SB(1, 1), cB + hstepB + kstep, voffB);
        PG8_WAIT_V(6); PG8_BAR;
    } else {
        PG8_STAGE(PG8_SB(0, 0), cB, voffB); PG8_STAGE(PG8_SA(0, 0), cA, voffA); PG8_STAGE(PG8_SB(0, 1), cB + hstepB, voffB); PG8_STAGE(PG8_SA(0, 1), cA + hstepA, voffA);
        if (wr == 1) PG8_BAR;
        PG8_WAIT_V(4); PG8_BAR;
        PG8_STAGE(PG8_SB(1, 0), cB + kstep, voffB); PG8_STAGE(PG8_SA(1, 0), cA + kstep, voffA); PG8_STAGE(PG8_SB(1, 1), cB + hstepB + kstep, voffB);
        PG8_WAIT_V(6); PG8_BAR;
    }
    for (;;) {
        const bool has_next = S.next(ui + 1, nxt);
        const char* nA = has_next ? (const char*)g.A + (size_t)nxt.pm * tstepA : cA; const char* nB = has_next ? (const char*)g.Bt + (size_t)nxt.pn * tstepB : cB;
        for (int t = 0; t < nt; t += 2) {
            const bool last = (t == nt - 2);
            const char* a1 = cA + (size_t)(t + 1) * kstep;
            const char* a2 = last ? nA : cA + (size_t)(t + 2) * kstep; const char* b2 = last ? nB : cB + (size_t)(t + 2) * kstep;
            const char* a3 = a2 + kstep; const char* b3 = b2 + kstep;
            if (last && has_next) S.a_ready(nxt);
            if constexpr (SP2) {
            PG8_LDB(B0, 0, 0); PG8_LDB(B1, 0, 1); PG8_SCHED; PG8_LDA(At, 0, 0); PG8_STAGE(PG8_SA(1, 1), a1 + hstepA, voffA);
            PG8_WAIT_V(8); PG8_WAIT_L(0); PG8_BAR; PG8_MMA(0, 0, At, B0); PG8_MMA(0, 1, At, B1); PG8_BAR; PG8_SCHED;
            PG8_LDA(At, 0, 1); PG8_STAGE(PG8_SB(0, 0), b2, voffB); PG8_STAGE(PG8_SB(0, 1), b2 + hstepB, voffB); PG8_STAGE(PG8_SA(0, 0), a2, voffA);
            PG8_WAIT_V(8); PG8_WAIT_L(0); PG8_BAR; PG8_MMA(1, 0, At, B0); PG8_MMA(1, 1, At, B1); PG8_BAR; PG8_SCHED;
            PG8_LDB(B0, 1, 0); PG8_LDB(B1, 1, 1); PG8_SCHED; PG8_LDA(At, 1, 0); PG8_STAGE(PG8_SA(0, 1), a2 + hstepA, voffA);
            PG8_WAIT_V(8); PG8_WAIT_L(0); PG8_BAR; PG8_MMA(0, 0, At, B0); PG8_MMA(0, 1, At, B1); PG8_BAR; PG8_SCHED;
            PG8_LDA(At, 1, 1); PG8_STAGE(PG8_SB(1, 0), b3, voffB); PG8_STAGE(PG8_SB(1, 1), b3 + hstepB, voffB); PG8_STAGE(PG8_SA(1, 0), a3, voffA);
            PG8_WAIT_V(8); PG8_WAIT_L(0); PG8_BAR; PG8_MMA(1, 0, At, B0); PG8_MMA(1, 1, At, B1); PG8_BAR; PG8_SCHED;
            } else {
            PG8_LDB(B0, 0, 0); PG8_SCHED; PG8_LDA(At, 0, 0); PG8_STAGE(PG8_SA(1, 1), a1 + hstepA, voffA);
            PG8_WAIT_L(8); PG8_BAR; PG8_WAIT_L(0); PG8_MMA(0, 0, At, B0); PG8_BAR; PG8_SCHED;
            PG8_LDB(B1, 0, 1); PG8_STAGE(PG8_SB(0, 0), b2, voffB);
            PG8_BAR; PG8_WAIT_L(0); PG8_MMA(0, 1, At, B1); PG8_BAR;
            PG8_LDA(At, 0, 1); PG8_STAGE(PG8_SA(0, 0), a2, voffA);
            PG8_BAR; PG8_WAIT_L(0); PG8_MMA(1, 0, At, B0); PG8_BAR; PG8_SCHED;
            PG8_STAGE(PG8_SB(0, 1), b2 + hstepB, voffB);
            PG8_WAIT_V(6); PG8_BAR; PG8_MMA(1, 1, At, B1); PG8_BAR;
            PG8_LDB(B0, 1, 0); PG8_SCHED; PG8_LDA(At, 1, 0); PG8_STAGE(PG8_SA(0, 1), a2 + hstepA, voffA);
            PG8_WAIT_L(8); PG8_BAR; PG8_WAIT_L(0); PG8_MMA(0, 0, At, B0); PG8_BAR; PG8_SCHED;
            PG8_LDB(B1, 1, 1); PG8_STAGE(PG8_SB(1, 0), b3, voffB);
            PG8_BAR; PG8_WAIT_L(0); PG8_MMA(0, 1, At, B1); PG8_BAR;
            PG8_LDA(At, 1, 1); PG8_STAGE(PG8_SA(1, 0), a3, voffA);
            PG8_BAR; PG8_WAIT_L(0); PG8_MMA(1, 0, At, B0); PG8_BAR; PG8_SCHED;
            PG8_STAGE(PG8_SB(1, 1), b3 + hstepB, voffB);
            PG8_WAIT_V(6); PG8_BAR; PG8_MMA(1, 1, At, B1); PG8_BAR;
            }
        }
        if constexpr (ALIGN_EPI) { if (wr == 0) PG8_BAR; }
        if constexpr (!Epi::AFTER_DRAIN) { E(acc, cur, wr, wc, fr, fq); S.done(cur); }
        if (!has_next) break;
#pragma unroll
        for (int a = 0; a < 2; ++a)
#pragma unroll
            for (int b = 0; b < 2; ++b)
#pragma unroll
                for (int m = 0; m < 4; ++m)
#pragma unroll
                    for (int n = 0; n < 2; ++n) acc[a][b][m][n] = (f32x4){0.f, 0.f, 0.f, 0.f};
        cur = nxt; cA = nA; cB = nB; ++ui;
        if constexpr (ALIGN_EPI) { if (wr == 1) PG8_BAR; }
    }
    PG8_WAIT_V(0);
    if constexpr (!ALIGN_EPI) { if (wr == 0) PG8_BAR; }
    PG8_BAR;
    if constexpr (Epi::AFTER_DRAIN) { E.fused(acc, cur, wr, wc, fr, fq, lds, wid, lane); S.done(cur); }
#undef PG8_SA
#undef PG8_SB
#undef PG8_STAGE
#undef PG8_LDA
#undef PG8_LDB
#undef PG8_MMA
#undef PG8_WAIT_V
#undef PG8_WAIT_L
#undef PG8_BAR
#undef PG8_SCHED
}
}
#define EPI_ROWS_BEGIN  _Pragma("unroll") for (int ai = 0; ai < 2; ++ai) _Pragma("unroll") for (int m = 0; m < 4; ++m) { const int row = u.pm * 256 + ai * 128 + wr * 64 + m * 16 + fr;
#define EPI_ROWS_END    }
__device__ __forceinline__ u32x4 pack8(const f32x4 a, const f32x4 b) { u32x4 w; w.x = cvt_pk_bf16(a[0], a[1]); w.y = cvt_pk_bf16(a[2], a[3]); w.z = cvt_pk_bf16(b[0], b[1]); w.w = cvt_pk_bf16(b[2], b[3]); return w; }
__device__ __forceinline__ void unpack8(const u32x4 w, f32x4& a, f32x4& b) { a = (f32x4){bf_lo(w.x), bf_hi(w.x), bf_lo(w.y), bf_hi(w.y)}; b = (f32x4){bf_lo(w.z), bf_hi(w.z), bf_lo(w.w), bf_hi(w.w)}; }
__device__ __forceinline__ f32x4 sig4(const f32x4 x) { return (f32x4){sigmoidf_(x[0]), sigmoidf_(x[1]), sigmoidf_(x[2]), sigmoidf_(x[3])}; }

struct EpiStoreBf16 {
    static constexpr bool PERM = true, AFTER_DRAIN = false;
    bf16_t* O; int ldc;
    __device__ __forceinline__ void operator()(const f32x4 (&acc)[2][2][4][2], const pg8::Unit& u, int wr, int wc, int fr, int fq) const {
        const int col0 = u.pn * 256 + wc * 32 + 8 * fq;
        EPI_ROWS_BEGIN
            bf16_t* rowp = O + (size_t)row * ldc + col0;
#pragma unroll
            for (int bj = 0; bj < 2; ++bj) *(u32x4*)(rowp + bj * 128) = pack8(acc[ai][bj][m][0], acc[ai][bj][m][1]);
        EPI_ROWS_END
    }
};
struct EpiGlu {
    static constexpr bool PERM = true, AFTER_DRAIN = false;
    const bf16_t* Z; bf16_t* O; int ldc;
    __device__ __forceinline__ void operator()(const f32x4 (&acc)[2][2][4][2], const pg8::Unit& u, int wr, int wc, int fr, int fq) const {
        const int col0 = u.pn * 256 + wc * 32 + 8 * fq;
        EPI_ROWS_BEGIN
#pragma unroll
            for (int bj = 0; bj < 2; ++bj) { const size_t o = (size_t)row * ldc + col0 + bj * 128; f32x4 z0, z1; unpack8(*(const u32x4*)(Z + o), z0, z1);
                *(u32x4*)(O + o) = pack8(z0 * sig4(acc[ai][bj][m][0]), z1 * sig4(acc[ai][bj][m][1])); }
        EPI_ROWS_END
    }
};
template <bool ADD> struct EpiGate {
    static constexpr bool PERM = true, AFTER_DRAIN = false;
    const bf16_t* Gt; int ldg; bf16_t* O; int ldc;
    __device__ __forceinline__ void operator()(const f32x4 (&acc)[2][2][4][2], const pg8::Unit& u, int wr, int wc, int fr, int fq) const {
        const int col0 = u.pn * 256 + wc * 32 + 8 * fq;
        EPI_ROWS_BEGIN
#pragma unroll
            for (int bj = 0; bj < 2; ++bj) { f32x4 g0, g1; unpack8(*(const u32x4*)(Gt + (size_t)row * ldg + col0 + bj * 128), g0, g1);
                f32x4 r0 = sig4(g0) * acc[ai][bj][m][0], r1 = sig4(g1) * acc[ai][bj][m][1]; bf16_t* op = O + (size_t)row * ldc + col0 + bj * 128;
                if (ADD) { f32x4 o0, o1; unpack8(*(const u32x4*)op, o0, o1); r0 += o0; r1 += o1; }
                *(u32x4*)op = pack8(r0, r1); }
        EPI_ROWS_END
    }
};
struct EpiResid {
    static constexpr bool PERM = false, AFTER_DRAIN = false;
    const float* bp; const float* bs; float* out;
    __device__ __forceinline__ void operator()(const f32x4 (&acc)[2][2][4][2], const pg8::Unit& u, int wr, int wc, int fr, int fq) const {
        const int col0 = u.pn * 256 + wc * 32 + 4 * fq;
        EPI_ROWS_BEGIN
            if (row < MR) { const float* b = (row < TP ? bp + (size_t)row * DM : bs + (size_t)(row - TP) * DM) + col0; float* o = out + (size_t)row * DM + col0;
#pragma unroll
                for (int bj = 0; bj < 2; ++bj)
#pragma unroll
                    for (int n = 0; n < 2; ++n) *(f32x4*)(o + bj * 128 + n * 16) = *(const f32x4*)(b + bj * 128 + n * 16) + acc[ai][bj][m][n]; }
        EPI_ROWS_END
    }
};
struct EpiPg {
    static constexpr bool PERM = false, AFTER_DRAIN = false;
    float* out; const bf16_t* pr; const float* rsp; const float* gp;
    __device__ __forceinline__ void operator()(const f32x4 (&acc)[2][2][4][2], const pg8::Unit& u, int wr, int wc, int fr, int fq) const {
        const int col0 = u.pn * 256 + wc * 32 + 4 * fq;
        f32x4 gv[2][2];
#pragma unroll
        for (int bj = 0; bj < 2; ++bj)
#pragma unroll
            for (int n = 0; n < 2; ++n) gv[bj][n] = *(const f32x4*)(gp + col0 + bj * 128 + n * 16);
        EPI_ROWS_BEGIN
            if (row < MR) { const float rs = rsp[row]; float* o = out + (size_t)row * DM + col0; const bf16_t* p = pr + (size_t)row * DM + col0;
#pragma unroll
                for (int bj = 0; bj < 2; ++bj)
#pragma unroll
                    for (int n = 0; n < 2; ++n) { const u32x2 w = *(const u32x2*)(p + bj * 128 + n * 16); const f32x4 pv = (f32x4){bf_lo(w.x), bf_hi(w.x), bf_lo(w.y), bf_hi(w.y)};
                        *(f32x4*)(o + bj * 128 + n * 16) = *(const f32x4*)(o + bj * 128 + n * 16) + sig4(acc[ai][bj][m][n]) * pv * gv[bj][n] * rs; } }
        EPI_ROWS_END
    }
};
#define XB_TMO      128
#define XB_XCNT(j)  (256  + 64 * (j))
#define XB_XSUB(j)  (1280 + 64 * (j))
#define XB_XGEN(j)  (2304 + 64 * (j))
#define XB_TOP      3328
#define XB_TOPGEN   3392
#define XCD_BAR_WORDS 3456
#define XB_SPIN_CAP (1u << 18)

__device__ __forceinline__ unsigned xb_ld(unsigned* p)              { return __hip_atomic_load(p, __ATOMIC_RELAXED, __HIP_MEMORY_SCOPE_AGENT); }
__device__ __forceinline__ unsigned xb_add(unsigned* p, unsigned v) { return __hip_atomic_fetch_add(p, v, __ATOMIC_RELAXED, __HIP_MEMORY_SCOPE_AGENT); }
__device__ __forceinline__ unsigned xb_xcc_id() { return (unsigned)__builtin_amdgcn_s_getreg((3 << 11) | 20) & 0xFu; }
#define XB_SPIN(cond, bar) do { unsigned _sp = 0; while (cond) { __builtin_amdgcn_s_sleep(1); \
    if ((++_sp & 255u) == 0u) { if (xb_ld(&(bar)[XB_TMO])) break; if (_sp > XB_SPIN_CAP) { atomicAdd(&(bar)[XB_TMO], 1u); break; } } } } while (0)

struct XcdBarrier {
    unsigned* bar; unsigned x;
    volatile LAS unsigned* st;
};

__device__ __forceinline__ XcdBarrier xcd_barrier_post(unsigned* bar, volatile LAS unsigned* st) {
    XcdBarrier b; b.bar = bar; b.x = xb_xcc_id(); b.st = st;
    if (threadIdx.x == 0) (void)xb_add(&bar[XB_XCNT(b.x)], 1u);
    return b;
}
__device__ __forceinline__ void xcd_barrier_complete(unsigned* bar, unsigned x, unsigned& nloc, unsigned& nx) {
    const unsigned G = gridDim.x * gridDim.y * gridDim.z;
    unsigned sum, cnt, mine, sp = 0u;
    for (;;) {
        sum = 0u; cnt = 0u; mine = 0u;
#pragma unroll
        for (unsigned j = 0; j < 16; ++j) { const unsigned c = xb_ld(&bar[XB_XCNT(j)]); sum += c; cnt += (c > 0u) ? 1u : 0u; mine = (j == x) ? c : mine; }
        if (sum == G) break;
        __builtin_amdgcn_s_sleep(1);
        if ((++sp & 255u) == 0u) { if (xb_ld(&bar[XB_TMO])) break; if (sp > XB_SPIN_CAP) { atomicAdd(&bar[XB_TMO], 1u); break; } }
    }
    nloc = mine > 0u ? mine : 1u; nx = cnt > 0u ? cnt : 1u;
}

__device__ __forceinline__ void xcd_barrier(const XcdBarrier& b) {
    asm volatile("s_waitcnt vmcnt(0)" ::: "memory");
    __syncthreads();
    if (threadIdx.x == 0) {
        unsigned* bar = b.bar;
        __builtin_amdgcn_s_waitcnt(0);
        unsigned nloc = b.st[0], nx = b.st[1];
        if (nloc == 0u) { xcd_barrier_complete(bar, b.x, nloc, nx); b.st[0] = nloc; b.st[1] = nx; }
        const unsigned old = xb_add(&bar[XB_XSUB(b.x)], 1u);
        const unsigned gen = old / nloc;
        if (old + 1u == (gen + 1u) * nloc) {
            __builtin_amdgcn_fence(__ATOMIC_RELEASE, "agent");
            asm volatile("s_waitcnt vmcnt(0)" ::: "memory");
            const unsigned og = xb_add(&bar[XB_TOP], 1u);
            const unsigned tg = og / nx;
            if (og + 1u == (tg + 1u) * nx) xb_add(&bar[XB_TOPGEN], 1u);
            else XB_SPIN(xb_ld(&bar[XB_TOPGEN]) == tg, bar);
            __builtin_amdgcn_fence(__ATOMIC_ACQUIRE, "agent");
            xb_add(&bar[XB_XGEN(b.x)], 1u);
            asm volatile("s_waitcnt vmcnt(0)" ::: "memory");
        } else {
            XB_SPIN(xb_ld(&bar[XB_XGEN(b.x)]) == gen, bar);
            __builtin_amdgcn_fence(__ATOMIC_ACQUIRE, "agent");
            asm volatile("s_waitcnt vmcnt(0)" ::: "memory");
        }
    }
    __syncthreads();
}
__device__ __forceinline__ void cexp_d(double re, double im, int k, double& ore, double& oim) {
    const double sc = 1.0 / (double)(1ull << k); const double zr = re * sc, zi = im * sc;
    double tr = 1.0, ti = 0.0, sr = 1.0, si = 0.0;
#pragma unroll 1
    for (int n = 1; n <= 12; ++n) { const double inv = 1.0 / (double)n; const double nr = (tr * zr - ti * zi) * inv, ni = (tr * zi + ti * zr) * inv; tr = nr; ti = ni; sr += tr; si += ti; }
#pragma unroll 1
    for (int i = 0; i < k; ++i) { const double nr = sr * sr - si * si, ni = 2.0 * sr * si; sr = nr; si = ni; }
    ore = sr; oim = si;
}

__device__ __forceinline__ void transpose_item(const float* __restrict__ W, int K, int N, bf16_t* __restrict__ WT, int nblk, LAS float* scr, int item, int lane) {
    const int kb = item / nblk, nb = item % nblk, k0 = 64 * kb, n0 = 32 * nb;
    const int nn = n0 + (lane & 31); const bool ok = nn < N;
#pragma unroll 8
    for (int i = 0; i < 32; ++i) { const int kk = 2 * i + (lane >> 5); scr[kk * 33 + (lane & 31)] = ok ? W[(size_t)(k0 + kk) * N + nn] : 0.f; }
    LDS_WAIT(); asm volatile("" ::: "memory");
    const int c = lane & 7;
#pragma unroll
    for (int j = 0; j < 4; ++j) { const int n = (lane >> 3) + 8 * j; const LAS float* s = scr + (8 * c) * 33 + n;
        u32x4 o; o.x = cvt_pk_bf16(s[0 * 33], s[1 * 33]); o.y = cvt_pk_bf16(s[2 * 33], s[3 * 33]); o.z = cvt_pk_bf16(s[4 * 33], s[5 * 33]); o.w = cvt_pk_bf16(s[6 * 33], s[7 * 33]);
        *(u32x4*)(WT + (size_t)(n0 + n) * K + k0 + 8 * c) = o; }
    LDS_WAIT(); asm volatile("" ::: "memory");
}
__device__ __forceinline__ void rms_row_to_bf16(const float* __restrict__ xrow, const float* __restrict__ g, bf16_t* __restrict__ orow, int lane) {
    const f32x4* xr = (const f32x4*)xrow + lane; const f32x4* gr = (const f32x4*)g + lane;
    f32x4 v[8]; float s = 0.f;
#pragma unroll
    for (int j = 0; j < 8; ++j) { v[j] = xr[64 * j]; s += (v[j].x * v[j].x + v[j].y * v[j].y) + (v[j].z * v[j].z + v[j].w * v[j].w); }
    const float rstd = 1.0f / sqrtf(wave_sum(s) * (1.f / DM) + EPS);
    u32x2* o8 = (u32x2*)orow + lane;
#pragma unroll
    for (int j = 0; j < 8; ++j) { const f32x4 gg = gr[64 * j]; u32x2 w; w.x = cvt_pk_bf16(v[j].x * rstd * gg.x, v[j].y * rstd * gg.y); w.y = cvt_pk_bf16(v[j].z * rstd * gg.z, v[j].w * rstd * gg.w); o8[64 * j] = w; }
}
__device__ __forceinline__ void ld16bf(const bf16_t* p, float (&v)[16]) {
    const u32x4 a = *(const u32x4*)p, b = *(const u32x4*)(p + 8);
    v[0] = bf_lo(a.x); v[1] = bf_hi(a.x); v[2] = bf_lo(a.y); v[3] = bf_hi(a.y); v[4] = bf_lo(a.z); v[5] = bf_hi(a.z); v[6] = bf_lo(a.w); v[7] = bf_hi(a.w);
    v[8] = bf_lo(b.x); v[9] = bf_hi(b.x); v[10] = bf_lo(b.y); v[11] = bf_hi(b.y); v[12] = bf_lo(b.z); v[13] = bf_hi(b.z); v[14] = bf_lo(b.w); v[15] = bf_hi(b.w);
}
__device__ __forceinline__ void st16bf(bf16_t* p, const float (&v)[16]) {
    u32x4 a, b; a.x = cvt_pk_bf16(v[0], v[1]); a.y = cvt_pk_bf16(v[2], v[3]); a.z = cvt_pk_bf16(v[4], v[5]); a.w = cvt_pk_bf16(v[6], v[7]);
    b.x = cvt_pk_bf16(v[8], v[9]); b.y = cvt_pk_bf16(v[10], v[11]); b.z = cvt_pk_bf16(v[12], v[13]); b.w = cvt_pk_bf16(v[14], v[15]);
    *(u32x4*)p = a; *(u32x4*)(p + 8) = b;
}
__device__ __forceinline__ void st16f(float* p, const float (&v)[16]) {
#pragma unroll
    for (int j = 0; j < 4; ++j) *(f32x4*)(p + 4 * j) = (f32x4){v[4 * j], v[4 * j + 1], v[4 * j + 2], v[4 * j + 3]};
}
__device__ __forceinline__ void norm_rope128(float (&v)[16], int sub, const float* __restrict__ g, const float* __restrict__ rt) {
    float ss = 0.f;
#pragma unroll
    for (int e = 0; e < 16; ++e) ss += v[e] * v[e];
    ss += __shfl_xor(ss, 1); ss += __shfl_xor(ss, 2); ss += __shfl_xor(ss, 4);
    const float rstd = 1.0f / sqrtf(ss * (1.f / 128.f) + EPS);
#pragma unroll
    for (int e = 0; e < 16; ++e) v[e] = v[e] * rstd * g[sub * 16 + e];
#pragma unroll
    for (int e = 0; e < 16; ++e) { const float o = __shfl_xor(v[e], 1); const float c = rt[e], s = rt[16 + e];
        const float r0 = v[e] * c - o * s, r1 = v[e] * c + o * s;
        v[e] = sub == 0 ? r0 : (sub == 1 ? r1 : v[e]); }
}
__device__ __forceinline__ void rope64(float (&v)[16], const float* __restrict__ rt) {
#pragma unroll
    for (int i = 0; i < 8; ++i) { const float c = rt[32 + i], s = rt[40 + i]; const float x1 = v[i], x2 = v[8 + i]; v[i] = x1 * c - x2 * s; v[8 + i] = x2 * c + x1 * s; }
}
__device__ __forceinline__ void ta_row(int row, int lane, const bf16_t* __restrict__ proj, const float* __restrict__ RT, const float* __restrict__ gq, const float* __restrict__ gk,
                                       bf16_t* __restrict__ qn, bf16_t* __restrict__ kn, bf16_t* __restrict__ vb, bf16_t* __restrict__ iqr, bf16_t* __restrict__ ikr, float* __restrict__ iws, float* __restrict__ out) {
    const bf16_t* pr = proj + (size_t)row * INWP;
    const int pi = row < TP ? (row & (SEQ - 1)) : SEQ + ((row - TP) & 3);
    const float* rt = RT + pi * 48;
    const bool isp = row < TP; const int rs = isp ? row : row - TP;
    float v[16];
    ld16bf(pr + C_Q + 16 * lane, v); norm_rope128(v, lane & 7, gq, rt); st16bf(qn + (size_t)row * 1024 + 16 * lane, v);
    { const int l = lane & 15; ld16bf(pr + C_K + 16 * l, v); norm_rope128(v, l & 7, gk, rt);
      if (lane < 16) { st16bf(kn + (size_t)row * 256 + 16 * l, v); st16f(out + (isp ? O_KP : O_KS) + (size_t)rs * 256 + 16 * l, v); } }
    if (lane < 16) { ld16bf(pr + C_V + 16 * lane, v); *(u32x4*)(vb + (size_t)row * 256 + 16 * lane) = *(const u32x4*)(pr + C_V + 16 * lane); *(u32x4*)(vb + (size_t)row * 256 + 16 * lane + 8) = *(const u32x4*)(pr + C_V + 16 * lane + 8);
      st16f(out + (isp ? O_VP : O_VS) + (size_t)rs * 256 + 16 * lane, v); }
    ld16bf(pr + C_IQ + 16 * lane, v); if ((lane & 3) == 0) rope64(v, rt); st16bf(iqr + (size_t)row * 1024 + 16 * lane, v);
    if (lane < 4) { ld16bf(pr + C_IK + 16 * lane, v); if (lane == 0) rope64(v, rt); st16bf(ikr + (size_t)row * 64 + 16 * lane, v); st16f(out + (isp ? O_IKP : O_IKS) + (size_t)rs * 64 + 16 * lane, v); }
    if (lane < 16) iws[(size_t)row * 16 + lane] = bf2f(pr[C_IW + lane]) * IDX_SCALE;
}
__device__ __forceinline__ bf16x8 as_bf16x8(const u32x4 w) { return __builtin_bit_cast(bf16x8, w); }
__device__ __forceinline__ void idx_load_a(const bf16_t* __restrict__ iqr, size_t row0, int lane, bf16x8 (&a)[4]) {
    const int rho = lane & 31, h = lane >> 5; const int tok = (rho >> 2) & 1, head = (rho & 3) + 4 * (rho >> 3);
    const bf16_t* p = iqr + (row0 + tok) * 1024 + head * 64 + 8 * h;
#pragma unroll
    for (int kk = 0; kk < 4; ++kk) a[kk] = *(const bf16x8*)(p + 16 * kk);
}
__device__ __forceinline__ float idx_reduce(const f32x16& acc, const f32x4 (&wv)[4]) {
    float s = 0.f;
#pragma unroll
    for (int r = 0; r < 16; ++r) s += wv[r >> 2][r & 3] * fmaxf(acc[r], 0.f);
    return s;
}
__device__ __forceinline__ void idx_prompt_block(int b, int qb, int wave, int lane, const bf16_t* __restrict__ iqr, const bf16_t* __restrict__ ikr, const float* __restrict__ iws, float* __restrict__ sc) {
    const int h = lane >> 5, kl = lane & 31;
    bf16x8 a[4][4]; f32x4 wv[4][4]; size_t rowi[4];
#pragma unroll
    for (int i = 0; i < 4; ++i) { const size_t row0 = (size_t)b * SEQ + 64 * qb + 2 * (4 * wave + i); rowi[i] = row0 + h; idx_load_a(iqr, row0, lane, a[i]);
#pragma unroll
        for (int j = 0; j < 4; ++j) wv[i][j] = *(const f32x4*)(iws + (row0 + h) * 16 + 4 * j); }
    const int ntile = 2 * qb + 2;
    const bf16_t* kp = ikr + ((size_t)b * SEQ + kl) * 64 + 8 * h;
    bf16x8 bc[4], bn[4];
#pragma unroll
    for (int kk = 0; kk < 4; ++kk) bc[kk] = *(const bf16x8*)(kp + 16 * kk);
    for (int kt = 0; kt < ntile; ++kt) {
        if (kt + 1 < ntile) {
#pragma unroll
            for (int kk = 0; kk < 4; ++kk) bn[kk] = *(const bf16x8*)(kp + (size_t)(kt + 1) * 32 * 64 + 16 * kk); }
#pragma unroll
        for (int i = 0; i < 4; ++i) { f32x16 acc = {};
#pragma unroll
            for (int kk = 0; kk < 4; ++kk) acc = __builtin_amdgcn_mfma_f32_32x32x16_bf16(a[i][kk], bc[kk], acc, 0, 0, 0);
            sc[rowi[i] * SEQ + 32 * kt + kl] = idx_reduce(acc, wv[i]); }
#pragma unroll
        for (int kk = 0; kk < 4; ++kk) bc[kk] = bn[kk];
    }
}
__device__ __forceinline__ void idx_sample_unit(int b, int c, int wave, int lane, const bf16_t* __restrict__ iqr, const bf16_t* __restrict__ ikr, const float* __restrict__ iws,
                                                const float* __restrict__ cik, const int* __restrict__ pt, float* __restrict__ ssc) {
    const int h = lane >> 5, kl = lane & 31;
    bf16x8 a[2][4]; f32x4 wv[2][4];
#pragma unroll
    for (int i = 0; i < 2; ++i) { const size_t row0 = (size_t)TP + 4 * b + 2 * i; idx_load_a(iqr, row0, lane, a[i]);
#pragma unroll
        for (int j = 0; j < 4; ++j) wv[i][j] = *(const f32x4*)(iws + (row0 + h) * 16 + 4 * j); }
    const int pgl = 8 * c + wave; const int page = pt[b * NPG + pgl];
#pragma unroll 1
    for (int kt = 0; kt < 4; ++kt) {
        const float* p = cik + ((size_t)page * PAGE + 32 * kt + kl) * 64 + 8 * h; bf16x8 bc[4];
#pragma unroll
        for (int kk = 0; kk < 4; ++kk) { const f32x4 x0 = *(const f32x4*)(p + 16 * kk), x1 = *(const f32x4*)(p + 16 * kk + 4); bc[kk] = as_bf16x8(pack8(x0, x1)); }
#pragma unroll
        for (int i = 0; i < 2; ++i) { f32x16 acc = {};
#pragma unroll
            for (int kk = 0; kk < 4; ++kk) acc = __builtin_amdgcn_mfma_f32_32x32x16_bf16(a[i][kk], bc[kk], acc, 0, 0, 0);
            ssc[(size_t)(b * 4 + 2 * i + h) * SSTR + pgl * PAGE + 32 * kt + kl] = idx_reduce(acc, wv[i]); }
    }
    if (c == 15 && wave == 0) {
        const bf16_t* p = ikr + ((size_t)TP + 4 * b + (kl & 3)) * 64 + 8 * h; bf16x8 bc[4];
#pragma unroll
        for (int kk = 0; kk < 4; ++kk) bc[kk] = *(const bf16x8*)(p + 16 * kk);
#pragma unroll
        for (int i = 0; i < 2; ++i) { f32x16 acc = {};
#pragma unroll
            for (int kk = 0; kk < 4; ++kk) acc = __builtin_amdgcn_mfma_f32_32x32x16_bf16(a[i][kk], bc[kk], acc, 0, 0, 0);
            const float s = idx_reduce(acc, wv[i]); if (kl < 4) ssc[(size_t)(b * 4 + 2 * i + h) * SSTR + PAST + kl] = s; }
    }
}
__device__ __forceinline__ unsigned fkey(float v) { const unsigned u = __float_as_uint(v); return (u >> 31) ? ~u : (u | 0x80000000u); }
__device__ __forceinline__ void select_prompt_row(int row, int lane, const float* __restrict__ sc, u64* __restrict__ bm) {
    const int t = row & (SEQ - 1);
    u64 myword = 0ull;
    if (t < 256) {
        const int n = t + 1 - 64 * lane; myword = n >= 64 ? ~0ull : (n > 0 ? ((1ull << n) - 1ull) : 0ull);
    } else {
        unsigned key[32]; const int nreg = (t >> 6) + 1; const float* sr = sc + (size_t)row * SEQ;
#pragma unroll
        for (int j = 0; j < 32; ++j) { key[j] = 0u; if (j < nreg) { const int s = 64 * j + lane; if (s <= t) key[j] = fkey(sr[s]); } }
        unsigned T = 0u;
#pragma unroll 1
        for (int bit = 31; bit >= 0; --bit) {
            const unsigned cand = T | (1u << bit); int cnt = 0;
#pragma unroll
            for (int gq = 0; gq < 4; ++gq) if (8 * gq < nreg) {
#pragma unroll
                for (int j = 8 * gq; j < 8 * gq + 8; ++j) cnt += __popcll(__ballot(key[j] >= cand)); }
            if (cnt >= 256) { T = cand; if (cnt == 256) break; }
        }
#pragma unroll
        for (int j = 0; j < 32; ++j) { const u64 w = __ballot(key[j] >= T); if (lane == j) myword = w; }
    }
    if (lane < 32) bm[(size_t)row * 32 + lane] = myword;
}
__device__ __forceinline__ void select_sample_row(int r, int tid, int lane, int wave, const float* __restrict__ ssc, int* __restrict__ sidx, LAS unsigned* red) {
    const int L = PAST + 1 + (r & 3);
    unsigned key[33]; const float* sr = ssc + (size_t)r * SSTR;
#pragma unroll
    for (int j = 0; j < 33; ++j) { const int s = j * 512 + tid; key[j] = s < L ? fkey(sr[s]) : 0u; }
    unsigned T = 0u;
#pragma unroll 1
    for (int bit = 31; bit >= 0; --bit) {
        const unsigned cand = T | (1u << bit); int c = 0;
#pragma unroll
        for (int j = 0; j < 33; ++j) c += (key[j] >= cand) ? 1 : 0;
#pragma unroll
        for (int o = 1; o < 64; o <<= 1) c += __shfl_xor(c, o);
        LAS unsigned* buf = red + (bit & 1) * 8;
        if (lane == 0) buf[wave] = (unsigned)c;
        __syncthreads();
        int tot = 0;
#pragma unroll
        for (int w = 0; w < 8; ++w) tot += (int)buf[w];
        if (tot >= 256) { T = cand; if (tot == 256) break; }
    }
    int c = 0;
#pragma unroll
    for (int j = 0; j < 33; ++j) c += (key[j] >= T) ? 1 : 0;
    int incl = c;
#pragma unroll
    for (int o = 1; o < 64; o <<= 1) { const int v = __shfl_up(incl, o); if (lane >= o) incl += v; }
    __syncthreads();
    if (lane == 63) red[16 + wave] = (unsigned)incl;
    __syncthreads();
    int base = incl - c;
#pragma unroll
    for (int w = 0; w < 8; ++w) if (w < wave) base += (int)red[16 + w];
    int* so = sidx + r * 256;
#pragma unroll
    for (int j = 0; j < 33; ++j) if (key[j] >= T) { if (base < 256) so[base] = j * 512 + tid; ++base; }
    __syncthreads();
}
struct SsmConst { const float* abar; const float* a32; const bf16_t* bbt; const bf16_t* cmt; };
template <int MODE>
__device__ __forceinline__ void ssm_task(int set, int g, int chunk, int lane, const SsmConst sc, const bf16_t* __restrict__ proj, const float* __restrict__ dvec,
                                         f32x2* __restrict__ SE, const f32x2* __restrict__ SIN, const float* __restrict__ s0re, const float* __restrict__ s0im,
                                         bf16_t* __restrict__ zb, float* __restrict__ ore, float* __restrict__ oim) {
    const int bq = lane & 15, q = lane >> 4; const int b = set * 16 + bq;
    bf16x4 bbt[8];
#pragma unroll
    for (int j = 0; j < 8; ++j) bbt[j] = *(const bf16x4*)(sc.bbt + ((size_t)(g * 128 + 16 * j + bq)) * 16 + 4 * q);
    float ar[16], ai[16], sr[16], si[16];
#pragma unroll
    for (int m = 0; m < 16; ++m) { const f32x2 a = *(const f32x2*)(sc.abar + ((size_t)(g * 64 + 16 * q + m)) * 2); ar[m] = a.x; ai[m] = a.y; sr[m] = 0.f; si[m] = 0.f; }
    bf16x8 cmt[4]; f32x4 dv = {0.f, 0.f, 0.f, 0.f};
    if (MODE != 0) {
#pragma unroll
        for (int j = 0; j < 4; ++j) cmt[j] = *(const bf16x8*)(sc.cmt + ((size_t)(g * 16 + bq)) * 128 + 32 * j + 8 * q);
        dv = *(const f32x4*)(dvec + 16 * g + 4 * q);
    }
    size_t row0; int nstep;
    if (MODE == 2) { row0 = (size_t)TP + 4 * b; nstep = DT;
#pragma unroll
        for (int m = 0; m < 16; ++m) { sr[m] = s0re[((size_t)b * SG + g) * SN + 16 * q + m]; si[m] = s0im[((size_t)b * SG + g) * SN + 16 * q + m]; } }
    else { row0 = (size_t)b * SEQ + (size_t)chunk * SSM_L; nstep = SSM_L;
        if (MODE == 1) {
#pragma unroll
            for (int m = 0; m < 16; ++m) { const f32x2 s = SIN[(((size_t)b * SSM_NCH + chunk) * SG + g) * SN + 16 * q + m]; sr[m] = s.x; si[m] = s.y; } } }
    const bf16_t* up = proj + row0 * INWP + C_U + 16 * g + 4 * q;
    bf16x4 ucur = *(const bf16x4*)up;
#pragma unroll 1
    for (int t = 0; t < nstep; ++t) {
        bf16x4 unxt = ucur; if (t + 1 < nstep) unxt = *(const bf16x4*)(up + (size_t)(t + 1) * INWP);
        f32x4 bu[8];
#pragma unroll
        for (int j = 0; j < 8; ++j) bu[j] = __builtin_amdgcn_mfma_f32_16x16x16bf16_1k(bbt[j], ucur, (f32x4){0.f, 0.f, 0.f, 0.f}, 0, 0, 0);
#pragma unroll
        for (int jh = 0; jh < 4; ++jh)
#pragma unroll
            for (int i = 0; i < 4; ++i) { const int m = 4 * jh + i; const float nr = ar[m] * sr[m] - ai[m] * si[m] + bu[2 * jh][i], ni = ar[m] * si[m] + ai[m] * sr[m] + bu[2 * jh + 1][i]; sr[m] = nr; si[m] = ni; }
        if (MODE != 0) {
            f32x4 y = {0.f, 0.f, 0.f, 0.f};
#pragma unroll
            for (int j = 0; j < 4; ++j) { u32x4 w; w.x = cvt_pk_bf16(sr[4 * j], sr[4 * j + 1]); w.y = cvt_pk_bf16(sr[4 * j + 2], sr[4 * j + 3]); w.z = cvt_pk_bf16(si[4 * j], si[4 * j + 1]); w.w = cvt_pk_bf16(si[4 * j + 2], si[4 * j + 3]);
                y = __builtin_amdgcn_mfma_f32_16x16x32_bf16(cmt[j], as_bf16x8(w), y, 0, 0, 0); }
            const u32x2 uw = __builtin_bit_cast(u32x2, ucur);
            const f32x4 uf = (f32x4){bf_lo(uw.x), bf_hi(uw.x), bf_lo(uw.y), bf_hi(uw.y)};
            y += dv * uf;
            u32x2 zo; zo.x = cvt_pk_bf16(gelu_tanh(y[0]), gelu_tanh(y[1])); zo.y = cvt_pk_bf16(gelu_tanh(y[2]), gelu_tanh(y[3]));
            *(u32x2*)(zb + (row0 + t) * SSMW + 16 * g + 4 * q) = zo;
        }
        ucur = unxt;
    }
    if (MODE == 0) {
        f32x2* e = SE + (((size_t)b * SSM_NCH + chunk) * SG + g) * SN + 16 * q;
#pragma unroll
        for (int m = 0; m < 16; ++m) e[m] = (f32x2){sr[m], si[m]};
    }
    if (MODE == 2) {
#pragma unroll
        for (int m = 0; m < 16; ++m) { ore[((size_t)b * SG + g) * SN + 16 * q + m] = sr[m]; oim[((size_t)b * SG + g) * SN + 16 * q + m] = si[m]; }
    }
}
__device__ __forceinline__ void ssm_carry(int idx  , const float* __restrict__ a32, const f32x2* __restrict__ SE, f32x2* __restrict__ SIN, float* __restrict__ ore, float* __restrict__ oim) {
    const int b = idx >> 11, gn = idx & 2047;
    const f32x2 a = *(const f32x2*)(a32 + (size_t)gn * 2);
    float sr = 0.f, si = 0.f;
#pragma unroll 4
    for (int j = 0; j < SSM_NCH; ++j) { const size_t o = ((size_t)b * SSM_NCH + j) * (SG * SN) + gn; SIN[o] = (f32x2){sr, si}; const f32x2 e = SE[o];
        const float nr = a.x * sr - a.y * si + e.x, ni = a.x * si + a.y * sr + e.y; sr = nr; si = ni; }
    ore[(size_t)b * (SG * SN) + gn] = sr; oim[(size_t)b * (SG * SN) + gn] = si;
}
__device__ __forceinline__ void ssm_constants(int gn, const float* __restrict__ a_re, const float* __restrict__ a_im, const float* __restrict__ log_dt, const float* __restrict__ b_re, const float* __restrict__ b_im,
                                              const float* __restrict__ c_re, const float* __restrict__ c_im, unsigned char* __restrict__ ssc) {
    const int g = gn >> 6, n = gn & 63;
    double dt, dum; cexp_d((double)log_dt[g], 0.0, 10, dt, dum);
    const double lr = (double)a_re[gn], li = (double)a_im[gn];
    double abr, abi; cexp_d(lr * dt, li * dt, 10, abr, abi);
    double p32r = abr, p32i = abi;
#pragma unroll 1
    for (int i = 0; i < 5; ++i) { const double nr = p32r * p32r - p32i * p32i, ni = 2.0 * p32r * p32i; p32r = nr; p32i = ni; }
    const double den = lr * lr + li * li;
    const double fr = ((abr - 1.0) * lr + abi * li) / den, fi = (abi * lr - (abr - 1.0) * li) / den;
    float* ab = (float*)(ssc + SSC_ABAR) + (size_t)gn * 2; ab[0] = (float)abr; ab[1] = (float)abi;
    float* a3 = (float*)(ssc + SSC_A32) + (size_t)gn * 2; a3[0] = (float)p32r; a3[1] = (float)p32i;
    bf16_t* bbt = (bf16_t*)(ssc + SSC_BBT); bf16_t* cmt = (bf16_t*)(ssc + SSC_CMT);
    const int qq = n >> 4, jh = (n >> 2) & 3, i = n & 3;
#pragma unroll
    for (int ri = 0; ri < 2; ++ri) {
        const int rowl = 16 * (2 * jh + ri) + 4 * qq + i;
        const int kap = 32 * jh + 8 * qq + 4 * ri + i;
#pragma unroll 1
        for (int c = 0; c < 16; ++c) {
            const double br = (double)b_re[(size_t)gn * 16 + c], bi = (double)b_im[(size_t)gn * 16 + c];
            const double v = ri == 0 ? (fr * br - fi * bi) : (fr * bi + fi * br);
            bbt[((size_t)g * 128 + rowl) * 16 + c] = (bf16_t)(cvt_pk_bf16((float)v, 0.f) & 0xffffu);
            const float cv = ri == 0 ? c_re[((size_t)g * 16 + c) * 64 + n] : -c_im[((size_t)g * 16 + c) * 64 + n];
            cmt[((size_t)g * 16 + c) * 128 + kap] = (bf16_t)(cvt_pk_bf16(cv, 0.f) & 0xffffu);
        }
    }
}
namespace att {
constexpr int D = 128, NW = 8, QBLK = 32, KVBLK = 64, QB = NW * QBLK;
constexpr int SHM_V = KVBLK * D * 2, SHM_K = KVBLK * D * 2;
constexpr int LDS_BYTES_ATT = 2 * SHM_V + 2 * SHM_K + NW * 64 * 4;
constexpr int QS = 1024, KS = 256;
constexpr float SCALE = 0.08838834764831845f, THR = 8.f;
#define KSWZ(row, colB) ((row) * 256 + ((colB) ^ (((row) & 7) << 4)))
#define SBAR() __builtin_amdgcn_sched_barrier(0)
__device__ __forceinline__ int v_st(int k, int c) { const int kk = (k & ~0xC) | ((k & 4) << 1) | ((k & 8) >> 1); return ((kk >> 3) * 4 + (c >> 5)) * 512 + ((kk & 7) * 32 + (c & 31)) * 2; }
__device__ __forceinline__ int v_rd_base(int lane) { return ((lane & 3) << 3) | (((lane >> 2) & 3) << 6) | (((lane >> 4) & 1) << 5) | (((lane >> 5) & 1) << 8); }
constexpr int v_rd_off(int d0, int ks, int half) { return d0 * 512 + ks * 4096 + half * 2048; }
__device__ __forceinline__ int crow(int r, int hi) { return (r & 3) + 8 * (r >> 2) + 4 * hi; }
__device__ __forceinline__ bf16x8 load8(const bf16_t* p) { return *reinterpret_cast<const bf16x8*>(p); }
__device__ __forceinline__ void mask_bits(f32x16& p0, f32x16& p1, u64 w, int hi) {
    const float NEG = -__builtin_inff();
    const unsigned lo = (unsigned)w >> (4 * hi), hh = (unsigned)(w >> 32) >> (4 * hi);
#pragma unroll
    for (int r = 0; r < 16; ++r) {
        const int c = (r & 3) + 8 * (r >> 2);
        if (!((lo >> c) & 1u)) p0[r] = NEG;
        if (!((hh >> c) & 1u)) p1[r] = NEG;
    }
}
__device__ __forceinline__ void partialSM(f32x16& p0, f32x16& p1, float& m_reg, float& mn, float& alpha) {
    float pmax = p0[0]; for (int r = 1; r < 16; ++r) pmax = fmaxf(pmax, p0[r]); for (int r = 0; r < 16; ++r) pmax = fmaxf(pmax, p1[r]);
    { auto rr = __builtin_amdgcn_permlane32_swap(__float_as_uint(pmax), __float_as_uint(pmax), false, false);
      pmax = fmaxf(__uint_as_float(rr[0]), __uint_as_float(rr[1])); }
    constexpr float C2 = 1.4426950408889634f * SCALE;
    if (__builtin_expect(__all((pmax - m_reg) * SCALE <= THR), 1)) { mn = m_reg; alpha = 1.f; }
    else { mn = fmaxf(m_reg, pmax); alpha = __builtin_amdgcn_exp2f((m_reg - mn) * C2); m_reg = mn; }
    const float mnL = -mn * C2;
    for (int r = 0; r < 16; ++r) p0[r] = fmaf(p0[r], C2, mnL); for (int r = 0; r < 16; ++r) p1[r] = fmaf(p1[r], C2, mnL);
    for (int r = 0; r < 16; ++r) p0[r] = __builtin_amdgcn_exp2f(p0[r]);
}
__device__ __forceinline__ void finishSM(f32x16& p0, f32x16& p1, float alpha, float& l_reg, bf16x8& pa0, bf16x8& pa1, bf16x8& pa2, bf16x8& pa3) {
    for (int r = 0; r < 16; ++r) p1[r] = __builtin_amdgcn_exp2f(p1[r]);
    float ps = 0; for (int r = 0; r < 16; ++r) ps += p0[r]; for (int r = 0; r < 16; ++r) ps += p1[r];
    { auto rr = __builtin_amdgcn_permlane32_swap(__float_as_uint(ps), __float_as_uint(ps), false, false);
      ps = __uint_as_float(rr[0]) + __uint_as_float(rr[1]); }
    l_reg = l_reg * alpha + ps;
#define PK4(P, B_, OUT) do { unsigned a0 = cvt_pk_bf16(P[B_+0], P[B_+1]), a1 = cvt_pk_bf16(P[B_+2], P[B_+3]);                          \
        unsigned b0 = cvt_pk_bf16(P[B_+4], P[B_+5]), b1 = cvt_pk_bf16(P[B_+6], P[B_+7]);                                             \
        auto r0 = __builtin_amdgcn_permlane32_swap(a0, b0, false, false); auto r1 = __builtin_amdgcn_permlane32_swap(a1, b1, false, false); \
        u32x4 w = {r0[0], r1[0], r0[1], r1[1]}; OUT = *reinterpret_cast<bf16x8*>(&w); } while (0)
    PK4(p0, 0, pa0); PK4(p0, 8, pa1); PK4(p1, 0, pa2); PK4(p1, 8, pa3);
#undef PK4
}
template <int KB>
__device__ __forceinline__ void qkt(f32x16& p0, f32x16& p1, const char* K_lds, int r32, int hi, const bf16x8* qr) {
    p0 = f32x16{}; p1 = f32x16{};
    const char* kb[4];
#pragma unroll
    for (int dd = 0; dd < 4; ++dd) kb[dd] = K_lds + KB * SHM_K + KSWZ(r32, (dd * 16 + hi * 8) * 2);
#pragma unroll
    for (int d0 = 0; d0 < 8; ++d0) { const char* a = kb[d0 & 3] + (d0 >> 2) * 128;
        bf16x8 b0 = *reinterpret_cast<const bf16x8*>(a);
        bf16x8 b1 = *reinterpret_cast<const bf16x8*>(a + 32 * 256);
        p0 = __builtin_amdgcn_mfma_f32_32x32x16_bf16(b0, qr[d0], p0, 0, 0, 0);
        p1 = __builtin_amdgcn_mfma_f32_32x32x16_bf16(b1, qr[d0], p1, 0, 0, 0); }
}
typedef short s16x4 __attribute__((ext_vector_type(4)));
template <int VB>
__device__ __forceinline__ void pv_tile(f32x16* o, int vb0, bf16x8 pa0, bf16x8 pa1, bf16x8 pa2, bf16x8 pa3) {
#define TRRD(dst, off) asm volatile("ds_read_b64_tr_b16 %0, %1 offset:%2" : "=&v"(dst) : "v"(vb0), "i"(off) : "memory")
#define PV_D0(d0) do { s16x4 l0, l1, l2, l3, h0, h1, h2, h3; constexpr int b_ = VB * SHM_V + v_rd_off(d0, 0, 0); \
        TRRD(l0, b_); TRRD(h0, b_ + 2048); TRRD(l1, b_ + 4096); TRRD(h1, b_ + 6144); TRRD(l2, b_ + 8192); TRRD(h2, b_ + 10240); TRRD(l3, b_ + 12288); TRRD(h3, b_ + 14336); \
        asm volatile("s_waitcnt lgkmcnt(0)" ::: "memory"); SBAR();   \
        o[d0] = __builtin_amdgcn_mfma_f32_32x32x16_bf16(pa0, (bf16x8){l0[0], l0[1], l0[2], l0[3], h0[0], h0[1], h0[2], h0[3]}, o[d0], 0, 0, 0);   \
        o[d0] = __builtin_amdgcn_mfma_f32_32x32x16_bf16(pa1, (bf16x8){l1[0], l1[1], l1[2], l1[3], h1[0], h1[1], h1[2], h1[3]}, o[d0], 0, 0, 0);   \
        o[d0] = __builtin_amdgcn_mfma_f32_32x32x16_bf16(pa2, (bf16x8){l2[0], l2[1], l2[2], l2[3], h2[0], h2[1], h2[2], h2[3]}, o[d0], 0, 0, 0);   \
        o[d0] = __builtin_amdgcn_mfma_f32_32x32x16_bf16(pa3, (bf16x8){l3[0], l3[1], l3[2], l3[3], h3[0], h3[1], h3[2], h3[3]}, o[d0], 0, 0, 0); } while (0)
    PV_D0(0); PV_D0(1); PV_D0(2); PV_D0(3);
#undef PV_D0
#undef TRRD
}
struct BlockRef { const bf16_t* Q; const bf16_t* K; const bf16_t* V; bf16_t* O; const u64* MB; int P0; };
struct Seam { bf16x8 qr[8]; bf16x8 st_v0, st_v1, st_k0, st_k1; };
#define ROWK(p, k0, rr) ((p) + (size_t)((k0) + (rr)) * KS + sc)
#define VMW() asm volatile("s_waitcnt vmcnt(0)" ::: "memory")
#define VMWN(n) asm volatile("s_waitcnt vmcnt(%0)" :: "i"(n) : "memory")
#define SLOAD_H(Kp, Vp, k0) do { S.st_v0 = load8(ROWK(Vp, k0, sr)); S.st_v1 = load8(ROWK(Vp, k0, 32 + sr));              \
                         S.st_k0 = load8(ROWK(Kp, k0, sr)); S.st_k1 = load8(ROWK(Kp, k0, 32 + sr)); } while (0)
#define SWRITE_HK(bf) do { *(bf16x8*)(K_lds + (bf) * SHM_K + kws) = S.st_k0; *(bf16x8*)(K_lds + (bf) * SHM_K + kws + 32 * 256) = S.st_k1; } while (0)
#define SWRITE_HV(bf) do { *(bf16x8*)(V_lds + (bf) * SHM_V + vst0) = S.st_v0; *(bf16x8*)(V_lds + (bf) * SHM_V + vst1) = S.st_v1; } while (0)
#define SWRITE_H(bf) do { SWRITE_HV(bf); SWRITE_HK(bf); } while (0)
__device__ __forceinline__ void attn_prime(const BlockRef& cur, char* lds, Seam& S) {
    const int tid = threadIdx.x, wid = __builtin_amdgcn_readfirstlane(tid >> 6), lane = tid & 63, r32 = lane & 31, hi = lane >> 5;
    const int sr = tid >> 4, sc = (tid & 15) * 8, kws = KSWZ(sr, sc * 2); char* K_lds = lds + 2 * SHM_V;
    for (int d0 = 0; d0 < 8; ++d0) S.qr[d0] = load8(cur.Q + (size_t)(wid * QBLK + r32) * QS + d0 * 16 + hi * 8);
    SLOAD_H(cur.K, cur.V, 0); VMW(); SWRITE_HK(0);
    __syncthreads();
}
__device__ __forceinline__ void attn_block(const BlockRef& cur, const BlockRef& nxt, char* lds, Seam& S) {
    const int tid = threadIdx.x, wid = __builtin_amdgcn_readfirstlane(tid >> 6), lane = tid & 63, r32 = lane & 31, hi = lane >> 5;
    const int NT = cur.P0 / KVBLK + QB / KVBLK;
    char* V_lds = lds; char* K_lds = lds + 2 * SHM_V;
    float* ws = (float*)(lds + 2 * SHM_V + 2 * SHM_K) + wid * 64; float* li_l = ws, * al_l = ws + 32;
    float m_reg = -1e30f, l_reg = 0; f32x16 o[4] = {};
    const int sr = tid >> 4, sc = (tid & 15) * 8, vst0 = v_st(sr, sc), vst1 = v_st(32 + sr, sc), kws = KSWZ(sr, sc * 2);
    const int vb0 = (int)(uintptr_t)V_lds + v_rd_base(lane);
    const bf16_t* Kh = cur.K; const bf16_t* Vh = cur.V;
    const u64* mrow = cur.MB + (size_t)(wid * QBLK + r32) * 32;
    u64 mw;
#define RESC(a) do { if (__any((a) < 1.f)) { if (hi == 0) al_l[r32] = (a); asm volatile("s_waitcnt lgkmcnt(0)" ::: "memory");              \
                     for (int d_ = 0; d_ < 4; ++d_) for (int r = 0; r < 16; ++r) o[d_][r] *= al_l[crow(r, hi)]; } } while (0)
#define KBASE(t) ((t) * KVBLK)
    constexpr int NQL = 8;
#define SEAM_K0() do { VMWN(NQL); SWRITE_HK(0); SBAR(); } while (0)
    f32x16 pA0, pA1, pB0, pB1; float mnA, mnB, alA, alB; bf16x8 pa0, pa1, pa2, pa3;
    SWRITE_HV(0); SBAR();
    if (NT > 1) { SLOAD_H(Kh, Vh, KBASE(1)); }
    mw = mrow[0];
    SBAR(); qkt<0>(pA0, pA1, K_lds, r32, hi, S.qr);
    mask_bits(pA0, pA1, mw, hi); partialSM(pA0, pA1, m_reg, mnA, alA);
    if (NT > 1) { VMW(); SWRITE_H(1); }
    __syncthreads();
#define HALF_STEP(PX0, PX1, mnX, alX, PY0, PY1, alY, t, KB, VB, SB) do {                                                      \
        SBAR(); mw = mrow[(t)]; qkt<KB>(PX0, PX1, K_lds, r32, hi, S.qr);                                             \
        finishSM(PY0, PY1, alY, l_reg, pa0, pa1, pa2, pa3); SBAR();                                                           \
        if ((t) + 1 < NT) { SLOAD_H(Kh, Vh, KBASE((t) + 1)); SBAR(); }                                               \
        pv_tile<VB>(o, vb0, pa0, pa1, pa2, pa3); mask_bits(PX0, PX1, mw, hi); partialSM(PX0, PX1, m_reg, mnX, alX);                                        \
        __syncthreads();                                                                                                      \
        if ((t) + 1 < NT) { VMW(); SWRITE_H(SB); }                                                                          \
        RESC(alX); __syncthreads(); } while (0)
    for (int t = 1; t + 1 < NT; t += 2) {
        HALF_STEP(pB0, pB1, mnB, alB, pA0, pA1, alA, t, 1, 0, 0);
        HALF_STEP(pA0, pA1, mnA, alA, pB0, pB1, alB, t + 1, 0, 1, 1);
    }
    SBAR(); mw = mrow[NT - 1]; qkt<1>(pB0, pB1, K_lds, r32, hi, S.qr); SBAR();
    SLOAD_H(nxt.K, nxt.V, 0); SBAR();
#pragma unroll
    for (int d0 = 0; d0 < 8; ++d0) S.qr[d0] = load8(nxt.Q + (size_t)(wid * QBLK + r32) * QS + d0 * 16 + hi * 8);
    SBAR();
    finishSM(pA0, pA1, alA, l_reg, pa0, pa1, pa2, pa3); SBAR();
    pv_tile<0>(o, vb0, pa0, pa1, pa2, pa3);
    mask_bits(pB0, pB1, mw, hi); partialSM(pB0, pB1, m_reg, mnB, alB); __syncthreads(); RESC(alB);
    finishSM(pB0, pB1, alB, l_reg, pa0, pa1, pa2, pa3); SBAR(); pv_tile<1>(o, vb0, pa0, pa1, pa2, pa3);
    SBAR(); SEAM_K0();
    if (hi == 0) li_l[r32] = l_reg; asm volatile("s_waitcnt lgkmcnt(0)" ::: "memory");
    float rli[16];
#pragma unroll
    for (int r = 0; r < 16; ++r) rli[r] = __builtin_amdgcn_rcpf(li_l[crow(r, hi)]);
    bf16_t* Ow = cur.O + (size_t)(wid * QBLK) * QS;
#pragma unroll
    for (int r = 0; r < 16; ++r) { const int orow = crow(r, hi);
#pragma unroll
        for (int d0 = 0; d0 < 4; ++d0) { const float v = o[d0][r] * rli[r];
            const float vn = __shfl_xor(v, 1);
            if ((r32 & 1) == 0) *(unsigned*)(Ow + (size_t)orow * QS + d0 * 32 + r32) = cvt_pk_bf16(v, vn); } }
    __syncthreads();
#undef RESC
#undef KBASE
#undef SEAM_K0
#undef HALF_STEP
}
#undef ROWK
#undef VMW
#undef VMWN
#undef SLOAD_H
#undef SWRITE_HK
#undef SWRITE_HV
#undef SWRITE_H
#undef KSWZ
}
__device__ __forceinline__ void sample_attn_unit(int u, int tid, int lane, int wave, LAS unsigned char* lds, const bf16_t* __restrict__ qn, const int* __restrict__ sidx, const int* __restrict__ pt,
                                                 const float* __restrict__ ck, const float* __restrict__ cv, const float* __restrict__ out, bf16_t* __restrict__ oatt) {
    const int b = u >> 3, t = (u >> 1) & 3, kvh = u & 1; const size_t row = (size_t)TP + 4 * b + t;
    LAS unsigned char* kv = lds; LAS int* lidx = (LAS int*)(lds + 69632); LAS float* lq = (LAS float*)(lds + 70656); LAS float* lp = (LAS float*)(lds + 72704);
    LAS float* lred = (LAS float*)(lds + 76800); LAS float* lo2 = (LAS float*)(lds + 77056);
    if (tid < 256) lidx[tid] = sidx[(b * 4 + t) * 256 + tid];
    lq[tid] = bf2f(qn[row * 1024 + kvh * 512 + tid]);
    __syncthreads();
#pragma unroll 4
    for (int kk = 0; kk < 32; ++kk) { const int key = wave * 32 + kk; const int idx = lidx[key];
        const float* src = idx < PAST ? ck + (((size_t)pt[b * NPG + (idx >> 7)] * PAGE + (idx & 127)) * 2 + kvh) * 128 : out + O_KS + ((size_t)(b * 4 + idx - PAST) * 2 + kvh) * 128;
        const f32x2 v = *(const f32x2*)(src + 2 * lane); *(LAS unsigned*)(kv + key * 272 + 4 * lane) = cvt_pk_bf16(v.x, v.y); }
    __syncthreads();
    const int key = tid & 255, hp = tid >> 8;
    float s0 = 0.f, s1 = 0.f;
    { const LAS unsigned char* kr = kv + key * 272; const LAS float* q0 = lq + (2 * hp) * 128; const LAS float* q1 = q0 + 128;
#pragma unroll
      for (int c = 0; c < 16; ++c) { const u32x4 w = *(const LAS u32x4*)(kr + 16 * c); f32x4 a, bb; unpack8(w, a, bb);
          const f32x4 qa = *(const LAS f32x4*)(q0 + 8 * c), qb = *(const LAS f32x4*)(q0 + 8 * c + 4), ra = *(const LAS f32x4*)(q1 + 8 * c), rb = *(const LAS f32x4*)(q1 + 8 * c + 4);
          s0 += (a[0] * qa[0] + a[1] * qa[1]) + (a[2] * qa[2] + a[3] * qa[3]) + (bb[0] * qb[0] + bb[1] * qb[1]) + (bb[2] * qb[2] + bb[3] * qb[3]);
          s1 += (a[0] * ra[0] + a[1] * ra[1]) + (a[2] * ra[2] + a[3] * ra[3]) + (bb[0] * rb[0] + bb[1] * rb[1]) + (bb[2] * rb[2] + bb[3] * rb[3]); } }
    s0 *= 0.08838834764831845f; s1 *= 0.08838834764831845f;
    float m0 = s0, m1 = s1;
#pragma unroll
    for (int o = 1; o < 64; o <<= 1) { m0 = fmaxf(m0, __shfl_xor(m0, o)); m1 = fmaxf(m1, __shfl_xor(m1, o)); }
    if (lane == 0) { lred[wave * 2] = m0; lred[wave * 2 + 1] = m1; }
    __syncthreads();
    { const int w0 = hp * 4; m0 = fmaxf(fmaxf(lred[w0 * 2], lred[w0 * 2 + 2]), fmaxf(lred[w0 * 2 + 4], lred[w0 * 2 + 6])); m1 = fmaxf(fmaxf(lred[w0 * 2 + 1], lred[w0 * 2 + 3]), fmaxf(lred[w0 * 2 + 5], lred[w0 * 2 + 7])); }
    const float p0 = __expf(s0 - m0), p1 = __expf(s1 - m1);
    lp[(2 * hp) * 256 + key] = p0; lp[(2 * hp + 1) * 256 + key] = p1;
    const float t0 = wave_sum(p0), t1 = wave_sum(p1);
    if (lane == 0) { lred[16 + wave * 2] = t0; lred[16 + wave * 2 + 1] = t1; }
    __syncthreads();
#pragma unroll 4
    for (int kk = 0; kk < 32; ++kk) { const int ky = wave * 32 + kk; const int idx = lidx[ky];
        const float* src = idx < PAST ? cv + (((size_t)pt[b * NPG + (idx >> 7)] * PAGE + (idx & 127)) * 2 + kvh) * 128 : out + O_VS + ((size_t)(b * 4 + idx - PAST) * 2 + kvh) * 128;
        const f32x2 v = *(const f32x2*)(src + 2 * lane); *(LAS unsigned*)(kv + ky * 256 + 4 * lane) = cvt_pk_bf16(v.x, v.y); }
    __syncthreads();
    const int dp = lane, head = wave & 3, kh = wave >> 2;
    float o0 = 0.f, o1 = 0.f;
#pragma unroll 8
    for (int k = kh * 128; k < kh * 128 + 128; ++k) { const unsigned w = *(const LAS unsigned*)(kv + k * 256 + 4 * dp); const float p = lp[head * 256 + k]; o0 += p * bf_lo(w); o1 += p * bf_hi(w); }
    if (kh == 1) { lo2[head * 128 + 2 * dp] = o0; lo2[head * 128 + 2 * dp + 1] = o1; }
    __syncthreads();
    if (kh == 0) { const int hq = head >> 1, hb = head & 1; const int w0 = hq * 4;
        const float sum = (lred[16 + w0 * 2 + hb] + lred[16 + w0 * 2 + 2 + hb]) + (lred[16 + w0 * 2 + 4 + hb] + lred[16 + w0 * 2 + 6 + hb]);
        const float inv = 1.0f / sum; o0 = (o0 + lo2[head * 128 + 2 * dp]) * inv; o1 = (o1 + lo2[head * 128 + 2 * dp + 1]) * inv;
        *(unsigned*)(oatt + row * 1024 + (kvh * 4 + head) * 128 + 2 * dp) = cvt_pk_bf16(o0, o1); }
    __syncthreads();
}
__device__ __forceinline__ void ld8bf(const bf16_t* p, float (&v)[8]) { const u32x4 a = *(const u32x4*)p; v[0] = bf_lo(a.x); v[1] = bf_hi(a.x); v[2] = bf_lo(a.y); v[3] = bf_hi(a.y); v[4] = bf_lo(a.z); v[5] = bf_hi(a.z); v[6] = bf_lo(a.w); v[7] = bf_hi(a.w); }
__device__ __forceinline__ void ld8f(const float* p, float (&v)[8]) { const f32x4 a = *(const f32x4*)p, b = *(const f32x4*)(p + 4); v[0] = a.x; v[1] = a.y; v[2] = a.z; v[3] = a.w; v[4] = b.x; v[5] = b.y; v[6] = b.z; v[7] = b.w; }
__device__ __forceinline__ void st8f(float* p, const float (&v)[8]) { *(f32x4*)p = (f32x4){v[0], v[1], v[2], v[3]}; *(f32x4*)(p + 4) = (f32x4){v[4], v[5], v[6], v[7]}; }
__device__ __forceinline__ void conv_item(int rblk, int cg, int lane, const bf16_t* __restrict__ up, bf16_t* __restrict__ act, const float* __restrict__ cw, const float* __restrict__ cb,
                                          const float* __restrict__ sconv, float* __restrict__ out) {
    const int col = 512 * cg + 8 * lane; if (col >= DFF) return;
    float wg[3][8], wv[3][8], bg[8], bv[8], g2[8], g1[8], v2[8], v1[8];
#pragma unroll
    for (int j = 0; j < 3; ++j) { ld8f(cw + (size_t)j * DFF2 + col, wg[j]); ld8f(cw + (size_t)j * DFF2 + DFF + col, wv[j]); }
    ld8f(cb + col, bg); ld8f(cb + DFF + col, bv);
    size_t row0; int nrows; int tbase; int b; const bool samp = rblk >= 512;
    if (!samp) { b = rblk >> 5; tbase = (rblk & 31) * 64; row0 = (size_t)b * SEQ + tbase; nrows = 64;
        if (tbase == 0) {
#pragma unroll
            for (int e = 0; e < 8; ++e) { g2[e] = 0.f; g1[e] = 0.f; v2[e] = 0.f; v1[e] = 0.f; } }
        else { ld8bf(up + (row0 - 2) * DFF2 + col, g2); ld8bf(up + (row0 - 1) * DFF2 + col, g1); ld8bf(up + (row0 - 2) * DFF2 + DFF + col, v2); ld8bf(up + (row0 - 1) * DFF2 + DFF + col, v1); } }
    else { b = rblk - 512; tbase = 0; row0 = (size_t)TP + 4 * b; nrows = 4;
        ld8f(sconv + ((size_t)b * 2 + 0) * DFF2 + col, g2); ld8f(sconv + ((size_t)b * 2 + 1) * DFF2 + col, g1); ld8f(sconv + ((size_t)b * 2 + 0) * DFF2 + DFF + col, v2); ld8f(sconv + ((size_t)b * 2 + 1) * DFF2 + DFF + col, v1); }
#pragma unroll 2
    for (int r = 0; r < nrows; ++r) {
        float gc[8], vc[8], a[8];
        ld8bf(up + (row0 + r) * DFF2 + col, gc); ld8bf(up + (row0 + r) * DFF2 + DFF + col, vc);
#pragma unroll
        for (int e = 0; e < 8; ++e) { const float cgt = wg[0][e] * g2[e] + wg[1][e] * g1[e] + wg[2][e] * gc[e] + bg[e]; const float cvl = wv[0][e] * v2[e] + wv[1][e] * v1[e] + wv[2][e] * vc[e] + bv[e]; a[e] = gelu_tanh(cgt) * cvl; }
        u32x4 w; w.x = cvt_pk_bf16(a[0], a[1]); w.y = cvt_pk_bf16(a[2], a[3]); w.z = cvt_pk_bf16(a[4], a[5]); w.w = cvt_pk_bf16(a[6], a[7]);
        *(u32x4*)(act + (row0 + r) * DFF + col) = w;
        const int t = tbase + r;
        if (!samp && t >= SEQ - 2) { float* o = out + O_CVP + ((size_t)b * 2 + (t - (SEQ - 2))) * DFF2; st8f(o + col, gc); st8f(o + DFF + col, vc); }
        if (samp && t >= DT - 2) { float* o = out + O_CVS + ((size_t)b * 2 + (t - (DT - 2))) * DFF2; st8f(o + col, gc); st8f(o + DFF + col, vc); }
#pragma unroll
        for (int e = 0; e < 8; ++e) { g2[e] = g1[e]; g1[e] = gc[e]; v2[e] = v1[e]; v1[e] = vc[e]; }
    }
}
constexpr int NPH = 15;
#ifndef MK_N_LAUNCHES
#define MK_N_LAUNCHES 1
#endif
struct Args { const void* in[36]; float* out; unsigned char* ws; int ph_lo, ph_hi, bar_region, pad; };

__global__ void __launch_bounds__(NWAVES * 64, 2) fwd(Args args) {
    extern __shared__ __attribute__((aligned(16))) unsigned char lds_raw[];
    LAS unsigned char* lds = (LAS unsigned char*)lds_raw;
    const int tid = threadIdx.x, lane = tid & 63, wave = __builtin_amdgcn_readfirstlane(tid >> 6);
    const int G = gridDim.x; const int bx = blockIdx.x; const int vcu = (G % 8 == 0) ? (bx % 8) * (G / 8) + bx / 8 : bx;
    const int gw = vcu * NWAVES + wave, NGW = G * NWAVES;
    unsigned char* ws = args.ws; float* out = args.out;
    const float* x_p = (const float*)args.in[0]; const float* x_s = (const float*)args.in[1];
    const float* cache_k = (const float*)args.in[2]; const float* cache_v = (const float*)args.in[3]; const float* cache_ik = (const float*)args.in[4];
    const float* st_re = (const float*)args.in[5]; const float* st_im = (const float*)args.in[6]; const float* st_conv = (const float*)args.in[7];
    const int* ptab = (const int*)args.in[8]; const float* p_p = (const float*)args.in[9]; const float* p_s = (const float*)args.in[10];
    const float* g_mix = (const float*)args.in[11]; const float* w_in = (const float*)args.in[12]; const float* g_q = (const float*)args.in[13]; const float* g_k = (const float*)args.in[14];
    const float* a_re = (const float*)args.in[15]; const float* a_im = (const float*)args.in[16]; const float* log_dt = (const float*)args.in[17];
    const float* sb_re = (const float*)args.in[18]; const float* sb_im = (const float*)args.in[19]; const float* sc_re = (const float*)args.in[20]; const float* sc_im = (const float*)args.in[21];
    const float* ssm_d = (const float*)args.in[22]; const float* w_glu = (const float*)args.in[23]; const float* w_att = (const float*)args.in[24]; const float* w_ssm = (const float*)args.in[25];
    const float* w_o = (const float*)args.in[26]; const float* g_ffn = (const float*)args.in[27]; const float* w_up = (const float*)args.in[28]; const float* conv_w = (const float*)args.in[29];
    const float* conv_b = (const float*)args.in[30]; const float* w_down = (const float*)args.in[31]; const float* w_ple = (const float*)args.in[32]; const float* g_ple = (const float*)args.in[33];
    const float* g_pg = (const float*)args.in[34]; const float* w_pg = (const float*)args.in[35];
    float* RT = (float*)(ws + WS_RT); unsigned char* SSC = ws + WS_SSC;
    bf16_t* WIN = (bf16_t*)(ws + WS_WIN); bf16_t* WGLU = (bf16_t*)(ws + WS_WGLU); bf16_t* WATT = (bf16_t*)(ws + WS_WATT); bf16_t* WSSM = (bf16_t*)(ws + WS_WSSM); bf16_t* WO = (bf16_t*)(ws + WS_WO);
    bf16_t* WUP = (bf16_t*)(ws + WS_WUP); bf16_t* WDN = (bf16_t*)(ws + WS_WDN); bf16_t* WPLE = (bf16_t*)(ws + WS_WPLE); bf16_t* WPG = (bf16_t*)(ws + WS_WPG);
    bf16_t* H = (bf16_t*)(ws + WS_H); bf16_t* PBF = (bf16_t*)(ws + WS_PBF); bf16_t* PLER = (bf16_t*)(ws + WS_PLER); float* RSP = (float*)(ws + WS_RSP);
    bf16_t* PROJ = (bf16_t*)(ws + WS_PROJ); bf16_t* QN = (bf16_t*)(ws + WS_QN); bf16_t* KN = (bf16_t*)(ws + WS_KN); bf16_t* VB = (bf16_t*)(ws + WS_VB); bf16_t* IQ = (bf16_t*)(ws + WS_IQ);
    bf16_t* IKR = (bf16_t*)(ws + WS_IKR); float* IW = (float*)(ws + WS_IW); float* SC = (float*)(ws + WS_SC); float* SSC2 = (float*)(ws + WS_SSC2); u64* BMK = (u64*)(ws + WS_BM); int* SIDX = (int*)(ws + WS_SIDX);
    bf16_t* OATT = (bf16_t*)(ws + WS_OATT); bf16_t* Z = (bf16_t*)(ws + WS_Z); bf16_t* Z2 = (bf16_t*)(ws + WS_Z2); f32x2* SE = (f32x2*)(ws + WS_SE); f32x2* SIN = (f32x2*)(ws + WS_SIN);
    bf16_t* MRG = (bf16_t*)(ws + WS_MRG); bf16_t* UP = (bf16_t*)(ws + WS_UP); bf16_t* ACT = (bf16_t*)(ws + WS_ACT);

    for (int u = tid; u < (LDS_BYTES - LDSCTL_OFF) / 4; u += NWAVES * 64) ((LAS unsigned*)(lds + LDSCTL_OFF))[u] = 0u;
    __syncthreads();
    const int lo = args.ph_lo, hi = args.ph_hi;
    XcdBarrier bar; bar.bar = (unsigned*)(ws + WS_CTL) + CW_BAR + args.bar_region * XCD_BAR_WORDS; bar.x = 0; bar.st = nullptr;
    if (hi - lo > 1) bar = xcd_barrier_post((unsigned*)(ws + WS_CTL) + CW_BAR + args.bar_region * XCD_BAR_WORDS, (volatile LAS unsigned*)(lds + MISC_OFF) + 8);
#define IN(k) (lo <= (k) && (k) < hi)
#define SEAM(k) do { if (IN(k) && IN((k) + 1)) xcd_barrier(bar); } while (0)
#define XROW(m) ((m) < TP ? x_p + (size_t)(m) * DM : x_s + (size_t)((m) - TP) * DM)
    const SsmConst sscn{(const float*)(SSC + SSC_ABAR), (const float*)(SSC + SSC_A32), (const bf16_t*)(SSC + SSC_BBT), (const bf16_t*)(SSC + SSC_CMT)};

    if (IN(0)) {
        LAS float* scr = (LAS float*)(lds + wave * 16384);
        constexpr int I0 = (DM / 64) * (INWP / 32), I1 = (512 / 64) * (512 / 32), I2 = (1024 / 64) * (DM / 32), I3 = (512 / 64) * (DM / 32), I4 = (DM / 64) * (DM / 32),
                      I5 = (DM / 64) * (DFF2 / 32), I6 = (DFF / 64) * (DM / 32), I7 = (PLE / 64) * (DM / 32), I8 = (DM / 64) * (DM / 32);
        constexpr int NITEMS = I0 + I1 + I2 + I3 + I4 + I5 + I6 + I7 + I8;
        for (int it = gw; it < NITEMS; it += NGW) {
            int r = it;
            if (r < I0) { transpose_item(w_in, DM, INW, WIN, INWP / 32, scr, r, lane); continue; } r -= I0;
            if (r < I1) { transpose_item(w_glu, 512, 512, WGLU, 512 / 32, scr, r, lane); continue; } r -= I1;
            if (r < I2) { transpose_item(w_att, 1024, DM, WATT, DM / 32, scr, r, lane); continue; } r -= I2;
            if (r < I3) { transpose_item(w_ssm, 512, DM, WSSM, DM / 32, scr, r, lane); continue; } r -= I3;
            if (r < I4) { transpose_item(w_o, DM, DM, WO, DM / 32, scr, r, lane); continue; } r -= I4;
            if (r < I5) { transpose_item(w_up, DM, DFF2, WUP, DFF2 / 32, scr, r, lane); continue; } r -= I5;
            if (r < I6) { transpose_item(w_down, DFF, DM, WDN, DM / 32, scr, r, lane); continue; } r -= I6;
            if (r < I7) { transpose_item(w_ple, PLE, DM, WPLE, DM / 32, scr, r, lane); continue; } r -= I7;
            transpose_item(w_pg, DM, DM, WPG, DM / 32, scr, r, lane);
        }
        for (int m = gw; m < MR; m += NGW) {
            rms_row_to_bf16(XROW(m), g_mix, H + (size_t)m * DM, lane);
            const float* pr = m < TP ? p_p + (size_t)m * PLE : p_s + (size_t)(m - TP) * PLE;
            const f32x4 v = *((const f32x4*)pr + lane); u32x2 w; w.x = cvt_pk_bf16(v.x, v.y); w.y = cvt_pk_bf16(v.z, v.w); *((u32x2*)(PBF + (size_t)m * PLE) + lane) = w;
        }
        for (int e = gw * 64 + lane; e < (SEQ + DT) * 24; e += NGW * 64) {
            const int pi = e / 24, i = e % 24; const double pos = pi < SEQ ? (double)pi : (double)(PAST + pi - SEQ);
            const double ex = i < 16 ? (double)i / 16.0 : (double)(i - 16) / 8.0; double inv, dum; cexp_d(-ex * 13.122363377404328, 0.0, 10, inv, dum);
            double c, s; cexp_d(0.0, pos * inv, 20, c, s);
            if (i < 16) { RT[pi * 48 + i] = (float)c; RT[pi * 48 + 16 + i] = (float)s; } else { RT[pi * 48 + 32 + (i - 16)] = (float)c; RT[pi * 48 + 40 + (i - 16)] = (float)s; }
        }
        for (int gn = gw * 64 + lane; gn < SG * SN; gn += NGW * 64) ssm_constants(gn, a_re, a_im, log_dt, sb_re, sb_im, sc_re, sc_im, SSC);
    }
    SEAM(0);
    if (IN(1)) {
        { pg8::Gemm g{H, WIN, MP, INWP, DM, DM}; pg8::StaticOrder S; S.init(MP, INWP, G, bx); EpiStoreBf16 E{PROJ, INWP};
          pg8::gemm_phase<EpiStoreBf16, pg8::StaticOrder, true, true>(lds, g, S, E); }
        { pg8::Gemm g{PBF, WPLE, MP, DM, PLE, PLE}; pg8::StaticOrder S; S.init(MP, DM, G, bx); EpiStoreBf16 E{PLER, DM};
          pg8::gemm_phase<EpiStoreBf16, pg8::StaticOrder, true, true>(lds, g, S, E); }
    }
    SEAM(1);
    if (IN(2)) {
        for (int task = gw; task < SSM_NCH * SG; task += NGW) ssm_task<0>(0, task & 31, task >> 5, lane, sscn, PROJ, ssm_d, SE, SIN, nullptr, nullptr, Z, nullptr, nullptr);
        for (int row = gw; row < MR; row += NGW) ta_row(row, lane, PROJ, RT, g_q, g_k, QN, KN, VB, IQ, IKR, IW, out);
    }
    SEAM(2);
    if (IN(3)) {
        for (int u = vcu; u < 256; u += G) { const int b = u >> 4, y = u & 15; idx_prompt_block(b, y, wave, lane, IQ, IKR, IW, SC); idx_prompt_block(b, 31 - y, wave, lane, IQ, IKR, IW, SC); }
        for (int u = vcu; u < 512; u += G) idx_sample_unit(u >> 4, u & 15, wave, lane, IQ, IKR, IW, cache_ik, ptab, SSC2);
        for (int idx = gw * 64 + lane; idx < NB * SG * SN; idx += NGW * 64) ssm_carry(idx, sscn.a32, SE, SIN, out + O_SRP, out + O_SIP);
    }
    SEAM(3);
    if (IN(4)) {
        for (int r = vcu; r < TS; r += G) select_sample_row(r, tid, lane, wave, SSC2, SIDX, (LAS unsigned*)lds);
        for (int k = gw; k < TP; k += NGW) { const int b = k >> 11, t0 = k & (SEQ - 1); const int t = (b & 1) ? (SEQ - 1 - t0) : t0; select_prompt_row(__builtin_amdgcn_readfirstlane(b * SEQ + t), lane, SC, BMK); }
        for (int task = gw; task < SSM_NCH * SG + 2 * SG; task += NGW) {
            if (task < SSM_NCH * SG) ssm_task<1>(0, task & 31, task >> 5, lane, sscn, PROJ, ssm_d, SE, SIN, nullptr, nullptr, Z, nullptr, nullptr);
            else { const int k = task - SSM_NCH * SG; ssm_task<2>(k >> 5, k & 31, 0, lane, sscn, PROJ, ssm_d, SE, SIN, st_re, st_im, Z, out + O_SRS, out + O_SIS); }
        }
    }
    SEAM(4);
    if (IN(5)) {
        {
            const int total = NB * NH * 4;
            auto mkref = [&](int L, int pass) { const int gq = L & 3, y = (L >> 2) & 3, kvh = (L >> 4) & 1, b = L >> 5; const int h = kvh * 4 + gq, qb = pass ? 7 - y : y;
                att::BlockRef r; const size_t q0 = ((size_t)b * SEQ + (size_t)qb * 256) * 1024 + h * 128;
                r.Q = QN + q0; r.O = OATT + q0; r.K = KN + (size_t)b * SEQ * 256 + kvh * 128; r.V = VB + (size_t)b * SEQ * 256 + kvh * 128; r.MB = BMK + ((size_t)b * SEQ + (size_t)qb * 256) * 32; r.P0 = qb * 256; return r; };
            int L = vcu;
            if (L < total) {
                int pass = 0; att::BlockRef cur = mkref(L, 0); att::Seam S;
                att::attn_prime(cur, (char*)lds_raw, S);
                for (;;) {
                    const bool more_pass = pass == 0, more_item = L + G < total, last = !more_pass && !more_item;
                    int passn = pass + 1, Ln = L; if (!more_pass) { passn = 0; Ln = more_item ? L + G : L; }
                    const att::BlockRef nxt = last ? cur : mkref(Ln, passn);
                    att::attn_block(cur, nxt, (char*)lds_raw, S);
                    if (last) break;
                    cur = nxt; pass = passn; L = Ln;
                }
            }
            VM_WAIT(); __syncthreads();
        }
        for (int u = vcu; u < 256; u += G) sample_attn_unit(u, tid, lane, wave, lds, QN, SIDX, ptab, cache_k, cache_v, out, OATT);
        { pg8::Gemm g{Z, WGLU, MP, 512, 512, 512}; pg8::StaticOrder S; S.init(MP, 512, G, bx); EpiGlu E{Z, Z2, 512};
          pg8::gemm_phase<EpiGlu, pg8::StaticOrder, true, true>(lds, g, S, E); }
    }
    SEAM(5);
    if (IN(6)) { pg8::Gemm g{OATT, WATT, MP, DM, 1024, 1024}; pg8::StaticOrder S; S.init(MP, DM, G, bx); EpiGate<false> E{PROJ + C_GA, INWP, MRG, DM};
        pg8::gemm_phase<EpiGate<false>, pg8::StaticOrder, true, true>(lds, g, S, E); }
    SEAM(6);
    if (IN(7)) { pg8::Gemm g{Z2, WSSM, MP, DM, 512, 512}; pg8::StaticOrder S; S.init(MP, DM, G, bx); EpiGate<true> E{PROJ + C_GS, INWP, MRG, DM};
        pg8::gemm_phase<EpiGate<true>, pg8::StaticOrder, true, true>(lds, g, S, E); }
    SEAM(7);
    if (IN(8)) { pg8::Gemm g{MRG, WO, MP, DM, DM, DM}; pg8::StaticOrder S; S.init(MP, DM, G, bx); EpiResid E{x_p, x_s, out + O_Y};
        pg8::gemm_phase<EpiResid, pg8::StaticOrder, true, true>(lds, g, S, E); }
    SEAM(8);
    if (IN(9)) { for (int m = gw; m < MR; m += NGW) rms_row_to_bf16(out + O_Y + (size_t)m * DM, g_ffn, H + (size_t)m * DM, lane); }
    SEAM(9);
    if (IN(10)) { pg8::Gemm g{H, WUP, MP, DFF2, DM, DM}; pg8::StaticOrder S; S.init(MP, DFF2, G, bx); EpiStoreBf16 E{UP, DFF2};
        pg8::gemm_phase<EpiStoreBf16, pg8::StaticOrder, true, true>(lds, g, S, E); }
    SEAM(10);
    if (IN(11)) { for (int it = gw; it < (512 + DB) * 11; it += NGW) conv_item(it / 11, it % 11, lane, UP, ACT, conv_w, conv_b, st_conv, out); }
    SEAM(11);
    if (IN(12)) { pg8::Gemm g{ACT, WDN, MP, DM, DFF, DFF}; pg8::StaticOrder S; S.init(MP, DM, G, bx); EpiResid E{out + O_Y, out + O_Y + (size_t)TP * DM, out + O_Y};
        pg8::gemm_phase<EpiResid, pg8::StaticOrder, true, true>(lds, g, S, E); }
    SEAM(12);
    if (IN(13)) { for (int m = gw; m < MR; m += NGW) { rms_row_to_bf16(out + O_Y + (size_t)m * DM, g_pg, H + (size_t)m * DM, lane);
            const bf16_t* pr = PLER + (size_t)m * DM + 32 * lane; float ss = 0.f;
#pragma unroll
            for (int j = 0; j < 4; ++j) { f32x4 a, b; unpack8(*(const u32x4*)(pr + 8 * j), a, b); ss += (a[0] * a[0] + a[1] * a[1]) + (a[2] * a[2] + a[3] * a[3]) + (b[0] * b[0] + b[1] * b[1]) + (b[2] * b[2] + b[3] * b[3]); }
            ss = wave_sum(ss); if (lane == 0) RSP[m] = 1.0f / sqrtf(ss * (1.f / DM) + EPS); } }
    SEAM(13);
    if (IN(14)) { pg8::Gemm g{H, WPG, MP, DM, DM, DM}; pg8::StaticOrder S; S.init(MP, DM, G, bx); EpiPg E{out + O_Y, PLER, RSP, g_ple};
        pg8::gemm_phase<EpiPg, pg8::StaticOrder, true, true>(lds, g, S, E); }
#undef IN
#undef SEAM
#undef XROW
}

extern "C" void kernel_launch(void* const* d_in, const int* in_sizes, int n_in, void* d_out, int out_size, void* d_ws, size_t ws_size, hipStream_t stream) {
    static int grid = 0;
    if (grid == 0) {
        if (n_in != 36 || out_size != (int)O_END || ws_size < WS_END) { fprintf(stderr, "kernel_launch: unexpected shapes (n_in %d, out %d, ws %zu; want 36, %zu, >= %zu)\n", n_in, out_size, ws_size, (size_t)O_END, (size_t)WS_END); grid = -1; return; }
        int dev = 0, cus = 0, per_cu = 0;
        if (hipGetDevice(&dev) != hipSuccess || hipDeviceGetAttribute(&cus, hipDeviceAttributeMultiprocessorCount, dev) != hipSuccess) { grid = -1; return; }
        if (hipFuncSetAttribute((const void*)fwd, hipFuncAttributeMaxDynamicSharedMemorySize, LDS_BYTES) != hipSuccess) { fprintf(stderr, "kernel_launch: hipFuncSetAttribute failed\n"); grid = -1; return; }
        if (hipOccupancyMaxActiveBlocksPerMultiprocessor(&per_cu, (const void*)fwd, NWAVES * 64, LDS_BYTES) != hipSuccess || per_cu < 1) fprintf(stderr, "kernel_launch: occupancy query reports %d\n", per_cu);
        (void)hipGetLastError();
        grid = cus;
    }
    if (grid < 0) return;
    if (hipMemsetAsync((char*)d_ws + WS_CTL, 0, CTL_ZERO_BYTES, stream) != hipSuccess) return;
    Args a{};
    for (int i = 0; i < 36; ++i) a.in[i] = d_in[i];
    a.out = (float*)d_out; a.ws = (unsigned char*)d_ws;
    const int nl = MK_N_LAUNCHES;
    for (int li = 0; li < nl; ++li) {
        a.ph_lo = (NPH * li) / nl; a.ph_hi = (NPH * (li + 1)) / nl; a.bar_region = li; a.pad = 0;
        hipLaunchKernelGGL(fwd, dim3(grid), dim3(NWAVES * 64), LDS_BYTES, stream, a);
    }
}
```

```cpp
#include <hip/hip_runtime.h>
#include <cstdio>
#include <cstdint>

#define LAS __attribute__((address_space(3)))
#define GAS __attribute__((address_space(1)))
typedef unsigned short bf16_t;
typedef short bf16x8 __attribute__((ext_vector_type(8)));
typedef short bf16x4 __attribute__((ext_vector_type(4)));
typedef float f32x4 __attribute__((ext_vector_type(4)));
typedef float f32x2 __attribute__((ext_vector_type(2)));
typedef float f32x16 __attribute__((ext_vector_type(16)));
typedef unsigned u32x4 __attribute__((ext_vector_type(4)));
typedef unsigned u32x2 __attribute__((ext_vector_type(2)));
typedef unsigned long long u64;

constexpr int DM = 2048, NB = 16, SEQ = 2048, DB = 32, DT = 4, PAST = 16384, PAGE = 128, NPG = 128;
constexpr int TP = NB * SEQ, TS = DB * DT, MR = TP + TS, MP = 33024;
constexpr int NH = 8, NKV = 2, HD = 128, IH = 16, IDD = 64;
constexpr int SSMW = 512, SG = 32, SN = 64;
constexpr int DFF = 5504, DFF2 = 11008, PLE = 256;
constexpr int INW = 7248, INWP = 7424;
constexpr int C_Q = 0, C_K = 1024, C_V = 1280, C_IQ = 1536, C_IK = 2560, C_IW = 2624, C_U = 2640, C_GA = 3152, C_GS = 5200;
constexpr float EPS = 1e-6f, IDX_SCALE = 0.03125f;
constexpr int SSM_L = 32, SSM_NCH = SEQ / SSM_L;
constexpr int SLEN = PAST + DT, SSTR = 16400;

constexpr size_t O_Y = 0;
constexpr size_t O_KP = (size_t)MR * DM;
constexpr size_t O_VP = O_KP + (size_t)TP * 256;
constexpr size_t O_IKP = O_VP + (size_t)TP * 256;
constexpr size_t O_SRP = O_IKP + (size_t)TP * 64;
constexpr size_t O_SIP = O_SRP + (size_t)NB * SG * SN;
constexpr size_t O_CVP = O_SIP + (size_t)NB * SG * SN;
constexpr size_t O_KS = O_CVP + (size_t)NB * 2 * DFF2;
constexpr size_t O_VS = O_KS + (size_t)TS * 256;
constexpr size_t O_IKS = O_VS + (size_t)TS * 256;
constexpr size_t O_SRS = O_IKS + (size_t)TS * 64;
constexpr size_t O_SIS = O_SRS + (size_t)DB * SG * SN;
constexpr size_t O_CVS = O_SIS + (size_t)DB * SG * SN;
constexpr size_t O_END = O_CVS + (size_t)DB * 2 * DFF2;
static_assert(O_END == 87572480, "output size");

constexpr size_t MiB = 1u << 20;
constexpr size_t al(size_t x) { return (x + MiB - 1) & ~(MiB - 1); }
constexpr size_t WS_CTL = 0, CTL_ZERO_BYTES = MiB;
constexpr size_t WS_RT = WS_CTL + MiB;
constexpr size_t WS_SSC = WS_RT + MiB;
constexpr size_t WS_WIN = WS_SSC + MiB;
constexpr size_t WS_WGLU = WS_WIN + al((size_t)INWP * DM * 2);
constexpr size_t WS_WATT = WS_WGLU + al((size_t)512 * 512 * 2);
constexpr size_t WS_WSSM = WS_WATT + al((size_t)DM * 1024 * 2);
constexpr size_t WS_WO = WS_WSSM + al((size_t)DM * 512 * 2);
constexpr size_t WS_WUP = WS_WO + al((size_t)DM * DM * 2);
constexpr size_t WS_WDN = WS_WUP + al((size_t)DFF2 * DM * 2);
constexpr size_t WS_WPLE = WS_WDN + al((size_t)DM * DFF * 2);
constexpr size_t WS_WPG = WS_WPLE + al((size_t)DM * PLE * 2);
constexpr size_t WS_H = WS_WPG + al((size_t)DM * DM * 2);
constexpr size_t WS_PBF = WS_H + al((size_t)MP * DM * 2);
constexpr size_t WS_PLER = WS_PBF + al((size_t)MP * PLE * 2);
constexpr size_t WS_RSP = WS_PLER + al((size_t)MP * DM * 2);
constexpr size_t WS_A0 = WS_RSP + MiB;
constexpr size_t WS_PROJ = WS_A0;
constexpr size_t WS_QN = WS_PROJ + al((size_t)MP * INWP * 2);
constexpr size_t WS_KN = WS_QN + al((size_t)MP * 1024 * 2);
constexpr size_t WS_VB = WS_KN + al((size_t)MP * 256 * 2);
constexpr size_t WS_IQ = WS_VB + al((size_t)MP * 256 * 2);
constexpr size_t WS_IKR = WS_IQ + al((size_t)MP * 1024 * 2);
constexpr size_t WS_IW = WS_IKR + al((size_t)MP * 64 * 2);
constexpr size_t WS_SC = WS_IW + al((size_t)MP * 16 * 4);
constexpr size_t WS_SSC2 = WS_SC + al((size_t)NB * SEQ * SEQ * 4);
constexpr size_t WS_BM = WS_SSC2 + al((size_t)TS * SSTR * 4);
constexpr size_t WS_SIDX = WS_BM + al((size_t)TP * 32 * 8);
constexpr size_t WS_OATT = WS_SIDX + MiB;
constexpr size_t WS_Z = WS_OATT + al((size_t)MP * 1024 * 2);
constexpr size_t WS_Z2 = WS_Z + al((size_t)MP * 512 * 2);
constexpr size_t WS_SE = WS_Z2 + al((size_t)MP * 512 * 2);
constexpr size_t WS_SIN = WS_SE + al((size_t)NB * SSM_NCH * SG * SN * 8);
constexpr size_t WS_MRG = WS_SIN + al((size_t)NB * SSM_NCH * SG * SN * 8);
constexpr size_t WS_A_END = WS_MRG + al((size_t)MP * DM * 2);
constexpr size_t WS_UP = WS_A0;
constexpr size_t WS_ACT = WS_UP + al((size_t)MP * DFF2 * 2);
constexpr size_t WS_B_END = WS_ACT + al((size_t)MP * DFF * 2);
constexpr size_t WS_END = WS_A_END > WS_B_END ? WS_A_END : WS_B_END;
static_assert(WS_END < (size_t)2600 * MiB, "d_ws map too large");
constexpr size_t SSC_ABAR = 0, SSC_A32 = 16384, SSC_BBT = 32768, SSC_CMT = 32768 + 131072, SSC_END = SSC_CMT + 131072;
static_assert(SSC_END <= MiB, "ssc");
constexpr int CW_BAR = 4096;

constexpr int RING_BYTES = 131072;
constexpr int LDSCTL_OFF = RING_BYTES, MISC_OFF = LDSCTL_OFF + 320;
constexpr int LDS_BYTES = 147456;
constexpr int NWAVES = 8;

__device__ __forceinline__ unsigned cvt_pk_bf16(float lo, float hi) { unsigned r; asm volatile("v_cvt_pk_bf16_f32 %0, %1, %2" : "=v"(r) : "v"(lo), "v"(hi)); return r; }
__device__ __forceinline__ float bf_lo(unsigned w) { return __uint_as_float(w << 16); }
__device__ __forceinline__ float bf_hi(unsigned w) { return __uint_as_float(w & 0xffff0000u); }
__device__ __forceinline__ float bf2f(bf16_t x) { return __uint_as_float(((unsigned)x) << 16); }
__device__ __forceinline__ float sigmoidf_(float x) { return __builtin_amdgcn_rcpf(1.0f + __expf(-x)); }
__device__ __forceinline__ float gelu_tanh(float y) { const float t = 1.5957691216057308f * (y + 0.044715f * y * y * y); return y * __builtin_amdgcn_rcpf(1.0f + __expf(-t)); }
__device__ __forceinline__ float wave_sum(float v) {
#pragma unroll
    for (int o = 1; o < 64; o <<= 1) v += __shfl_xor(v, o);
    return v;
}
#define LDS_WAIT() asm volatile("s_waitcnt lgkmcnt(0)" ::: "memory")
#define VM_WAIT() asm volatile("s_waitcnt vmcnt(0)" ::: "memory")
namespace pg8 {
#define PG8_LAS __attribute__((address_space(3)))
constexpr int BM = 256, BK = 64, HALF = 128, HTB = HALF * BK * 2  , STAGE_BYTES = 8 * HTB, NXCD = 8, WGM = 8;

__host__ __device__ __forceinline__ int lds_byte(int r, int c) { const int st = (r >> 4) * 2 + (c >> 5), rr = r & 15, cc = c & 31, ob = rr * 64 + cc * 2; return st * 1024 + (ob ^ (((ob >> 9) & 1) << 5)); }
__host__ __device__ __forceinline__ void stage_rc(int b, int& R, int& C) { const int st = b / 1024, sb = b % 1024, swz = sb ^ (((sb >> 9) & 1) << 5); R = (st >> 1) * 16 + swz / 64; C = (st & 1) * 32 + (swz % 64) / 2; }
__host__ __device__ __forceinline__ int perm32(int rho) { const int n = rho >> 4, i = rho & 15; return 8 * (i >> 2) + 4 * n + (i & 3); }

struct Unit { int pm, pn; };
struct Gemm { const bf16_t* A; const bf16_t* Bt; int M, N, K, lda; };

struct StaticOrder {
    int nM, nN, nwg, G, c;
    __host__ __device__ void init(int M, int N, int G_, int c_) { nM = M / BM; nN = N / BM; nwg = nM * nN; G = G_; c = c_; }
    __host__ __device__ bool next(int i, Unit& u) const {
        const long L = (long)i * G + c; if (L >= nwg) return false;
        int wgid = (int)L; { const int q = nwg / NXCD, r = nwg % NXCD, xcd = wgid % NXCD, off = wgid / NXCD; wgid = (xcd < r ? xcd * (q + 1) : r * (q + 1) + (xcd - r) * q) + off; }
        const int nig = WGM * nN, gid = wgid / nig, fm = gid * WGM, gsz = (nM - fm) < WGM ? (nM - fm) : WGM;
        u.pm = fm + ((wgid % nig) % gsz); u.pn = (wgid % nig) / gsz; return true;
    }
    __device__ __forceinline__ void a_ready(const Unit&) const {}
    __device__ __forceinline__ void done(const Unit&) const {}
};
template <class Epi, class Sched, bool ALIGN_EPI = false, bool SP2 = false>
__device__ __forceinline__ void gemm_phase(PG8_LAS unsigned char* lds, const Gemm g, const Sched& S, const Epi& E) {
    const int tid = threadIdx.x, wid = __builtin_amdgcn_readfirstlane(tid >> 6), lane = tid & 63, wr = wid >> 2, wc = wid & 3, fr = lane & 15, fq = lane >> 4;
    const int K = g.K, nt = K / BK;
    unsigned voffA[2], voffB[2];
#pragma unroll
    for (int i = 0; i < 2; ++i) { int R, C; stage_rc(tid * 16 + i * 8192, R, C); const int Rb = Epi::PERM ? ((R & ~31) + perm32(R & 31)) : R;
        voffA[i] = (unsigned)(R * g.lda + C) * 2u; voffB[i] = (unsigned)(Rb * K + C) * 2u; }
    const size_t kstep = (size_t)(BK * 2);
    const size_t hstepB = (size_t)HALF * K * 2, hstepA = (size_t)HALF * g.lda * 2;
    const size_t tstepB = 2 * hstepB, tstepA = 2 * hstepA;
    const unsigned ldsw = (unsigned)wid * 1024u;
    const int aoff = lds_byte(wr * 64 + fr, fq * 8), boff = lds_byte(wc * 32 + fr, fq * 8);
#define PG8_SA(b, h) (((b) * 2 + (h)) * HTB)
#define PG8_SB(b, h) ((4 + (b) * 2 + (h)) * HTB)
#define PG8_STAGE(bufoff, gbase, voff) do { _Pragma("unroll") for (int _i = 0; _i < 2; ++_i) \
        __builtin_amdgcn_global_load_lds((const unsigned*)((const char*)(gbase) + (voff)[_i]), (PG8_LAS unsigned*)(lds + (bufoff) + ldsw + _i * 8192), 16, 0, 0); } while (0)
#define PG8_LDA(dst, b, h) do { _Pragma("unroll") for (int m = 0; m < 4; ++m) _Pragma("unroll") for (int k = 0; k < 2; ++k) dst[m][k] = *(const PG8_LAS bf16x8*)(lds + PG8_SA(b, h) + aoff + m * 2048 + k * 1024); } while (0)
#define PG8_LDB(dst, b, h) do { _Pragma("unroll") for (int n = 0; n < 2; ++n) _Pragma("unroll") for (int k = 0; k < 2; ++k) dst[n][k] = *(const PG8_LAS bf16x8*)(lds + PG8_SB(b, h) + boff + n * 2048 + k * 1024); } while (0)
#define PG8_MMA(ai, bj, At, Bt) do { __builtin_amdgcn_s_setprio(1); _Pragma("unroll") for (int m = 0; m < 4; ++m) _Pragma("unroll") for (int n = 0; n < 2; ++n) _Pragma("unroll") for (int k = 0; k < 2; ++k) \
        acc[ai][bj][m][n] = __builtin_amdgcn_mfma_f32_16x16x32_bf16(Bt[n][k], At[m][k], acc[ai][bj][m][n], 0, 0, 0); __builtin_amdgcn_s_setprio(0); } while (0)
#define PG8_WAIT_V(n) asm volatile("s_waitcnt vmcnt(" #n ")" ::: "memory")
#define PG8_WAIT_L(n) asm volatile("s_waitcnt lgkmcnt(" #n ")" ::: "memory")
#define PG8_BAR __builtin_amdgcn_s_barrier()
#define PG8_SCHED __builtin_amdgcn_sched_barrier(0)
    Unit cur, nxt; int ui = 0;
    if (!S.next(0, cur)) return;
    f32x4 acc[2][2][4][2];
#pragma unroll
    for (int a = 0; a < 2; ++a)
#pragma unroll
        for (int b = 0; b < 2; ++b)
#pragma unroll
            for (int m = 0; m < 4; ++m)
#pragma unroll
                for (int n = 0; n < 2; ++n) acc[a][b][m][n] = (f32x4){0.f, 0.f, 0.f, 0.f};
    bf16x8 At[4][2], B0[2][2], B1[2][2];
    const char* cA = (const char*)g.A + (size_t)cur.pm * tstepA; const char* cB = (const char*)g.Bt + (size_t)cur.pn * tstepB;
    S.a_ready(cur);
    if constexpr (SP2) {
        PG8_STAGE(PG8_SB(0, 0), cB, voffB); PG8_STAGE(PG8_SB(0, 1), cB + hstepB, voffB); PG8_STAGE(PG8_SA(0, 0), cA, voffA); PG8_STAGE(PG8_SA(0, 1), cA + hstepA, voffA);
        if (wr == 1) PG8_BAR;
        PG8_WAIT_V(2); PG8_BAR;
        PG8_STAGE(PG8_SB(1, 0), cB + kstep, voffB); PG8_STAGE(PG8_SA(1, 0), cA + kstep, voffA); PG8_STAGE(PG8_SB(1, 1), cB + hstepB + kstep, voffB);
        PG8_WAIT_V(6); PG8_BAR;
    } else {
        PG8_STAGE(PG8_SB(0, 0), cB, voffB); PG8_STAGE(PG8_SA(0, 0), cA, voffA); PG8_STAGE(PG8_SB(0, 1), cB + hstepB, voffB); PG8_STAGE(PG8_SA(0, 1), cA + hstepA, voffA);
        if (wr == 1) PG8_BAR;
        PG8_WAIT_V(4); PG8_BAR;
        PG8_STAGE(PG8_SB(1, 0), cB + kstep, voffB); PG8_STAGE(PG8_SA(1, 0), cA + kstep, voffA); PG8_STAGE(PG8_SB(1, 1), cB + hstepB + kstep, voffB);
        PG8_WAIT_V(6); PG8_BAR;
    }
    for (;;) {
        const bool has_next = S.next(ui + 1, nxt);
        const char* nA = has_next ? (const char*)g.A + (size_t)nxt.pm * tstepA : cA; const char* nB = has_next ? (const char*)g.Bt + (size_t)nxt.pn * tstepB : cB;
        for (int t = 0; t < nt; t += 2) {
            const bool last = (t == nt - 2);
            const char* a1 = cA + (size_t)(t + 1) * kstep;
            const char* a2 = last ? nA : cA + (size_t)(t + 2) * kstep; const char* b2 = last ? nB : cB + (size_t)(t + 2) * kstep;
            const char* a3 = a2 + kstep; const char* b3 = b2 + kstep;
            if (last && has_next) S.a_ready(nxt);
            if constexpr (SP2) {
            PG8_LDB(B0, 0, 0); PG8_LDB(B1, 0, 1); PG8_SCHED; PG8_LDA(At, 0, 0); PG8_STAGE(PG8_SA(1, 1), a1 + hstepA, voffA);
            PG8_WAIT_V(8); PG8_WAIT_L(0); PG8_BAR; PG8_MMA(0, 0, At, B0); PG8_MMA(0, 1, At, B1); PG8_BAR; PG8_SCHED;
            PG8_LDA(At, 0, 1); PG8_STAGE(PG8_SB(0, 0), b2, voffB); PG8_STAGE(PG8_SB(0, 1), b2 + hstepB, voffB); PG8_STAGE(PG8_SA(0, 0), a2, voffA);
            PG8_WAIT_V(8); PG8_WAIT_L(0); PG8_BAR; PG8_MMA(1, 0, At, B0); PG8_MMA(1, 1, At, B1); PG8_BAR; PG8_SCHED;
            PG8_LDB(B0, 1, 0); PG8_LDB(B1, 1, 1); PG8_SCHED; PG8_LDA(At, 1, 0); PG8_STAGE(PG8_SA(0, 1), a2 + hstepA, voffA);
            PG8_WAIT_V(8); PG8_WAIT_L(0); PG8_BAR; PG8_MMA(0, 0, At, B0); PG8_MMA(0, 1, At, B1); PG8_BAR; PG8_SCHED;
            PG8_LDA(At, 1, 1); PG8_STAGE(PG8_SB(1, 0), b3, voffB); PG8_STAGE(PG8_SB(1, 1), b3 + hstepB, voffB); PG8_STAGE(PG8_SA(1, 0), a3, voffA);
            PG8_WAIT_V(8); PG8_WAIT_L(0); PG8_BAR; PG8_MMA(1, 0, At, B0); PG8_MMA(1, 1, At, B1); PG8_BAR; PG8_SCHED;
            } else {
            PG8_LDB(B0, 0, 0); PG8_SCHED; PG8_LDA(At, 0, 0); PG8_STAGE(PG8_SA(1, 1), a1 + hstepA, voffA);
            PG8_WAIT_L(8); PG8_BAR; PG8_WAIT_L(0); PG8_MMA(0, 0, At, B0); PG8_BAR; PG8_SCHED;
            PG8_LDB(B1, 0, 1); PG8_STAGE(PG8_SB(0, 0), b2, voffB);
            PG8_BAR; PG8_WAIT_L(0); PG8_MMA(0, 1, At, B1); PG8_BAR;
            PG8_LDA(At, 0, 1); PG8_STAGE(PG8_SA(0, 0), a2, voffA);
            PG8_BAR; PG8_WAIT_L(0); PG8_MMA(1, 0, At, B0); PG8_BAR; PG8_SCHED;
            PG8_STAGE(PG8_SB(0, 1), b2 + hstepB, voffB);
            PG8_WAIT_V(6); PG8_BAR; PG8_MMA(1, 1, At, B1); PG8_BAR;
            PG8_LDB(B0, 1, 0); PG8_SCHED; PG8_LDA(At, 1, 0); PG8_STAGE(PG8_SA(0, 1), a2 + hstepA, voffA);
            PG8_WAIT_L(8); PG8_BAR; PG8_WAIT_L(0); PG8_MMA(0, 0, At, B0); PG8_BAR; PG8_SCHED;
            PG8_LDB(B1, 1, 1); PG8_STAGE(PG8_SB(1, 0), b3, voffB);
            PG8_BAR; PG8_WAIT_L(0); PG8_MMA(0, 1, At, B1); PG8_BAR;
            PG8_LDA(At, 1, 1); PG8_STAGE(PG8_SA(1, 0), a3, voffA);
            PG8_BAR; PG8_WAIT_L(0); PG8_MMA(1, 0, At, B0); PG8_BAR; PG8_SCHED;
            PG8_STAGE(PG8_SB(1, 1), b3 + hstepB, voffB);
            PG8_WAIT_V(6); PG8_BAR; PG8_MMA(1, 1, At, B1); PG8_BAR;
            }
        }
        if constexpr (ALIGN_EPI) { if (wr == 0) PG8_BAR; }
        if constexpr (!Epi::AFTER_DRAIN) { E(acc, cur, wr, wc, fr, fq); S.done(cur); }
        if (!has_next) break;
#pragma unroll
        for (int a = 0; a < 2; ++a)
#pragma unroll
            for (int b = 0; b < 2; ++b)
#pragma unroll
                for (int m = 0; m < 4; ++m)
#pragma unroll
                    for (int n = 0; n < 2; ++n) acc[a][b][m][n] = (f32x4){0.f, 0.f, 0.f, 0.f};
        cur = nxt; cA = nA; cB = nB; ++ui;
        if constexpr (ALIGN_EPI) { if (wr == 1) PG8_BAR; }
    }
    PG8_WAIT_V(0);
    if constexpr (!ALIGN_EPI) { if (wr == 0) PG8_BAR; }
    PG8_BAR;
    if constexpr (Epi::AFTER_DRAIN) { E.fused(acc, cur, wr, wc, fr, fq, lds, wid, lane); S.done(cur); }
#undef PG8_SA
#undef PG8_SB
#undef PG8_STAGE
#undef PG8_LDA
#undef PG8_LDB
#undef PG8_MMA
#undef PG8_WAIT_V
#undef PG8_WAIT_L
#undef PG8_BAR
#undef PG8_SCHED
}
}
#define EPI_ROWS_BEGIN  _Pragma("unroll") for (int ai = 0; ai < 2; ++ai) _Pragma("unroll") for (int m = 0; m < 4; ++m) { const int row = u.pm * 256 + ai * 128 + wr * 64 + m * 16 + fr;
#define EPI_ROWS_END    }
__device__ __forceinline__ u32x4 pack8(const f32x4 a, const f32x4 b) { u32x4 w; w.x = cvt_pk_bf16(a[0], a[1]); w.y = cvt_pk_bf16(a[2], a[3]); w.z = cvt_pk_bf16(b[0], b[1]); w.w = cvt_pk_bf16(b[2], b[3]); return w; }
__device__ __forceinline__ void unpack8(const u32x4 w, f32x4& a, f32x4& b) { a = (f32x4){bf_lo(w.x), bf_hi(w.x), bf_lo(w.y), bf_hi(w.y)}; b = (f32x4){bf_lo(w.z), bf_hi(w.z), bf_lo(w.w), bf_hi(w.w)}; }
__device__ __forceinline__ f32x4 sig4(const f32x4 x) { return (f32x4){sigmoidf_(x[0]), sigmoidf_(x[1]), sigmoidf_(x[2]), sigmoidf_(x[3])}; }

__device__ __forceinline__ void ssq_add(float* ssq, int row, float part, int fq) { part += __shfl_xor(part, 16); part += __shfl_xor(part, 32); if (fq == 0) atomicAdd(ssq + row, part); }
__device__ __forceinline__ float sq4(const f32x4 a) { return (a[0] * a[0] + a[1] * a[1]) + (a[2] * a[2] + a[3] * a[3]); }
template <int RS, bool SSQ> struct EpiStoreBf16 {
    static constexpr bool PERM = true, AFTER_DRAIN = false;
    bf16_t* O; int ldc; const float* rs; float* ssq;
    __device__ __forceinline__ void operator()(const f32x4 (&acc)[2][2][4][2], const pg8::Unit& u, int wr, int wc, int fr, int fq) const {
        const int col0 = u.pn * 256 + wc * 32 + 8 * fq;
        EPI_ROWS_BEGIN
            bf16_t* rowp = O + (size_t)row * ldc + col0;
            float sc = 1.f; if (RS == 1) sc = rs[row]; if (RS == 2) sc = 1.0f / sqrtf(rs[row] * (1.f / DM) + EPS);
            float part = 0.f;
#pragma unroll
            for (int bj = 0; bj < 2; ++bj) { const f32x4 v0 = acc[ai][bj][m][0] * sc, v1 = acc[ai][bj][m][1] * sc; if (SSQ) part += sq4(v0) + sq4(v1); *(u32x4*)(rowp + bj * 128) = pack8(v0, v1); }
            if (SSQ) ssq_add(ssq, row, part, fq);
        EPI_ROWS_END
    }
};
struct EpiGlu {
    static constexpr bool PERM = true, AFTER_DRAIN = false;
    const bf16_t* Z; bf16_t* O; int ldc;
    __device__ __forceinline__ void operator()(const f32x4 (&acc)[2][2][4][2], const pg8::Unit& u, int wr, int wc, int fr, int fq) const {
        const int col0 = u.pn * 256 + wc * 32 + 8 * fq;
        EPI_ROWS_BEGIN
#pragma unroll
            for (int bj = 0; bj < 2; ++bj) { const size_t o = (size_t)row * ldc + col0 + bj * 128; f32x4 z0, z1; unpack8(*(const u32x4*)(Z + o), z0, z1);
                *(u32x4*)(O + o) = pack8(z0 * sig4(acc[ai][bj][m][0]), z1 * sig4(acc[ai][bj][m][1])); }
        EPI_ROWS_END
    }
};
template <bool ADD> struct EpiGate {
    static constexpr bool PERM = true, AFTER_DRAIN = false;
    const bf16_t* Gt; int ldg; bf16_t* O; int ldc;
    __device__ __forceinline__ void operator()(const f32x4 (&acc)[2][2][4][2], const pg8::Unit& u, int wr, int wc, int fr, int fq) const {
        const int col0 = u.pn * 256 + wc * 32 + 8 * fq;
        EPI_ROWS_BEGIN
#pragma unroll
            for (int bj = 0; bj < 2; ++bj) { f32x4 g0, g1; unpack8(*(const u32x4*)(Gt + (size_t)row * ldg + col0 + bj * 128), g0, g1);
                f32x4 r0 = sig4(g0) * acc[ai][bj][m][0], r1 = sig4(g1) * acc[ai][bj][m][1]; bf16_t* op = O + (size_t)row * ldc + col0 + bj * 128;
                if (ADD) { f32x4 o0, o1; unpack8(*(const u32x4*)op, o0, o1); r0 += o0; r1 += o1; }
                *(u32x4*)op = pack8(r0, r1); }
        EPI_ROWS_END
    }
};
struct EpiResidBf {
    static constexpr bool PERM = true, AFTER_DRAIN = false;
    bf16_t* X; float* ssq;
    __device__ __forceinline__ void operator()(const f32x4 (&acc)[2][2][4][2], const pg8::Unit& u, int wr, int wc, int fr, int fq) const {
        const int col0 = u.pn * 256 + wc * 32 + 8 * fq;
        EPI_ROWS_BEGIN
            bf16_t* rowp = X + (size_t)row * DM + col0; float part = 0.f;
#pragma unroll
            for (int bj = 0; bj < 2; ++bj) { f32x4 x0, x1; unpack8(*(const u32x4*)(rowp + bj * 128), x0, x1); x0 += acc[ai][bj][m][0]; x1 += acc[ai][bj][m][1]; part += sq4(x0) + sq4(x1); *(u32x4*)(rowp + bj * 128) = pack8(x0, x1); }
            ssq_add(ssq, row, part, fq);
        EPI_ROWS_END
    }
};
struct EpiPg {
    static constexpr bool PERM = false, AFTER_DRAIN = false;
    float* out; const bf16_t* x2; const bf16_t* pr; const float* ssq2; const float* ssqp; const float* gp;
    __device__ __forceinline__ void operator()(const f32x4 (&acc)[2][2][4][2], const pg8::Unit& u, int wr, int wc, int fr, int fq) const {
        const int col0 = u.pn * 256 + wc * 32 + 4 * fq;
        f32x4 gv[2][2];
#pragma unroll
        for (int bj = 0; bj < 2; ++bj)
#pragma unroll
            for (int n = 0; n < 2; ++n) gv[bj][n] = *(const f32x4*)(gp + col0 + bj * 128 + n * 16);
        EPI_ROWS_BEGIN
            if (row < MR) { const float r2 = 1.0f / sqrtf(ssq2[row] * (1.f / DM) + EPS), rp = 1.0f / sqrtf(ssqp[row] * (1.f / DM) + EPS);
                float* o = out + (size_t)row * DM + col0; const bf16_t* p = pr + (size_t)row * DM + col0; const bf16_t* xx = x2 + (size_t)row * DM + col0;
#pragma unroll
                for (int bj = 0; bj < 2; ++bj)
#pragma unroll
                    for (int n = 0; n < 2; ++n) { const u32x2 w = *(const u32x2*)(p + bj * 128 + n * 16); const f32x4 pv = (f32x4){bf_lo(w.x), bf_hi(w.x), bf_lo(w.y), bf_hi(w.y)};
                        const u32x2 xw = *(const u32x2*)(xx + bj * 128 + n * 16); const f32x4 xv = (f32x4){bf_lo(xw.x), bf_hi(xw.x), bf_lo(xw.y), bf_hi(xw.y)};
                        *(f32x4*)(o + bj * 128 + n * 16) = xv + sig4(acc[ai][bj][m][n] * r2) * pv * gv[bj][n] * rp; } }
        EPI_ROWS_END
    }
};
#define XB_TMO      128
#define XB_XCNT(j)  (256  + 64 * (j))
#define XB_XSUB(j)  (1280 + 64 * (j))
#define XB_XGEN(j)  (2304 + 64 * (j))
#define XB_TOP      3328
#define XB_TOPGEN   3392
#define XCD_BAR_WORDS 3456
#define XB_SPIN_CAP (1u << 18)

__device__ __forceinline__ unsigned xb_ld(unsigned* p)              { return __hip_atomic_load(p, __ATOMIC_RELAXED, __HIP_MEMORY_SCOPE_AGENT); }
__device__ __forceinline__ unsigned xb_add(unsigned* p, unsigned v) { return __hip_atomic_fetch_add(p, v, __ATOMIC_RELAXED, __HIP_MEMORY_SCOPE_AGENT); }
__device__ __forceinline__ unsigned xb_xcc_id() { return (unsigned)__builtin_amdgcn_s_getreg((3 << 11) | 20) & 0xFu; }
#define XB_SPIN(cond, bar) do { unsigned _sp = 0; while (cond) { __builtin_amdgcn_s_sleep(1); \
    if ((++_sp & 255u) == 0u) { if (xb_ld(&(bar)[XB_TMO])) break; if (_sp > XB_SPIN_CAP) { atomicAdd(&(bar)[XB_TMO], 1u); break; } } } } while (0)

struct XcdBarrier {
    unsigned* bar; unsigned x;
    volatile LAS unsigned* st;
};

__device__ __forceinline__ XcdBarrier xcd_barrier_post(unsigned* bar, volatile LAS unsigned* st) {
    XcdBarrier b; b.bar = bar; b.x = xb_xcc_id(); b.st = st;
    if (threadIdx.x == 0) (void)xb_add(&bar[XB_XCNT(b.x)], 1u);
    return b;
}
__device__ __forceinline__ void xcd_barrier_complete(unsigned* bar, unsigned x, unsigned& nloc, unsigned& nx) {
    const unsigned G = gridDim.x * gridDim.y * gridDim.z;
    unsigned sum, cnt, mine, sp = 0u;
    for (;;) {
        sum = 0u; cnt = 0u; mine = 0u;
#pragma unroll
        for (unsigned j = 0; j < 16; ++j) { const unsigned c = xb_ld(&bar[XB_XCNT(j)]); sum += c; cnt += (c > 0u) ? 1u : 0u; mine = (j == x) ? c : mine; }
        if (sum == G) break;
        __builtin_amdgcn_s_sleep(1);
        if ((++sp & 255u) == 0u) { if (xb_ld(&bar[XB_TMO])) break; if (sp > XB_SPIN_CAP) { atomicAdd(&bar[XB_TMO], 1u); break; } }
    }
    nloc = mine > 0u ? mine : 1u; nx = cnt > 0u ? cnt : 1u;
}

__device__ __forceinline__ void xcd_barrier(const XcdBarrier& b) {
    asm volatile("s_waitcnt vmcnt(0)" ::: "memory");
    __syncthreads();
    if (threadIdx.x == 0) {
        unsigned* bar = b.bar;
        __builtin_amdgcn_s_waitcnt(0);
        unsigned nloc = b.st[0], nx = b.st[1];
        if (nloc == 0u) { xcd_barrier_complete(bar, b.x, nloc, nx); b.st[0] = nloc; b.st[1] = nx; }
        const unsigned old = xb_add(&bar[XB_XSUB(b.x)], 1u);
        const unsigned gen = old / nloc;
        if (old + 1u == (gen + 1u) * nloc) {
            __builtin_amdgcn_fence(__ATOMIC_RELEASE, "agent");
            asm volatile("s_waitcnt vmcnt(0)" ::: "memory");
            const unsigned og = xb_add(&bar[XB_TOP], 1u);
            const unsigned tg = og / nx;
            if (og + 1u == (tg + 1u) * nx) xb_add(&bar[XB_TOPGEN], 1u);
            else XB_SPIN(xb_ld(&bar[XB_TOPGEN]) == tg, bar);
            __builtin_amdgcn_fence(__ATOMIC_ACQUIRE, "agent");
            xb_add(&bar[XB_XGEN(b.x)], 1u);
            asm volatile("s_waitcnt vmcnt(0)" ::: "memory");
        } else {
            XB_SPIN(xb_ld(&bar[XB_XGEN(b.x)]) == gen, bar);
            __builtin_amdgcn_fence(__ATOMIC_ACQUIRE, "agent");
            asm volatile("s_waitcnt vmcnt(0)" ::: "memory");
        }
    }
    __syncthreads();
}
__device__ __forceinline__ void cexp_d(double re, double im, int k, double& ore, double& oim) {
    const double sc = 1.0 / (double)(1ull << k); const double zr = re * sc, zi = im * sc;
    double tr = 1.0, ti = 0.0, sr = 1.0, si = 0.0;
#pragma unroll 1
    for (int n = 1; n <= 12; ++n) { const double inv = 1.0 / (double)n; const double nr = (tr * zr - ti * zi) * inv, ni = (tr * zi + ti * zr) * inv; tr = nr; ti = ni; sr += tr; si += ti; }
#pragma unroll 1
    for (int i = 0; i < k; ++i) { const double nr = sr * sr - si * si, ni = 2.0 * sr * si; sr = nr; si = ni; }
    ore = sr; oim = si;
}

__device__ __forceinline__ void transpose_item(const float* __restrict__ W, int K, int N, bf16_t* __restrict__ WT, int nblk, LAS float* scr, int item, int lane, const float* __restrict__ gk = nullptr) {
    const int kb = item / nblk, nb = item % nblk, k0 = 64 * kb, n0 = 32 * nb;
    const int nn = n0 + (lane & 31); const bool ok = nn < N;
#pragma unroll 8
    for (int i = 0; i < 32; ++i) { const int kk = 2 * i + (lane >> 5); float w = ok ? W[(size_t)(k0 + kk) * N + nn] : 0.f; if (gk) w *= gk[k0 + kk]; scr[kk * 33 + (lane & 31)] = w; }
    LDS_WAIT(); asm volatile("" ::: "memory");
    const int c = lane & 7;
#pragma unroll
    for (int j = 0; j < 4; ++j) { const int n = (lane >> 3) + 8 * j; const LAS float* s = scr + (8 * c) * 33 + n;
        u32x4 o; o.x = cvt_pk_bf16(s[0 * 33], s[1 * 33]); o.y = cvt_pk_bf16(s[2 * 33], s[3 * 33]); o.z = cvt_pk_bf16(s[4 * 33], s[5 * 33]); o.w = cvt_pk_bf16(s[6 * 33], s[7 * 33]);
        *(u32x4*)(WT + (size_t)(n0 + n) * K + k0 + 8 * c) = o; }
    LDS_WAIT(); asm volatile("" ::: "memory");
}
__device__ __forceinline__ void row_to_bf16_rstd(const float* __restrict__ xrow, bf16_t* __restrict__ orow, float* __restrict__ rs, int lane) {
    const f32x4* xr = (const f32x4*)xrow + lane;
    f32x4 v[8]; float s = 0.f;
#pragma unroll
    for (int j = 0; j < 8; ++j) { v[j] = xr[64 * j]; s += (v[j].x * v[j].x + v[j].y * v[j].y) + (v[j].z * v[j].z + v[j].w * v[j].w); }
    s = wave_sum(s);
    u32x2* o8 = (u32x2*)orow + lane;
#pragma unroll
    for (int j = 0; j < 8; ++j) { u32x2 w; w.x = cvt_pk_bf16(v[j].x, v[j].y); w.y = cvt_pk_bf16(v[j].z, v[j].w); o8[64 * j] = w; }
    if (lane == 0) *rs = 1.0f / sqrtf(s * (1.f / DM) + EPS);
}
__device__ __forceinline__ void ld16bf(const bf16_t* p, float (&v)[16]) {
    const u32x4 a = *(const u32x4*)p, b = *(const u32x4*)(p + 8);
    v[0] = bf_lo(a.x); v[1] = bf_hi(a.x); v[2] = bf_lo(a.y); v[3] = bf_hi(a.y); v[4] = bf_lo(a.z); v[5] = bf_hi(a.z); v[6] = bf_lo(a.w); v[7] = bf_hi(a.w);
    v[8] = bf_lo(b.x); v[9] = bf_hi(b.x); v[10] = bf_lo(b.y); v[11] = bf_hi(b.y); v[12] = bf_lo(b.z); v[13] = bf_hi(b.z); v[14] = bf_lo(b.w); v[15] = bf_hi(b.w);
}
__device__ __forceinline__ void st16bf(bf16_t* p, const float (&v)[16]) {
    u32x4 a, b; a.x = cvt_pk_bf16(v[0], v[1]); a.y = cvt_pk_bf16(v[2], v[3]); a.z = cvt_pk_bf16(v[4], v[5]); a.w = cvt_pk_bf16(v[6], v[7]);
    b.x = cvt_pk_bf16(v[8], v[9]); b.y = cvt_pk_bf16(v[10], v[11]); b.z = cvt_pk_bf16(v[12], v[13]); b.w = cvt_pk_bf16(v[14], v[15]);
    *(u32x4*)p = a; *(u32x4*)(p + 8) = b;
}
__device__ __forceinline__ void st16f(float* p, const float (&v)[16]) {
#pragma unroll
    for (int j = 0; j < 4; ++j) *(f32x4*)(p + 4 * j) = (f32x4){v[4 * j], v[4 * j + 1], v[4 * j + 2], v[4 * j + 3]};
}
__device__ __forceinline__ void norm_rope128(float (&v)[16], int sub, const float* __restrict__ g, const float* __restrict__ rt) {
    float ss = 0.f;
#pragma unroll
    for (int e = 0; e < 16; ++e) ss += v[e] * v[e];
    ss += __shfl_xor(ss, 1); ss += __shfl_xor(ss, 2); ss += __shfl_xor(ss, 4);
    const float rstd = 1.0f / sqrtf(ss * (1.f / 128.f) + EPS);
#pragma unroll
    for (int e = 0; e < 16; ++e) v[e] = v[e] * rstd * g[sub * 16 + e];
#pragma unroll
    for (int e = 0; e < 16; ++e) { const float o = __shfl_xor(v[e], 1); const float c = rt[e], s = rt[16 + e];
        const float r0 = v[e] * c - o * s, r1 = v[e] * c + o * s;
        v[e] = sub == 0 ? r0 : (sub == 1 ? r1 : v[e]); }
}
__device__ __forceinline__ void rope64(float (&v)[16], const float* __restrict__ rt) {
#pragma unroll
    for (int i = 0; i < 8; ++i) { const float c = rt[32 + i], s = rt[40 + i]; const float x1 = v[i], x2 = v[8 + i]; v[i] = x1 * c - x2 * s; v[8 + i] = x2 * c + x1 * s; }
}
__device__ __forceinline__ void ta_row(int row, int lane, const bf16_t* __restrict__ proj, const float* __restrict__ RT, const float* __restrict__ gq, const float* __restrict__ gk,
                                       bf16_t* __restrict__ qn, bf16_t* __restrict__ kn, bf16_t* __restrict__ vb, bf16_t* __restrict__ iqr, bf16_t* __restrict__ ikr, float* __restrict__ iws, float* __restrict__ out) {
    const bf16_t* pr = proj + (size_t)row * INWP;
    const int pi = row < TP ? (row & (SEQ - 1)) : SEQ + ((row - TP) & 3);
    const float* rt = RT + pi * 48;
    const bool isp = row < TP; const int rs = isp ? row : row - TP;
    float v[16];
    ld16bf(pr + C_Q + 16 * lane, v); norm_rope128(v, lane & 7, gq, rt); st16bf(qn + (size_t)row * 1024 + 16 * lane, v);
    { const int l = lane & 15; ld16bf(pr + C_K + 16 * l, v); norm_rope128(v, l & 7, gk, rt);
      if (lane < 16) { st16bf(kn + (size_t)row * 256 + 16 * l, v); st16f(out + (isp ? O_KP : O_KS) + (size_t)rs * 256 + 16 * l, v); } }
    if (lane < 16) { ld16bf(pr + C_V + 16 * lane, v); *(u32x4*)(vb + (size_t)row * 256 + 16 * lane) = *(const u32x4*)(pr + C_V + 16 * lane); *(u32x4*)(vb + (size_t)row * 256 + 16 * lane + 8) = *(const u32x4*)(pr + C_V + 16 * lane + 8);
      st16f(out + (isp ? O_VP : O_VS) + (size_t)rs * 256 + 16 * lane, v); }
    ld16bf(pr + C_IQ + 16 * lane, v); if ((lane & 3) == 0) rope64(v, rt); st16bf(iqr + (size_t)row * 1024 + 16 * lane, v);
    if (lane < 4) { ld16bf(pr + C_IK + 16 * lane, v); if (lane == 0) rope64(v, rt); st16bf(ikr + (size_t)row * 64 + 16 * lane, v); st16f(out + (isp ? O_IKP : O_IKS) + (size_t)rs * 64 + 16 * lane, v); }
    if (lane < 16) iws[(size_t)row * 16 + lane] = bf2f(pr[C_IW + lane]) * IDX_SCALE;
}
__device__ __forceinline__ bf16x8 as_bf16x8(const u32x4 w) { return __builtin_bit_cast(bf16x8, w); }
__device__ __forceinline__ void idx_load_a(const bf16_t* __restrict__ iqr, size_t row0, int lane, bf16x8 (&a)[4]) {
    const int rho = lane & 31, h = lane >> 5; const int tok = (rho >> 2) & 1, head = (rho & 3) + 4 * (rho >> 3);
    const bf16_t* p = iqr + (row0 + tok) * 1024 + head * 64 + 8 * h;
#pragma unroll
    for (int kk = 0; kk < 4; ++kk) a[kk] = *(const bf16x8*)(p + 16 * kk);
}
__device__ __forceinline__ float idx_reduce(const f32x16& acc, const f32x4 (&wv)[4]) {
    float s = 0.f;
#pragma unroll
    for (int r = 0; r < 16; ++r) s += wv[r >> 2][r & 3] * fmaxf(acc[r], 0.f);
    return s;
}
__device__ __forceinline__ void idx_prompt_block(int b, int qb, int wave, int lane, const bf16_t* __restrict__ iqr, const bf16_t* __restrict__ ikr, const float* __restrict__ iws, float* __restrict__ sc) {
    const int h = lane >> 5, kl = lane & 31;
    bf16x8 a[4][4]; f32x4 wv[4][4]; size_t rowi[4];
#pragma unroll
    for (int i = 0; i < 4; ++i) { const size_t row0 = (size_t)b * SEQ + 64 * qb + 2 * (4 * wave + i); rowi[i] = row0 + h; idx_load_a(iqr, row0, lane, a[i]);
#pragma unroll
        for (int j = 0; j < 4; ++j) wv[i][j] = *(const f32x4*)(iws + (row0 + h) * 16 + 4 * j); }
    const int ntile = 2 * qb + 2;
    const bf16_t* kp = ikr + ((size_t)b * SEQ + kl) * 64 + 8 * h;
    bf16x8 bc[4], bn[4];
#pragma unroll
    for (int kk = 0; kk < 4; ++kk) bc[kk] = *(const bf16x8*)(kp + 16 * kk);
    for (int kt = 0; kt < ntile; ++kt) {
        if (kt + 1 < ntile) {
#pragma unroll
            for (int kk = 0; kk < 4; ++kk) bn[kk] = *(const bf16x8*)(kp + (size_t)(kt + 1) * 32 * 64 + 16 * kk); }
#pragma unroll
        for (int i = 0; i < 4; ++i) { f32x16 acc = {};
#pragma unroll
            for (int kk = 0; kk < 4; ++kk) acc = __builtin_amdgcn_mfma_f32_32x32x16_bf16(a[i][kk], bc[kk], acc, 0, 0, 0);
            sc[rowi[i] * SEQ + 32 * kt + kl] = idx_reduce(acc, wv[i]); }
#pragma unroll
        for (int kk = 0; kk < 4; ++kk) bc[kk] = bn[kk];
    }
}
__device__ __forceinline__ void idx_sample_unit(int b, int c, int wave, int lane, const bf16_t* __restrict__ iqr, const bf16_t* __restrict__ ikr, const float* __restrict__ iws,
                                                const float* __restrict__ cik, const int* __restrict__ pt, float* __restrict__ ssc) {
    const int h = lane >> 5, kl = lane & 31;
    bf16x8 a[2][4]; f32x4 wv[2][4];
#pragma unroll
    for (int i = 0; i < 2; ++i) { const size_t row0 = (size_t)TP + 4 * b + 2 * i; idx_load_a(iqr, row0, lane, a[i]);
#pragma unroll
        for (int j = 0; j < 4; ++j) wv[i][j] = *(const f32x4*)(iws + (row0 + h) * 16 + 4 * j); }
    const int pgl = 8 * c + wave; const int page = pt[b * NPG + pgl];
#pragma unroll 1
    for (int kt = 0; kt < 4; ++kt) {
        const float* p = cik + ((size_t)page * PAGE + 32 * kt + kl) * 64 + 8 * h; bf16x8 bc[4];
#pragma unroll
        for (int kk = 0; kk < 4; ++kk) { const f32x4 x0 = *(const f32x4*)(p + 16 * kk), x1 = *(const f32x4*)(p + 16 * kk + 4); bc[kk] = as_bf16x8(pack8(x0, x1)); }
#pragma unroll
        for (int i = 0; i < 2; ++i) { f32x16 acc = {};
#pragma unroll
            for (int kk = 0; kk < 4; ++kk) acc = __builtin_amdgcn_mfma_f32_32x32x16_bf16(a[i][kk], bc[kk], acc, 0, 0, 0);
            ssc[(size_t)(b * 4 + 2 * i + h) * SSTR + pgl * PAGE + 32 * kt + kl] = idx_reduce(acc, wv[i]); }
    }
    if (c == 15 && wave == 0) {
        const bf16_t* p = ikr + ((size_t)TP + 4 * b + (kl & 3)) * 64 + 8 * h; bf16x8 bc[4];
#pragma unroll
        for (int kk = 0; kk < 4; ++kk) bc[kk] = *(const bf16x8*)(p + 16 * kk);
#pragma unroll
        for (int i = 0; i < 2; ++i) { f32x16 acc = {};
#pragma unroll
            for (int kk = 0; kk < 4; ++kk) acc = __builtin_amdgcn_mfma_f32_32x32x16_bf16(a[i][kk], bc[kk], acc, 0, 0, 0);
            const float s = idx_reduce(acc, wv[i]); if (kl < 4) ssc[(size_t)(b * 4 + 2 * i + h) * SSTR + PAST + kl] = s; }
    }
}
__device__ __forceinline__ unsigned fkey(float v) { const unsigned u = __float_as_uint(v); return (u >> 31) ? ~u : (u | 0x80000000u); }
__device__ __forceinline__ void select_prompt_row(int row, int lane, const float* __restrict__ sc, u64* __restrict__ bm) {
    const int t = row & (SEQ - 1);
    u64 myword = 0ull;
    if (t < 256) {
        const int n = t + 1 - 64 * lane; myword = n >= 64 ? ~0ull : (n > 0 ? ((1ull << n) - 1ull) : 0ull);
    } else {
        unsigned key[32]; const int nreg = (t >> 6) + 1; const float* sr = sc + (size_t)row * SEQ;
#pragma unroll
        for (int j = 0; j < 32; ++j) { key[j] = 0u; if (j < nreg) { const int s = 64 * j + lane; if (s <= t) key[j] = fkey(sr[s]); } }
        unsigned T = 0u;
#pragma unroll 1
        for (int bit = 31; bit >= 0; --bit) {
            const unsigned cand = T | (1u << bit); int cnt = 0;
#pragma unroll
            for (int gq = 0; gq < 4; ++gq) if (8 * gq < nreg) {
#pragma unroll
                for (int j = 8 * gq; j < 8 * gq + 8; ++j) cnt += __popcll(__ballot(key[j] >= cand)); }
            if (cnt >= 256) { T = cand; if (cnt == 256) break; }
        }
#pragma unroll
        for (int j = 0; j < 32; ++j) { const u64 w = __ballot(key[j] >= T); if (lane == j) myword = w; }
    }
    if (lane < 32) bm[(size_t)row * 32 + lane] = myword;
}
__device__ __forceinline__ void select_sample_row(int r, int tid, int lane, int wave, const float* __restrict__ ssc, int* __restrict__ sidx, LAS unsigned* red) {
    const int L = PAST + 1 + (r & 3);
    unsigned key[33]; const float* sr = ssc + (size_t)r * SSTR;
#pragma unroll
    for (int j = 0; j < 33; ++j) { const int s = j * 512 + tid; key[j] = s < L ? fkey(sr[s]) : 0u; }
    unsigned T = 0u;
#pragma unroll 1
    for (int bit = 31; bit >= 0; --bit) {
        const unsigned cand = T | (1u << bit); int c = 0;
#pragma unroll
        for (int j = 0; j < 33; ++j) c += (key[j] >= cand) ? 1 : 0;
#pragma unroll
        for (int o = 1; o < 64; o <<= 1) c += __shfl_xor(c, o);
        LAS unsigned* buf = red + (bit & 1) * 8;
        if (lane == 0) buf[wave] = (unsigned)c;
        __syncthreads();
        int tot = 0;
#pragma unroll
        for (int w = 0; w < 8; ++w) tot += (int)buf[w];
        if (tot >= 256) { T = cand; if (tot == 256) break; }
    }
    int c = 0;
#pragma unroll
    for (int j = 0; j < 33; ++j) c += (key[j] >= T) ? 1 : 0;
    int incl = c;
#pragma unroll
    for (int o = 1; o < 64; o <<= 1) { const int v = __shfl_up(incl, o); if (lane >= o) incl += v; }
    __syncthreads();
    if (lane == 63) red[16 + wave] = (unsigned)incl;
    __syncthreads();
    int base = incl - c;
#pragma unroll
    for (int w = 0; w < 8; ++w) if (w < wave) base += (int)red[16 + w];
    int* so = sidx + r * 256;
#pragma unroll
    for (int j = 0; j < 33; ++j) if (key[j] >= T) { if (base < 256) so[base] = j * 512 + tid; ++base; }
    __syncthreads();
}
struct SsmConst { const float* abar; const float* a32; const bf16_t* bbt; const bf16_t* cmt; };
template <int MODE>
__device__ __forceinline__ void ssm_task(int set, int g, int chunk, int lane, const SsmConst sc, const bf16_t* __restrict__ proj, const float* __restrict__ dvec,
                                         f32x2* __restrict__ SE, const f32x2* __restrict__ SIN, const float* __restrict__ s0re, const float* __restrict__ s0im,
                                         bf16_t* __restrict__ zb, float* __restrict__ ore, float* __restrict__ oim) {
    const int bq = lane & 15, q = lane >> 4; const int b = set * 16 + bq;
    bf16x4 bbt[8];
#pragma unroll
    for (int j = 0; j < 8; ++j) bbt[j] = *(const bf16x4*)(sc.bbt + ((size_t)(g * 128 + 16 * j + bq)) * 16 + 4 * q);
    float ar[16], ai[16], sr[16], si[16];
#pragma unroll
    for (int m = 0; m < 16; ++m) { const f32x2 a = *(const f32x2*)(sc.abar + ((size_t)(g * 64 + 16 * q + m)) * 2); ar[m] = a.x; ai[m] = a.y; sr[m] = 0.f; si[m] = 0.f; }
    bf16x8 cmt[4]; f32x4 dv = {0.f, 0.f, 0.f, 0.f};
    if (MODE != 0) {
#pragma unroll
        for (int j = 0; j < 4; ++j) cmt[j] = *(const bf16x8*)(sc.cmt + ((size_t)(g * 16 + bq)) * 128 + 32 * j + 8 * q);
        dv = *(const f32x4*)(dvec + 16 * g + 4 * q);
    }
    size_t row0; int nstep;
    if (MODE == 2) { row0 = (size_t)TP + 4 * b; nstep = DT;
#pragma unroll
        for (int m = 0; m < 16; ++m) { sr[m] = s0re[((size_t)b * SG + g) * SN + 16 * q + m]; si[m] = s0im[((size_t)b * SG + g) * SN + 16 * q + m]; } }
    else { row0 = (size_t)b * SEQ + (size_t)chunk * SSM_L; nstep = SSM_L;
        if (MODE == 1) {
#pragma unroll
            for (int m = 0; m < 16; ++m) { const f32x2 s = SIN[(((size_t)b * SSM_NCH + chunk) * SG + g) * SN + 16 * q + m]; sr[m] = s.x; si[m] = s.y; } } }
    const bf16_t* up = proj + row0 * INWP + C_U + 16 * g + 4 * q;
    bf16x4 ucur = *(const bf16x4*)up;
#pragma unroll 1
    for (int t = 0; t < nstep; ++t) {
        bf16x4 unxt = ucur; if (t + 1 < nstep) unxt = *(const bf16x4*)(up + (size_t)(t + 1) * INWP);
        f32x4 bu[8];
#pragma unroll
        for (int j = 0; j < 8; ++j) bu[j] = __builtin_amdgcn_mfma_f32_16x16x16bf16_1k(bbt[j], ucur, (f32x4){0.f, 0.f, 0.f, 0.f}, 0, 0, 0);
#pragma unroll
        for (int jh = 0; jh < 4; ++jh)
#pragma unroll
            for (int i = 0; i < 4; ++i) { const int m = 4 * jh + i; const float nr = ar[m] * sr[m] - ai[m] * si[m] + bu[2 * jh][i], ni = ar[m] * si[m] + ai[m] * sr[m] + bu[2 * jh + 1][i]; sr[m] = nr; si[m] = ni; }
        if (MODE != 0) {
            f32x4 y = {0.f, 0.f, 0.f, 0.f};
#pragma unroll
            for (int j = 0; j < 4; ++j) { u32x4 w; w.x = cvt_pk_bf16(sr[4 * j], sr[4 * j + 1]); w.y = cvt_pk_bf16(sr[4 * j + 2], sr[4 * j + 3]); w.z = cvt_pk_bf16(si[4 * j], si[4 * j + 1]); w.w = cvt_pk_bf16(si[4 * j + 2], si[4 * j + 3]);
                y = __builtin_amdgcn_mfma_f32_16x16x32_bf16(cmt[j], as_bf16x8(w), y, 0, 0, 0); }
            const u32x2 uw = __builtin_bit_cast(u32x2, ucur);
            const f32x4 uf = (f32x4){bf_lo(uw.x), bf_hi(uw.x), bf_lo(uw.y), bf_hi(uw.y)};
            y += dv * uf;
            u32x2 zo; zo.x = cvt_pk_bf16(gelu_tanh(y[0]), gelu_tanh(y[1])); zo.y = cvt_pk_bf16(gelu_tanh(y[2]), gelu_tanh(y[3]));
            *(u32x2*)(zb + (row0 + t) * SSMW + 16 * g + 4 * q) = zo;
        }
        ucur = unxt;
    }
    if (MODE == 0) {
        f32x2* e = SE + (((size_t)b * SSM_NCH + chunk) * SG + g) * SN + 16 * q;
#pragma unroll
        for (int m = 0; m < 16; ++m) e[m] = (f32x2){sr[m], si[m]};
    }
    if (MODE == 2) {
#pragma unroll
        for (int m = 0; m < 16; ++m) { ore[((size_t)b * SG + g) * SN + 16 * q + m] = sr[m]; oim[((size_t)b * SG + g) * SN + 16 * q + m] = si[m]; }
    }
}
__device__ __forceinline__ void ssm_carry(int idx  , const float* __restrict__ a32, const f32x2* __restrict__ SE, f32x2* __restrict__ SIN, float* __restrict__ ore, float* __restrict__ oim) {
    const int b = idx >> 11, gn = idx & 2047;
    const f32x2 a = *(const f32x2*)(a32 + (size_t)gn * 2);
    float sr = 0.f, si = 0.f;
#pragma unroll 4
    for (int j = 0; j < SSM_NCH; ++j) { const size_t o = ((size_t)b * SSM_NCH + j) * (SG * SN) + gn; SIN[o] = (f32x2){sr, si}; const f32x2 e = SE[o];
        const float nr = a.x * sr - a.y * si + e.x, ni = a.x * si + a.y * sr + e.y; sr = nr; si = ni; }
    ore[(size_t)b * (SG * SN) + gn] = sr; oim[(size_t)b * (SG * SN) + gn] = si;
}
__device__ __forceinline__ void ssm_constants(int gn, const float* __restrict__ a_re, const float* __restrict__ a_im, const float* __restrict__ log_dt, const float* __restrict__ b_re, const float* __restrict__ b_im,
                                              const float* __restrict__ c_re, const float* __restrict__ c_im, unsigned char* __restrict__ ssc) {
    const int g = gn >> 6, n = gn & 63;
    double dt, dum; cexp_d((double)log_dt[g], 0.0, 10, dt, dum);
    const double lr = (double)a_re[gn], li = (double)a_im[gn];
    double abr, abi; cexp_d(lr * dt, li * dt, 10, abr, abi);
    double p32r = abr, p32i = abi;
#pragma unroll 1
    for (int i = 0; i < 5; ++i) { const double nr = p32r * p32r - p32i * p32i, ni = 2.0 * p32r * p32i; p32r = nr; p32i = ni; }
    const double den = lr * lr + li * li;
    const double fr = ((abr - 1.0) * lr + abi * li) / den, fi = (abi * lr - (abr - 1.0) * li) / den;
    float* ab = (float*)(ssc + SSC_ABAR) + (size_t)gn * 2; ab[0] = (float)abr; ab[1] = (float)abi;
    float* a3 = (float*)(ssc + SSC_A32) + (size_t)gn * 2; a3[0] = (float)p32r; a3[1] = (float)p32i;
    bf16_t* bbt = (bf16_t*)(ssc + SSC_BBT); bf16_t* cmt = (bf16_t*)(ssc + SSC_CMT);
    const int qq = n >> 4, jh = (n >> 2) & 3, i = n & 3;
#pragma unroll
    for (int ri = 0; ri < 2; ++ri) {
        const int rowl = 16 * (2 * jh + ri) + 4 * qq + i;
        const int kap = 32 * jh + 8 * qq + 4 * ri + i;
#pragma unroll 1
        for (int c = 0; c < 16; ++c) {
            const double br = (double)b_re[(size_t)gn * 16 + c], bi = (double)b_im[(size_t)gn * 16 + c];
            const double v = ri == 0 ? (fr * br - fi * bi) : (fr * bi + fi * br);
            bbt[((size_t)g * 128 + rowl) * 16 + c] = (bf16_t)(cvt_pk_bf16((float)v, 0.f) & 0xffffu);
            const float cv = ri == 0 ? c_re[((size_t)g * 16 + c) * 64 + n] : -c_im[((size_t)g * 16 + c) * 64 + n];
            cmt[((size_t)g * 16 + c) * 128 + kap] = (bf16_t)(cvt_pk_bf16(cv, 0.f) & 0xffffu);
        }
    }
}
namespace att {
constexpr int D = 128, NW = 8, QBLK = 32, KVBLK = 64, QB = NW * QBLK;
constexpr int SHM_V = KVBLK * D * 2, SHM_K = KVBLK * D * 2;
constexpr int LDS_BYTES_ATT = 2 * SHM_V + 2 * SHM_K + NW * 64 * 4;
constexpr int QS = 1024, KS = 256;
constexpr float SCALE = 0.08838834764831845f, THR = 8.f;
#define KSWZ(row, colB) ((row) * 256 + ((colB) ^ (((row) & 7) << 4)))
#define SBAR() __builtin_amdgcn_sched_barrier(0)
__device__ __forceinline__ int v_st(int k, int c) { const int kk = (k & ~0xC) | ((k & 4) << 1) | ((k & 8) >> 1); return ((kk >> 3) * 4 + (c >> 5)) * 512 + ((kk & 7) * 32 + (c & 31)) * 2; }
__device__ __forceinline__ int v_rd_base(int lane) { return ((lane & 3) << 3) | (((lane >> 2) & 3) << 6) | (((lane >> 4) & 1) << 5) | (((lane >> 5) & 1) << 8); }
constexpr int v_rd_off(int d0, int ks, int half) { return d0 * 512 + ks * 4096 + half * 2048; }
__device__ __forceinline__ int crow(int r, int hi) { return (r & 3) + 8 * (r >> 2) + 4 * hi; }
__device__ __forceinline__ bf16x8 load8(const bf16_t* p) { return *reinterpret_cast<const bf16x8*>(p); }
__device__ __forceinline__ void mask_bits(f32x16& p0, f32x16& p1, u64 w, int hi) {
    const float NEG = -__builtin_inff();
    const unsigned lo = (unsigned)w >> (4 * hi), hh = (unsigned)(w >> 32) >> (4 * hi);
#pragma unroll
    for (int r = 0; r < 16; ++r) {
        const int c = (r & 3) + 8 * (r >> 2);
        if (!((lo >> c) & 1u)) p0[r] = NEG;
        if (!((hh >> c) & 1u)) p1[r] = NEG;
    }
}
__device__ __forceinline__ void partialSM(f32x16& p0, f32x16& p1, float& m_reg, float& mn, float& alpha) {
    float pmax = p0[0]; for (int r = 1; r < 16; ++r) pmax = fmaxf(pmax, p0[r]); for (int r = 0; r < 16; ++r) pmax = fmaxf(pmax, p1[r]);
    { auto rr = __builtin_amdgcn_permlane32_swap(__float_as_uint(pmax), __float_as_uint(pmax), false, false);
      pmax = fmaxf(__uint_as_float(rr[0]), __uint_as_float(rr[1])); }
    constexpr float C2 = 1.4426950408889634f * SCALE;
    if (__builtin_expect(__all((pmax - m_reg) * SCALE <= THR), 1)) { mn = m_reg; alpha = 1.f; }
    else { mn = fmaxf(m_reg, pmax); alpha = __builtin_amdgcn_exp2f((m_reg - mn) * C2); m_reg = mn; }
    const float mnL = -mn * C2;
    for (int r = 0; r < 16; ++r) p0[r] = fmaf(p0[r], C2, mnL); for (int r = 0; r < 16; ++r) p1[r] = fmaf(p1[r], C2, mnL);
    for (int r = 0; r < 16; ++r) p0[r] = __builtin_amdgcn_exp2f(p0[r]);
}
__device__ __forceinline__ void finishSM(f32x16& p0, f32x16& p1, float alpha, float& l_reg, bf16x8& pa0, bf16x8& pa1, bf16x8& pa2, bf16x8& pa3) {
    for (int r = 0; r < 16; ++r) p1[r] = __builtin_amdgcn_exp2f(p1[r]);
    float ps = 0; for (int r = 0; r < 16; ++r) ps += p0[r]; for (int r = 0; r < 16; ++r) ps += p1[r];
    { auto rr = __builtin_amdgcn_permlane32_swap(__float_as_uint(ps), __float_as_uint(ps), false, false);
      ps = __uint_as_float(rr[0]) + __uint_as_float(rr[1]); }
    l_reg = l_reg * alpha + ps;
#define PK4(P, B_, OUT) do { unsigned a0 = cvt_pk_bf16(P[B_+0], P[B_+1]), a1 = cvt_pk_bf16(P[B_+2], P[B_+3]);                          \
        unsigned b0 = cvt_pk_bf16(P[B_+4], P[B_+5]), b1 = cvt_pk_bf16(P[B_+6], P[B_+7]);                                             \
        auto r0 = __builtin_amdgcn_permlane32_swap(a0, b0, false, false); auto r1 = __builtin_amdgcn_permlane32_swap(a1, b1, false, false); \
        u32x4 w = {r0[0], r1[0], r0[1], r1[1]}; OUT = *reinterpret_cast<bf16x8*>(&w); } while (0)
    PK4(p0, 0, pa0); PK4(p0, 8, pa1); PK4(p1, 0, pa2); PK4(p1, 8, pa3);
#undef PK4
}
template <int KB>
__device__ __forceinline__ void qkt(f32x16& p0, f32x16& p1, const char* K_lds, int r32, int hi, const bf16x8* qr) {
    p0 = f32x16{}; p1 = f32x16{};
    const char* kb[4];
#pragma unroll
    for (int dd = 0; dd < 4; ++dd) kb[dd] = K_lds + KB * SHM_K + KSWZ(r32, (dd * 16 + hi * 8) * 2);
#pragma unroll
    for (int d0 = 0; d0 < 8; ++d0) { const char* a = kb[d0 & 3] + (d0 >> 2) * 128;
        bf16x8 b0 = *reinterpret_cast<const bf16x8*>(a);
        bf16x8 b1 = *reinterpret_cast<const bf16x8*>(a + 32 * 256);
        p0 = __builtin_amdgcn_mfma_f32_32x32x16_bf16(b0, qr[d0], p0, 0, 0, 0);
        p1 = __builtin_amdgcn_mfma_f32_32x32x16_bf16(b1, qr[d0], p1, 0, 0, 0); }
}
typedef short s16x4 __attribute__((ext_vector_type(4)));
template <int VB>
__device__ __forceinline__ void pv_tile(f32x16* o, int vb0, bf16x8 pa0, bf16x8 pa1, bf16x8 pa2, bf16x8 pa3) {
#define TRRD(dst, off) asm volatile("ds_read_b64_tr_b16 %0, %1 offset:%2" : "=&v"(dst) : "v"(vb0), "i"(off) : "memory")
#define PV_D0(d0) do { s16x4 l0, l1, l2, l3, h0, h1, h2, h3; constexpr int b_ = VB * SHM_V + v_rd_off(d0, 0, 0); \
        TRRD(l0, b_); TRRD(h0, b_ + 2048); TRRD(l1, b_ + 4096); TRRD(h1, b_ + 6144); TRRD(l2, b_ + 8192); TRRD(h2, b_ + 10240); TRRD(l3, b_ + 12288); TRRD(h3, b_ + 14336); \
        asm volatile("s_waitcnt lgkmcnt(0)" ::: "memory"); SBAR();   \
        o[d0] = __builtin_amdgcn_mfma_f32_32x32x16_bf16(pa0, (bf16x8){l0[0], l0[1], l0[2], l0[3], h0[0], h0[1], h0[2], h0[3]}, o[d0], 0, 0, 0);   \
        o[d0] = __builtin_amdgcn_mfma_f32_32x32x16_bf16(pa1, (bf16x8){l1[0], l1[1], l1[2], l1[3], h1[0], h1[1], h1[2], h1[3]}, o[d0], 0, 0, 0);   \
        o[d0] = __builtin_amdgcn_mfma_f32_32x32x16_bf16(pa2, (bf16x8){l2[0], l2[1], l2[2], l2[3], h2[0], h2[1], h2[2], h2[3]}, o[d0], 0, 0, 0);   \
        o[d0] = __builtin_amdgcn_mfma_f32_32x32x16_bf16(pa3, (bf16x8){l3[0], l3[1], l3[2], l3[3], h3[0], h3[1], h3[2], h3[3]}, o[d0], 0, 0, 0); } while (0)
    PV_D0(0); PV_D0(1); PV_D0(2); PV_D0(3);
#undef PV_D0
#undef TRRD
}
struct BlockRef { const bf16_t* Q; const bf16_t* K; const bf16_t* V; bf16_t* O; const u64* MB; int P0; };
struct Seam { bf16x8 qr[8]; bf16x8 st_v0, st_v1, st_k0, st_k1; };
#define ROWK(p, k0, rr) ((p) + (size_t)((k0) + (rr)) * KS + sc)
#define VMW() asm volatile("s_waitcnt vmcnt(0)" ::: "memory")
#define VMWN(n) asm volatile("s_waitcnt vmcnt(%0)" :: "i"(n) : "memory")
#define SLOAD_H(Kp, Vp, k0) do { S.st_v0 = load8(ROWK(Vp, k0, sr)); S.st_v1 = load8(ROWK(Vp, k0, 32 + sr));              \
                         S.st_k0 = load8(ROWK(Kp, k0, sr)); S.st_k1 = load8(ROWK(Kp, k0, 32 + sr)); } while (0)
#define SWRITE_HK(bf) do { *(bf16x8*)(K_lds + (bf) * SHM_K + kws) = S.st_k0; *(bf16x8*)(K_lds + (bf) * SHM_K + kws + 32 * 256) = S.st_k1; } while (0)
#define SWRITE_HV(bf) do { *(bf16x8*)(V_lds + (bf) * SHM_V + vst0) = S.st_v0; *(bf16x8*)(V_lds + (bf) * SHM_V + vst1) = S.st_v1; } while (0)
#define SWRITE_H(bf) do { SWRITE_HV(bf); SWRITE_HK(bf); } while (0)
__device__ __forceinline__ void attn_prime(const BlockRef& cur, char* lds, Seam& S) {
    const int tid = threadIdx.x, wid = __builtin_amdgcn_readfirstlane(tid >> 6), lane = tid & 63, r32 = lane & 31, hi = lane >> 5;
    const int sr = tid >> 4, sc = (tid & 15) * 8, kws = KSWZ(sr, sc * 2); char* K_lds = lds + 2 * SHM_V;
    for (int d0 = 0; d0 < 8; ++d0) S.qr[d0] = load8(cur.Q + (size_t)(wid * QBLK + r32) * QS + d0 * 16 + hi * 8);
    SLOAD_H(cur.K, cur.V, 0); VMW(); SWRITE_HK(0);
    __syncthreads();
}
__device__ __forceinline__ void attn_block(const BlockRef& cur, const BlockRef& nxt, char* lds, Seam& S) {
    const int tid = threadIdx.x, wid = __builtin_amdgcn_readfirstlane(tid >> 6), lane = tid & 63, r32 = lane & 31, hi = lane >> 5;
    const int NT = cur.P0 / KVBLK + QB / KVBLK;
    char* V_lds = lds; char* K_lds = lds + 2 * SHM_V;
    float* ws = (float*)(lds + 2 * SHM_V + 2 * SHM_K) + wid * 64; float* li_l = ws, * al_l = ws + 32;
    float m_reg = -1e30f, l_reg = 0; f32x16 o[4] = {};
    const int sr = tid >> 4, sc = (tid & 15) * 8, vst0 = v_st(sr, sc), vst1 = v_st(32 + sr, sc), kws = KSWZ(sr, sc * 2);
    const int vb0 = (int)(uintptr_t)V_lds + v_rd_base(lane);
    const bf16_t* Kh = cur.K; const bf16_t* Vh = cur.V;
    const u64* mrow = cur.MB + (size_t)(wid * QBLK + r32) * 32;
    u64 mw;
#define RESC(a) do { if (__any((a) < 1.f)) { if (hi == 0) al_l[r32] = (a); asm volatile("s_waitcnt lgkmcnt(0)" ::: "memory");              \
                     for (int d_ = 0; d_ < 4; ++d_) for (int r = 0; r < 16; ++r) o[d_][r] *= al_l[crow(r, hi)]; } } while (0)
#define KBASE(t) ((t) * KVBLK)
    constexpr int NQL = 8;
#define SEAM_K0() do { VMWN(NQL); SWRITE_HK(0); SBAR(); } while (0)
    f32x16 pA0, pA1, pB0, pB1; float mnA, mnB, alA, alB; bf16x8 pa0, pa1, pa2, pa3;
    SWRITE_HV(0); SBAR();
    if (NT > 1) { SLOAD_H(Kh, Vh, KBASE(1)); }
    mw = mrow[0];
    SBAR(); qkt<0>(pA0, pA1, K_lds, r32, hi, S.qr);
    mask_bits(pA0, pA1, mw, hi); partialSM(pA0, pA1, m_reg, mnA, alA);
    if (NT > 1) { VMW(); SWRITE_H(1); }
    __syncthreads();
#define HALF_STEP(PX0, PX1, mnX, alX, PY0, PY1, alY, t, KB, VB, SB) do {                                                      \
        SBAR(); mw = mrow[(t)]; qkt<KB>(PX0, PX1, K_lds, r32, hi, S.qr);                                             \
        finishSM(PY0, PY1, alY, l_reg, pa0, pa1, pa2, pa3); SBAR();                                                           \
        if ((t) + 1 < NT) { SLOAD_H(Kh, Vh, KBASE((t) + 1)); SBAR(); }                                               \
        pv_tile<VB>(o, vb0, pa0, pa1, pa2, pa3); mask_bits(PX0, PX1, mw, hi); partialSM(PX0, PX1, m_reg, mnX, alX);                                        \
        __syncthreads();                                                                                                      \
        if ((t) + 1 < NT) { VMW(); SWRITE_H(SB); }                                                                          \
        RESC(alX); __syncthreads(); } while (0)
    for (int t = 1; t + 1 < NT; t += 2) {
        HALF_STEP(pB0, pB1, mnB, alB, pA0, pA1, alA, t, 1, 0, 0);
        HALF_STEP(pA0, pA1, mnA, alA, pB0, pB1, alB, t + 1, 0, 1, 1);
    }
    SBAR(); mw = mrow[NT - 1]; qkt<1>(pB0, pB1, K_lds, r32, hi, S.qr); SBAR();
    SLOAD_H(nxt.K, nxt.V, 0); SBAR();
#pragma unroll
    for (int d0 = 0; d0 < 8; ++d0) S.qr[d0] = load8(nxt.Q + (size_t)(wid * QBLK + r32) * QS + d0 * 16 + hi * 8);
    SBAR();
    finishSM(pA0, pA1, alA, l_reg, pa0, pa1, pa2, pa3); SBAR();
    pv_tile<0>(o, vb0, pa0, pa1, pa2, pa3);
    mask_bits(pB0, pB1, mw, hi); partialSM(pB0, pB1, m_reg, mnB, alB); __syncthreads(); RESC(alB);
    finishSM(pB0, pB1, alB, l_reg, pa0, pa1, pa2, pa3); SBAR(); pv_tile<1>(o, vb0, pa0, pa1, pa2, pa3);
    SBAR(); SEAM_K0();
    if (hi == 0) li_l[r32] = l_reg; asm volatile("s_waitcnt lgkmcnt(0)" ::: "memory");
    float rli[16];
#pragma unroll
    for (int r = 0; r < 16; ++r) rli[r] = __builtin_amdgcn_rcpf(li_l[crow(r, hi)]);
    bf16_t* Ow = cur.O + (size_t)(wid * QBLK) * QS;
#pragma unroll
    for (int r = 0; r < 16; ++r) { const int orow = crow(r, hi);
#pragma unroll
        for (int d0 = 0; d0 < 4; ++d0) { const float v = o[d0][r] * rli[r];
            const float vn = __shfl_xor(v, 1);
            if ((r32 & 1) == 0) *(unsigned*)(Ow + (size_t)orow * QS + d0 * 32 + r32) = cvt_pk_bf16(v, vn); } }
    __syncthreads();
#undef RESC
#undef KBASE
#undef SEAM_K0
#undef HALF_STEP
}
#undef ROWK
#undef VMW
#undef VMWN
#undef SLOAD_H
#undef SWRITE_HK
#undef SWRITE_HV
#undef SWRITE_H
#undef KSWZ
}
__device__ __forceinline__ void sample_attn_unit(int u, int tid, int lane, int wave, LAS unsigned char* lds, const bf16_t* __restrict__ qn, const int* __restrict__ sidx, const int* __restrict__ pt,
                                                 const float* __restrict__ ck, const float* __restrict__ cv, const float* __restrict__ out, bf16_t* __restrict__ oatt) {
    const int b = u >> 3, t = (u >> 1) & 3, kvh = u & 1; const size_t row = (size_t)TP + 4 * b + t;
    LAS unsigned char* kv = lds; LAS int* lidx = (LAS int*)(lds + 69632); LAS float* lq = (LAS float*)(lds + 70656); LAS float* lp = (LAS float*)(lds + 72704);
    LAS float* lred = (LAS float*)(lds + 76800); LAS float* lo2 = (LAS float*)(lds + 77056);
    if (tid < 256) lidx[tid] = sidx[(b * 4 + t) * 256 + tid];
    lq[tid] = bf2f(qn[row * 1024 + kvh * 512 + tid]);
    __syncthreads();
#pragma unroll 4
    for (int kk = 0; kk < 32; ++kk) { const int key = wave * 32 + kk; const int idx = lidx[key];
        const float* src = idx < PAST ? ck + (((size_t)pt[b * NPG + (idx >> 7)] * PAGE + (idx & 127)) * 2 + kvh) * 128 : out + O_KS + ((size_t)(b * 4 + idx - PAST) * 2 + kvh) * 128;
        const f32x2 v = *(const f32x2*)(src + 2 * lane); *(LAS unsigned*)(kv + key * 272 + 4 * lane) = cvt_pk_bf16(v.x, v.y); }
    __syncthreads();
    const int key = tid & 255, hp = tid >> 8;
    float s0 = 0.f, s1 = 0.f;
    { const LAS unsigned char* kr = kv + key * 272; const LAS float* q0 = lq + (2 * hp) * 128; const LAS float* q1 = q0 + 128;
#pragma unroll
      for (int c = 0; c < 16; ++c) { const u32x4 w = *(const LAS u32x4*)(kr + 16 * c); f32x4 a, bb; unpack8(w, a, bb);
          const f32x4 qa = *(const LAS f32x4*)(q0 + 8 * c), qb = *(const LAS f32x4*)(q0 + 8 * c + 4), ra = *(const LAS f32x4*)(q1 + 8 * c), rb = *(const LAS f32x4*)(q1 + 8 * c + 4);
          s0 += (a[0] * qa[0] + a[1] * qa[1]) + (a[2] * qa[2] + a[3] * qa[3]) + (bb[0] * qb[0] + bb[1] * qb[1]) + (bb[2] * qb[2] + bb[3] * qb[3]);
          s1 += (a[0] * ra[0] + a[1] * ra[1]) + (a[2] * ra[2] + a[3] * ra[3]) + (bb[0] * rb[0] + bb[1] * rb[1]) + (bb[2] * rb[2] + bb[3] * rb[3]); } }
    s0 *= 0.08838834764831845f; s1 *= 0.08838834764831845f;
    float m0 = s0, m1 = s1;
#pragma unroll
    for (int o = 1; o < 64; o <<= 1) { m0 = fmaxf(m0, __shfl_xor(m0, o)); m1 = fmaxf(m1, __shfl_xor(m1, o)); }
    if (lane == 0) { lred[wave * 2] = m0; lred[wave * 2 + 1] = m1; }
    __syncthreads();
    { const int w0 = hp * 4; m0 = fmaxf(fmaxf(lred[w0 * 2], lred[w0 * 2 + 2]), fmaxf(lred[w0 * 2 + 4], lred[w0 * 2 + 6])); m1 = fmaxf(fmaxf(lred[w0 * 2 + 1], lred[w0 * 2 + 3]), fmaxf(lred[w0 * 2 + 5], lred[w0 * 2 + 7])); }
    const float p0 = __expf(s0 - m0), p1 = __expf(s1 - m1);
    lp[(2 * hp) * 256 + key] = p0; lp[(2 * hp + 1) * 256 + key] = p1;
    const float t0 = wave_sum(p0), t1 = wave_sum(p1);
    if (lane == 0) { lred[16 + wave * 2] = t0; lred[16 + wave * 2 + 1] = t1; }
    __syncthreads();
#pragma unroll 4
    for (int kk = 0; kk < 32; ++kk) { const int ky = wave * 32 + kk; const int idx = lidx[ky];
        const float* src = idx < PAST ? cv + (((size_t)pt[b * NPG + (idx >> 7)] * PAGE + (idx & 127)) * 2 + kvh) * 128 : out + O_VS + ((size_t)(b * 4 + idx - PAST) * 2 + kvh) * 128;
        const f32x2 v = *(const f32x2*)(src + 2 * lane); *(LAS unsigned*)(kv + ky * 256 + 4 * lane) = cvt_pk_bf16(v.x, v.y); }
    __syncthreads();
    const int dp = lane, head = wave & 3, kh = wave >> 2;
    float o0 = 0.f, o1 = 0.f;
#pragma unroll 8
    for (int k = kh * 128; k < kh * 128 + 128; ++k) { const unsigned w = *(const LAS unsigned*)(kv + k * 256 + 4 * dp); const float p = lp[head * 256 + k]; o0 += p * bf_lo(w); o1 += p * bf_hi(w); }
    if (kh == 1) { lo2[head * 128 + 2 * dp] = o0; lo2[head * 128 + 2 * dp + 1] = o1; }
    __syncthreads();
    if (kh == 0) { const int hq = head >> 1, hb = head & 1; const int w0 = hq * 4;
        const float sum = (lred[16 + w0 * 2 + hb] + lred[16 + w0 * 2 + 2 + hb]) + (lred[16 + w0 * 2 + 4 + hb] + lred[16 + w0 * 2 + 6 + hb]);
        const float inv = 1.0f / sum; o0 = (o0 + lo2[head * 128 + 2 * dp]) * inv; o1 = (o1 + lo2[head * 128 + 2 * dp + 1]) * inv;
        *(unsigned*)(oatt + row * 1024 + (kvh * 4 + head) * 128 + 2 * dp) = cvt_pk_bf16(o0, o1); }
    __syncthreads();
}
__device__ __forceinline__ void ld8bf(const bf16_t* p, float (&v)[8]) { const u32x4 a = *(const u32x4*)p; v[0] = bf_lo(a.x); v[1] = bf_hi(a.x); v[2] = bf_lo(a.y); v[3] = bf_hi(a.y); v[4] = bf_lo(a.z); v[5] = bf_hi(a.z); v[6] = bf_lo(a.w); v[7] = bf_hi(a.w); }
__device__ __forceinline__ void ld8f(const float* p, float (&v)[8]) { const f32x4 a = *(const f32x4*)p, b = *(const f32x4*)(p + 4); v[0] = a.x; v[1] = a.y; v[2] = a.z; v[3] = a.w; v[4] = b.x; v[5] = b.y; v[6] = b.z; v[7] = b.w; }
__device__ __forceinline__ void st8f(float* p, const float (&v)[8]) { *(f32x4*)p = (f32x4){v[0], v[1], v[2], v[3]}; *(f32x4*)(p + 4) = (f32x4){v[4], v[5], v[6], v[7]}; }
__device__ __forceinline__ void conv_item(int rblk, int cg, int lane, const bf16_t* __restrict__ up, bf16_t* __restrict__ act, const float* __restrict__ cw, const float* __restrict__ cb,
                                          const float* __restrict__ sconv, float* __restrict__ out) {
    const int col = 512 * cg + 8 * lane; if (col >= DFF) return;
    float wg[3][8], wv[3][8], bg[8], bv[8], g2[8], g1[8], v2[8], v1[8];
#pragma unroll
    for (int j = 0; j < 3; ++j) { ld8f(cw + (size_t)j * DFF2 + col, wg[j]); ld8f(cw + (size_t)j * DFF2 + DFF + col, wv[j]); }
    ld8f(cb + col, bg); ld8f(cb + DFF + col, bv);
    size_t row0; int nrows; int tbase; int b; const bool samp = rblk >= 512;
    if (!samp) { b = rblk >> 5; tbase = (rblk & 31) * 64; row0 = (size_t)b * SEQ + tbase; nrows = 64;
        if (tbase == 0) {
#pragma unroll
            for (int e = 0; e < 8; ++e) { g2[e] = 0.f; g1[e] = 0.f; v2[e] = 0.f; v1[e] = 0.f; } }
        else { ld8bf(up + (row0 - 2) * DFF2 + col, g2); ld8bf(up + (row0 - 1) * DFF2 + col, g1); ld8bf(up + (row0 - 2) * DFF2 + DFF + col, v2); ld8bf(up + (row0 - 1) * DFF2 + DFF + col, v1); } }
    else { b = rblk - 512; tbase = 0; row0 = (size_t)TP + 4 * b; nrows = 4;
        ld8f(sconv + ((size_t)b * 2 + 0) * DFF2 + col, g2); ld8f(sconv + ((size_t)b * 2 + 1) * DFF2 + col, g1); ld8f(sconv + ((size_t)b * 2 + 0) * DFF2 + DFF + col, v2); ld8f(sconv + ((size_t)b * 2 + 1) * DFF2 + DFF + col, v1); }
#pragma unroll 2
    for (int r = 0; r < nrows; ++r) {
        float gc[8], vc[8], a[8];
        ld8bf(up + (row0 + r) * DFF2 + col, gc); ld8bf(up + (row0 + r) * DFF2 + DFF + col, vc);
#pragma unroll
        for (int e = 0; e < 8; ++e) { const float cgt = wg[0][e] * g2[e] + wg[1][e] * g1[e] + wg[2][e] * gc[e] + bg[e]; const float cvl = wv[0][e] * v2[e] + wv[1][e] * v1[e] + wv[2][e] * vc[e] + bv[e]; a[e] = gelu_tanh(cgt) * cvl; }
        u32x4 w; w.x = cvt_pk_bf16(a[0], a[1]); w.y = cvt_pk_bf16(a[2], a[3]); w.z = cvt_pk_bf16(a[4], a[5]); w.w = cvt_pk_bf16(a[6], a[7]);
        *(u32x4*)(act + (row0 + r) * DFF + col) = w;
        const int t = tbase + r;
        if (!samp && t >= SEQ - 2) { float* o = out + O_CVP + ((size_t)b * 2 + (t - (SEQ - 2))) * DFF2; st8f(o + col, gc); st8f(o + DFF + col, vc); }
        if (samp && t >= DT - 2) { float* o = out + O_CVS + ((size_t)b * 2 + (t - (DT - 2))) * DFF2; st8f(o + col, gc); st8f(o + DFF + col, vc); }
#pragma unroll
        for (int e = 0; e < 8; ++e) { g2[e] = g1[e]; g1[e] = gc[e]; v2[e] = v1[e]; v1[e] = vc[e]; }
    }
}
constexpr int NPH = 13;
#ifndef MK_REP
#define MK_REP {1,1,1,1,1,1,1,1,1,1,1,1,1}
#endif
__device__ constexpr int kRep[NPH] = MK_REP;
#ifndef MK_N_LAUNCHES
#define MK_N_LAUNCHES 1
#endif
struct Args { const void* in[36]; float* out; unsigned char* ws; int ph_lo, ph_hi, bar_region, pad; };

__global__ void __launch_bounds__(NWAVES * 64, 2) fwd(Args args) {
    extern __shared__ __attribute__((aligned(16))) unsigned char lds_raw[];
    LAS unsigned char* lds = (LAS unsigned char*)lds_raw;
    const int tid = threadIdx.x, lane = tid & 63, wave = __builtin_amdgcn_readfirstlane(tid >> 6);
    const int G = gridDim.x; const int bx = blockIdx.x; const int vcu = (G % 8 == 0) ? (bx % 8) * (G / 8) + bx / 8 : bx;
    const int gw = vcu * NWAVES + wave, NGW = G * NWAVES;
    unsigned char* ws = args.ws; float* out = args.out;
    const float* x_p = (const float*)args.in[0]; const float* x_s = (const float*)args.in[1];
    const float* cache_k = (const float*)args.in[2]; const float* cache_v = (const float*)args.in[3]; const float* cache_ik = (const float*)args.in[4];
    const float* st_re = (const float*)args.in[5]; const float* st_im = (const float*)args.in[6]; const float* st_conv = (const float*)args.in[7];
    const int* ptab = (const int*)args.in[8]; const float* p_p = (const float*)args.in[9]; const float* p_s = (const float*)args.in[10];
    const float* g_mix = (const float*)args.in[11]; const float* w_in = (const float*)args.in[12]; const float* g_q = (const float*)args.in[13]; const float* g_k = (const float*)args.in[14];
    const float* a_re = (const float*)args.in[15]; const float* a_im = (const float*)args.in[16]; const float* log_dt = (const float*)args.in[17];
    const float* sb_re = (const float*)args.in[18]; const float* sb_im = (const float*)args.in[19]; const float* sc_re = (const float*)args.in[20]; const float* sc_im = (const float*)args.in[21];
    const float* ssm_d = (const float*)args.in[22]; const float* w_glu = (const float*)args.in[23]; const float* w_att = (const float*)args.in[24]; const float* w_ssm = (const float*)args.in[25];
    const float* w_o = (const float*)args.in[26]; const float* g_ffn = (const float*)args.in[27]; const float* w_up = (const float*)args.in[28]; const float* conv_w = (const float*)args.in[29];
    const float* conv_b = (const float*)args.in[30]; const float* w_down = (const float*)args.in[31]; const float* w_ple = (const float*)args.in[32]; const float* g_ple = (const float*)args.in[33];
    const float* g_pg = (const float*)args.in[34]; const float* w_pg = (const float*)args.in[35];
    float* RT = (float*)(ws + WS_RT); unsigned char* SSC = ws + WS_SSC;
    bf16_t* WIN = (bf16_t*)(ws + WS_WIN); bf16_t* WGLU = (bf16_t*)(ws + WS_WGLU); bf16_t* WATT = (bf16_t*)(ws + WS_WATT); bf16_t* WSSM = (bf16_t*)(ws + WS_WSSM); bf16_t* WO = (bf16_t*)(ws + WS_WO);
    bf16_t* WUP = (bf16_t*)(ws + WS_WUP); bf16_t* WDN = (bf16_t*)(ws + WS_WDN); bf16_t* WPLE = (bf16_t*)(ws + WS_WPLE); bf16_t* WPG = (bf16_t*)(ws + WS_WPG);
    bf16_t* H = (bf16_t*)(ws + WS_H); bf16_t* PBF = (bf16_t*)(ws + WS_PBF); bf16_t* PLER = (bf16_t*)(ws + WS_PLER); float* RS0 = (float*)(ws + WS_RSP); float* SSQ1 = (float*)(ws + WS_RSP + 262144); float* SSQ2 = (float*)(ws + WS_RSP + 524288); float* SSQP = (float*)(ws + WS_RSP + 786432);
    bf16_t* PROJ = (bf16_t*)(ws + WS_PROJ); bf16_t* QN = (bf16_t*)(ws + WS_QN); bf16_t* KN = (bf16_t*)(ws + WS_KN); bf16_t* VB = (bf16_t*)(ws + WS_VB); bf16_t* IQ = (bf16_t*)(ws + WS_IQ);
    bf16_t* IKR = (bf16_t*)(ws + WS_IKR); float* IW = (float*)(ws + WS_IW); float* SC = (float*)(ws + WS_SC); float* SSC2 = (float*)(ws + WS_SSC2); u64* BMK = (u64*)(ws + WS_BM); int* SIDX = (int*)(ws + WS_SIDX);
    bf16_t* OATT = (bf16_t*)(ws + WS_OATT); bf16_t* Z = (bf16_t*)(ws + WS_Z); bf16_t* Z2 = (bf16_t*)(ws + WS_Z2); f32x2* SE = (f32x2*)(ws + WS_SE); f32x2* SIN = (f32x2*)(ws + WS_SIN);
    bf16_t* MRG = (bf16_t*)(ws + WS_MRG); bf16_t* UP = (bf16_t*)(ws + WS_UP); bf16_t* ACT = (bf16_t*)(ws + WS_ACT);

    for (int u = tid; u < (LDS_BYTES - LDSCTL_OFF) / 4; u += NWAVES * 64) ((LAS unsigned*)(lds + LDSCTL_OFF))[u] = 0u;
    __syncthreads();
    const int lo = args.ph_lo, hi = args.ph_hi;
    XcdBarrier bar; bar.bar = (unsigned*)(ws + WS_CTL) + CW_BAR + args.bar_region * XCD_BAR_WORDS; bar.x = 0; bar.st = nullptr;
    if (hi - lo > 1) bar = xcd_barrier_post((unsigned*)(ws + WS_CTL) + CW_BAR + args.bar_region * XCD_BAR_WORDS, (volatile LAS unsigned*)(lds + MISC_OFF) + 8);
#define IN(k) (lo <= (k) && (k) < hi)
#define SEAM(k) do { if (IN(k) && IN((k) + 1)) xcd_barrier(bar); } while (0)
#define XROW(m) ((m) < TP ? x_p + (size_t)(m) * DM : x_s + (size_t)((m) - TP) * DM)
    const SsmConst sscn{(const float*)(SSC + SSC_ABAR), (const float*)(SSC + SSC_A32), (const bf16_t*)(SSC + SSC_BBT), (const bf16_t*)(SSC + SSC_CMT)};

    if (IN(0)) for (int rep_ = 0; rep_ < kRep[0]; ++rep_) {
        LAS float* scr = (LAS float*)(lds + wave * 16384);
        constexpr int I0 = (DM / 64) * (INWP / 32), I1 = (512 / 64) * (512 / 32), I2 = (1024 / 64) * (DM / 32), I3 = (512 / 64) * (DM / 32), I4 = (DM / 64) * (DM / 32),
                      I5 = (DM / 64) * (DFF2 / 32), I6 = (DFF / 64) * (DM / 32), I7 = (PLE / 64) * (DM / 32), I8 = (DM / 64) * (DM / 32);
        constexpr int NITEMS = I0 + I1 + I2 + I3 + I4 + I5 + I6 + I7 + I8;
        for (int it = gw; it < NITEMS; it += NGW) {
            int r = it;
            if (r < I0) { transpose_item(w_in, DM, INW, WIN, INWP / 32, scr, r, lane, g_mix); continue; } r -= I0;
            if (r < I1) { transpose_item(w_glu, 512, 512, WGLU, 512 / 32, scr, r, lane); continue; } r -= I1;
            if (r < I2) { transpose_item(w_att, 1024, DM, WATT, DM / 32, scr, r, lane); continue; } r -= I2;
            if (r < I3) { transpose_item(w_ssm, 512, DM, WSSM, DM / 32, scr, r, lane); continue; } r -= I3;
            if (r < I4) { transpose_item(w_o, DM, DM, WO, DM / 32, scr, r, lane); continue; } r -= I4;
            if (r < I5) { transpose_item(w_up, DM, DFF2, WUP, DFF2 / 32, scr, r, lane, g_ffn); continue; } r -= I5;
            if (r < I6) { transpose_item(w_down, DFF, DM, WDN, DM / 32, scr, r, lane); continue; } r -= I6;
            if (r < I7) { transpose_item(w_ple, PLE, DM, WPLE, DM / 32, scr, r, lane); continue; } r -= I7;
            transpose_item(w_pg, DM, DM, WPG, DM / 32, scr, r, lane, g_pg);
        }
        for (int m = gw; m < MR; m += NGW) {
            row_to_bf16_rstd(XROW(m), H + (size_t)m * DM, RS0 + m, lane);
            const float* pr = m < TP ? p_p + (size_t)m * PLE : p_s + (size_t)(m - TP) * PLE;
            const f32x4 v = *((const f32x4*)pr + lane); u32x2 w; w.x = cvt_pk_bf16(v.x, v.y); w.y = cvt_pk_bf16(v.z, v.w); *((u32x2*)(PBF + (size_t)m * PLE) + lane) = w;
        }
        for (int e = gw * 64 + lane; e < (SEQ + DT) * 24; e += NGW * 64) {
            const int pi = e / 24, i = e % 24; const double pos = pi < SEQ ? (double)pi : (double)(PAST + pi - SEQ);
            const double ex = i < 16 ? (double)i / 16.0 : (double)(i - 16) / 8.0; double inv, dum; cexp_d(-ex * 13.122363377404328, 0.0, 10, inv, dum);
            double c, s; cexp_d(0.0, pos * inv, 20, c, s);
            if (i < 16) { RT[pi * 48 + i] = (float)c; RT[pi * 48 + 16 + i] = (float)s; } else { RT[pi * 48 + 32 + (i - 16)] = (float)c; RT[pi * 48 + 40 + (i - 16)] = (float)s; }
        }
        for (int m = gw * 64 + lane; m < MP; m += NGW * 64) { SSQ1[m] = 0.f; SSQ2[m] = 0.f; SSQP[m] = 0.f; }
        for (int gn = gw * 64 + lane; gn < SG * SN; gn += NGW * 64) ssm_constants(gn, a_re, a_im, log_dt, sb_re, sb_im, sc_re, sc_im, SSC);
    }
    SEAM(0);
    if (IN(1)) for (int rep_ = 0; rep_ < kRep[1]; ++rep_) {
        { pg8::Gemm g{H, WIN, MP, INWP, DM, DM}; pg8::StaticOrder S; S.init(MP, INWP, G, bx); EpiStoreBf16<1, false> E{PROJ, INWP, RS0, nullptr};
          pg8::gemm_phase<EpiStoreBf16<1, false>, pg8::StaticOrder, true, true>(lds, g, S, E); }
        { pg8::Gemm g{PBF, WPLE, MP, DM, PLE, PLE}; pg8::StaticOrder S; S.init(MP, DM, G, bx); EpiStoreBf16<0, true> E{PLER, DM, nullptr, SSQP};
          pg8::gemm_phase<EpiStoreBf16<0, true>, pg8::StaticOrder, true, true>(lds, g, S, E); }
    }
    SEAM(1);
    if (IN(2)) for (int rep_ = 0; rep_ < kRep[2]; ++rep_) {
        for (int task = gw; task < SSM_NCH * SG; task += NGW) ssm_task<0>(0, task & 31, task >> 5, lane, sscn, PROJ, ssm_d, SE, SIN, nullptr, nullptr, Z, nullptr, nullptr);
        for (int row = gw; row < MR; row += NGW) ta_row(row, lane, PROJ, RT, g_q, g_k, QN, KN, VB, IQ, IKR, IW, out);
    }
    SEAM(2);
    if (IN(3)) for (int rep_ = 0; rep_ < kRep[3]; ++rep_) {
        for (int u = vcu; u < 256; u += G) { const int b = u >> 4, y = u & 15; idx_prompt_block(b, y, wave, lane, IQ, IKR, IW, SC); idx_prompt_block(b, 31 - y, wave, lane, IQ, IKR, IW, SC); }
        for (int u = vcu; u < 512; u += G) idx_sample_unit(u >> 4, u & 15, wave, lane, IQ, IKR, IW, cache_ik, ptab, SSC2);
        for (int idx = gw * 64 + lane; idx < NB * SG * SN; idx += NGW * 64) ssm_carry(idx, sscn.a32, SE, SIN, out + O_SRP, out + O_SIP);
    }
    SEAM(3);
    if (IN(4)) for (int rep_ = 0; rep_ < kRep[4]; ++rep_) {
        for (int r = vcu; r < TS; r += G) select_sample_row(r, tid, lane, wave, SSC2, SIDX, (LAS unsigned*)lds);
        for (int k = gw; k < TP; k += NGW) { const int b = k >> 11, t0 = k & (SEQ - 1); const int t = (b & 1) ? (SEQ - 1 - t0) : t0; select_prompt_row(__builtin_amdgcn_readfirstlane(b * SEQ + t), lane, SC, BMK); }
        for (int task = gw; task < SSM_NCH * SG + 2 * SG; task += NGW) {
            if (task < SSM_NCH * SG) ssm_task<1>(0, task & 31, task >> 5, lane, sscn, PROJ, ssm_d, SE, SIN, nullptr, nullptr, Z, nullptr, nullptr);
            else { const int k = task - SSM_NCH * SG; ssm_task<2>(k >> 5, k & 31, 0, lane, sscn, PROJ, ssm_d, SE, SIN, st_re, st_im, Z, out + O_SRS, out + O_SIS); }
        }
    }
    SEAM(4);
    if (IN(5)) for (int rep_ = 0; rep_ < kRep[5]; ++rep_) {
        {
            const int total = NB * NH * 4;
            auto mkref = [&](int L, int pass) { const int gq = L & 3, y = (L >> 2) & 3, kvh = (L >> 4) & 1, b = L >> 5; const int h = kvh * 4 + gq, qb = pass ? 7 - y : y;
                att::BlockRef r; const size_t q0 = ((size_t)b * SEQ + (size_t)qb * 256) * 1024 + h * 128;
                r.Q = QN + q0; r.O = OATT + q0; r.K = KN + (size_t)b * SEQ * 256 + kvh * 128; r.V = VB + (size_t)b * SEQ * 256 + kvh * 128; r.MB = BMK + ((size_t)b * SEQ + (size_t)qb * 256) * 32; r.P0 = qb * 256; return r; };
            int L = vcu;
            if (L < total) {
                int pass = 0; att::BlockRef cur = mkref(L, 0); att::Seam S;
                att::attn_prime(cur, (char*)lds_raw, S);
                for (;;) {
                    const bool more_pass = pass == 0, more_item = L + G < total, last = !more_pass && !more_item;
                    int passn = pass + 1, Ln = L; if (!more_pass) { passn = 0; Ln = more_item ? L + G : L; }
                    const att::BlockRef nxt = last ? cur : mkref(Ln, passn);
                    att::attn_block(cur, nxt, (char*)lds_raw, S);
                    if (last) break;
                    cur = nxt; pass = passn; L = Ln;
                }
            }
            VM_WAIT(); __syncthreads();
        }
        for (int u = vcu; u < 256; u += G) sample_attn_unit(u, tid, lane, wave, lds, QN, SIDX, ptab, cache_k, cache_v, out, OATT);
        { pg8::Gemm g{Z, WGLU, MP, 512, 512, 512}; pg8::StaticOrder S; S.init(MP, 512, G, bx); EpiGlu E{Z, Z2, 512};
          pg8::gemm_phase<EpiGlu, pg8::StaticOrder, true, true>(lds, g, S, E); }
    }
    SEAM(5);
    if (IN(6)) for (int rep_ = 0; rep_ < kRep[6]; ++rep_) { pg8::Gemm g{OATT, WATT, MP, DM, 1024, 1024}; pg8::StaticOrder S; S.init(MP, DM, G, bx); EpiGate<false> E{PROJ + C_GA, INWP, MRG, DM};
        pg8::gemm_phase<EpiGate<false>, pg8::StaticOrder, true, true>(lds, g, S, E); }
    SEAM(6);
    if (IN(7)) { pg8::Gemm g{Z2, WSSM, MP, DM, 512, 512}; pg8::StaticOrder S; S.init(MP, DM, G, bx); EpiGate<true> E{PROJ + C_GS, INWP, MRG, DM};
        pg8::gemm_phase<EpiGate<true>, pg8::StaticOrder, true, true>(lds, g, S, E); }
    SEAM(7);
    if (IN(8)) for (int rep_ = 0; rep_ < kRep[8]; ++rep_) { pg8::Gemm g{MRG, WO, MP, DM, DM, DM}; pg8::StaticOrder S; S.init(MP, DM, G, bx); EpiResidBf E{H, SSQ1};
        pg8::gemm_phase<EpiResidBf, pg8::StaticOrder, true, true>(lds, g, S, E); }
    SEAM(8);
    if (IN(9)) for (int rep_ = 0; rep_ < kRep[9]; ++rep_) { pg8::Gemm g{H, WUP, MP, DFF2, DM, DM}; pg8::StaticOrder S; S.init(MP, DFF2, G, bx); EpiStoreBf16<2, false> E{UP, DFF2, SSQ1, nullptr};
        pg8::gemm_phase<EpiStoreBf16<2, false>, pg8::StaticOrder, true, true>(lds, g, S, E); }
    SEAM(9);
    if (IN(10)) for (int rep_ = 0; rep_ < kRep[10]; ++rep_) { for (int it = gw; it < (512 + DB) * 11; it += NGW) conv_item(it / 11, it % 11, lane, UP, ACT, conv_w, conv_b, st_conv, out); }
    SEAM(10);
    if (IN(11)) { pg8::Gemm g{ACT, WDN, MP, DM, DFF, DFF}; pg8::StaticOrder S; S.init(MP, DM, G, bx); EpiResidBf E{H, SSQ2};
        pg8::gemm_phase<EpiResidBf, pg8::StaticOrder, true, true>(lds, g, S, E); }
    SEAM(11);
    if (IN(12)) { pg8::Gemm g{H, WPG, MP, DM, DM, DM}; pg8::StaticOrder S; S.init(MP, DM, G, bx); EpiPg E{out + O_Y, H, PLER, SSQ2, SSQP, g_ple};
        pg8::gemm_phase<EpiPg, pg8::StaticOrder, true, true>(lds, g, S, E); }
#undef IN
#undef SEAM
#undef XROW
}

extern "C" void kernel_launch(void* const* d_in, const int* in_sizes, int n_in, void* d_out, int out_size, void* d_ws, size_t ws_size, hipStream_t stream) {
    static int grid = 0;
    if (grid == 0) {
        if (n_in != 36 || out_size != (int)O_END || ws_size < WS_END) { fprintf(stderr, "kernel_launch: unexpected shapes (n_in %d, out %d, ws %zu; want 36, %zu, >= %zu)\n", n_in, out_size, ws_size, (size_t)O_END, (size_t)WS_END); grid = -1; return; }
        int dev = 0, cus = 0, per_cu = 0;
        if (hipGetDevice(&dev) != hipSuccess || hipDeviceGetAttribute(&cus, hipDeviceAttributeMultiprocessorCount, dev) != hipSuccess) { grid = -1; return; }
        if (hipFuncSetAttribute((const void*)fwd, hipFuncAttributeMaxDynamicSharedMemorySize, LDS_BYTES) != hipSuccess) { fprintf(stderr, "kernel_launch: hipFuncSetAttribute failed\n"); grid = -1; return; }
        if (hipOccupancyMaxActiveBlocksPerMultiprocessor(&per_cu, (const void*)fwd, NWAVES * 64, LDS_BYTES) != hipSuccess || per_cu < 1) fprintf(stderr, "kernel_launch: occupancy query reports %d\n", per_cu);
        (void)hipGetLastError();
        grid = cus;
    }
    if (grid < 0) return;
    if (hipMemsetAsync((char*)d_ws + WS_CTL, 0, CTL_ZERO_BYTES, stream) != hipSuccess) return;
    Args a{};
    for (int i = 0; i < 36; ++i) a.in[i] = d_in[i];
    a.out = (float*)d_out; a.ws = (unsigned char*)d_ws;
    const int nl = MK_N_LAUNCHES;
    for (int li = 0; li < nl; ++li) {
        a.ph_lo = (NPH * li) / nl; a.ph_hi = (NPH * (li + 1)) / nl; a.bar_region = li; a.pad = 0;
        hipLaunchKernelGGL(fwd, dim3(grid), dim3(NWAVES * 64), LDS_BYTES, stream, a);
    }
}
```

```cpp
#include <hip/hip_runtime.h>
#include <cstdio>
#include <cstdint>

#define LAS __attribute__((address_space(3)))
#define GAS __attribute__((address_space(1)))
typedef unsigned short bf16_t;
typedef short bf16x8 __attribute__((ext_vector_type(8)));
typedef short bf16x4 __attribute__((ext_vector_type(4)));
typedef float f32x4 __attribute__((ext_vector_type(4)));
typedef float f32x2 __attribute__((ext_vector_type(2)));
typedef float f32x16 __attribute__((ext_vector_type(16)));
typedef unsigned u32x4 __attribute__((ext_vector_type(4)));
typedef unsigned u32x2 __attribute__((ext_vector_type(2)));
typedef unsigned long long u64;

constexpr int DM = 2048, NB = 16, SEQ = 2048, DB = 32, DT = 4, PAST = 16384, PAGE = 128, NPG = 128;
constexpr int TP = NB * SEQ, TS = DB * DT, MR = TP + TS, MP = 33024;
constexpr int NH = 8, NKV = 2, HD = 128, IH = 16, IDD = 64;
constexpr int SSMW = 512, SG = 32, SN = 64;
constexpr int DFF = 5504, DFF2 = 11008, PLE = 256;
constexpr int INW = 7248, INWP = 7424;
constexpr int C_Q = 0, C_K = 1024, C_V = 1280, C_IQ = 1536, C_IK = 2560, C_IW = 2624, C_U = 2640, C_GA = 3152, C_GS = 5200;
constexpr float EPS = 1e-6f, IDX_SCALE = 0.03125f;
constexpr int SSM_L = 32, SSM_NCH = SEQ / SSM_L;
constexpr int SLEN = PAST + DT, SSTR = 16400;

constexpr size_t O_Y = 0;
constexpr size_t O_KP = (size_t)MR * DM;
constexpr size_t O_VP = O_KP + (size_t)TP * 256;
constexpr size_t O_IKP = O_VP + (size_t)TP * 256;
constexpr size_t O_SRP = O_IKP + (size_t)TP * 64;
constexpr size_t O_SIP = O_SRP + (size_t)NB * SG * SN;
constexpr size_t O_CVP = O_SIP + (size_t)NB * SG * SN;
constexpr size_t O_KS = O_CVP + (size_t)NB * 2 * DFF2;
constexpr size_t O_VS = O_KS + (size_t)TS * 256;
constexpr size_t O_IKS = O_VS + (size_t)TS * 256;
constexpr size_t O_SRS = O_IKS + (size_t)TS * 64;
constexpr size_t O_SIS = O_SRS + (size_t)DB * SG * SN;
constexpr size_t O_CVS = O_SIS + (size_t)DB * SG * SN;
constexpr size_t O_END = O_CVS + (size_t)DB * 2 * DFF2;
static_assert(O_END == 87572480, "output size");

constexpr size_t MiB = 1u << 20;
constexpr size_t al(size_t x) { return (x + MiB - 1) & ~(MiB - 1); }
constexpr size_t WS_CTL = 0, CTL_ZERO_BYTES = MiB;
constexpr size_t WS_RT = WS_CTL + MiB;
constexpr size_t WS_SSC = WS_RT + MiB;
constexpr size_t WS_WIN = WS_SSC + MiB;
constexpr size_t WS_WGLU = WS_WIN + al((size_t)INWP * DM * 2);
constexpr size_t WS_WATT = WS_WGLU + al((size_t)512 * 512 * 2);
constexpr size_t WS_WSSM = WS_WATT + al((size_t)DM * 1024 * 2);
constexpr size_t WS_WO = WS_WSSM + al((size_t)DM * 512 * 2);
constexpr size_t WS_WUP = WS_WO + al((size_t)DM * DM * 2);
constexpr size_t WS_WDN = WS_WUP + al((size_t)DFF2 * DM * 2);
constexpr size_t WS_WPLE = WS_WDN + al((size_t)DM * DFF * 2);
constexpr size_t WS_WPG = WS_WPLE + al((size_t)DM * PLE * 2);
constexpr size_t WS_H = WS_WPG + al((size_t)DM * DM * 2);
constexpr size_t WS_PBF = WS_H + al((size_t)MP * DM * 2);
constexpr size_t WS_PLER = WS_PBF + al((size_t)MP * PLE * 2);
constexpr size_t WS_RSP = WS_PLER + al((size_t)MP * DM * 2);
constexpr size_t WS_A0 = WS_RSP + MiB;
constexpr size_t WS_PROJ = WS_A0;
constexpr size_t WS_QN = WS_PROJ + al((size_t)MP * INWP * 2);
constexpr size_t WS_KN = WS_QN + al((size_t)MP * 1024 * 2);
constexpr size_t WS_VB = WS_KN + al((size_t)MP * 256 * 2);
constexpr size_t WS_IQ = WS_VB + al((size_t)MP * 256 * 2);
constexpr size_t WS_IKR = WS_IQ + al((size_t)MP * 1024 * 2);
constexpr size_t WS_IW = WS_IKR + al((size_t)MP * 64 * 2);
constexpr size_t WS_SC = WS_IW + al((size_t)MP * 16 * 4);
constexpr size_t WS_SSC2 = WS_SC + al((size_t)NB * SEQ * SEQ * 4);
constexpr size_t WS_BM = WS_SSC2 + al((size_t)TS * SSTR * 4);
constexpr size_t WS_SIDX = WS_BM + al((size_t)TP * 32 * 8);
constexpr size_t WS_OATT = WS_SIDX + MiB;
constexpr size_t WS_Z = WS_OATT + al((size_t)MP * 1024 * 2);
constexpr size_t WS_Z2 = WS_Z + al((size_t)MP * 512 * 2);
constexpr size_t WS_SE = WS_Z2 + al((size_t)MP * 512 * 2);
constexpr size_t WS_SIN = WS_SE + al((size_t)NB * SSM_NCH * SG * SN * 8);
constexpr size_t WS_MRG = WS_SIN + al((size_t)NB * SSM_NCH * SG * SN * 8);
constexpr size_t WS_A_END = WS_MRG + al((size_t)MP * DM * 2);
constexpr size_t WS_UP = WS_A0;
constexpr size_t WS_ACT = WS_UP + al((size_t)MP * DFF2 * 2);
constexpr size_t WS_B_END = WS_ACT + al((size_t)MP * DFF * 2);
constexpr size_t WS_END = WS_A_END > WS_B_END ? WS_A_END : WS_B_END;
static_assert(WS_END < (size_t)2600 * MiB, "d_ws map too large");
constexpr size_t SSC_ABAR = 0, SSC_A32 = 16384, SSC_BBT = 32768, SSC_CMT = 32768 + 131072, SSC_END = SSC_CMT + 131072;
static_assert(SSC_END <= MiB, "ssc");
constexpr int CW_BAR = 4096;

constexpr int RING_BYTES = 131072;
constexpr int LDSCTL_OFF = RING_BYTES, MISC_OFF = LDSCTL_OFF + 320;
constexpr int LDS_BYTES = 147456;
constexpr int NWAVES = 8;

__device__ __forceinline__ unsigned cvt_pk_bf16(float lo, float hi) { unsigned r; asm volatile("v_cvt_pk_bf16_f32 %0, %1, %2" : "=v"(r) : "v"(lo), "v"(hi)); return r; }
__device__ __forceinline__ float bf_lo(unsigned w) { return __uint_as_float(w << 16); }
__device__ __forceinline__ float bf_hi(unsigned w) { return __uint_as_float(w & 0xffff0000u); }
__device__ __forceinline__ float bf2f(bf16_t x) { return __uint_as_float(((unsigned)x) << 16); }
__device__ __forceinline__ float sigmoidf_(float x) { return __builtin_amdgcn_rcpf(1.0f + __expf(-x)); }
__device__ __forceinline__ float gelu_tanh(float y) { const float t = 1.5957691216057308f * (y + 0.044715f * y * y * y); return y * __builtin_amdgcn_rcpf(1.0f + __expf(-t)); }
__device__ __forceinline__ float wave_sum(float v) {
#pragma unroll
    for (int o = 1; o < 64; o <<= 1) v += __shfl_xor(v, o);
    return v;
}
#define LDS_WAIT() asm volatile("s_waitcnt lgkmcnt(0)" ::: "memory")
#define VM_WAIT() asm volatile("s_waitcnt vmcnt(0)" ::: "memory")
namespace pg8 {
#define PG8_LAS __attribute__((address_space(3)))
constexpr int BM = 256, BK = 64, HALF = 128, HTB = HALF * BK * 2  , STAGE_BYTES = 8 * HTB, NXCD = 8, WGM = 8;

__host__ __device__ __forceinline__ int lds_byte(int r, int c) { const int st = (r >> 4) * 2 + (c >> 5), rr = r & 15, cc = c & 31, ob = rr * 64 + cc * 2; return st * 1024 + (ob ^ (((ob >> 9) & 1) << 5)); }
__host__ __device__ __forceinline__ void stage_rc(int b, int& R, int& C) { const int st = b / 1024, sb = b % 1024, swz = sb ^ (((sb >> 9) & 1) << 5); R = (st >> 1) * 16 + swz / 64; C = (st & 1) * 32 + (swz % 64) / 2; }
__host__ __device__ __forceinline__ int perm32(int rho) { const int n = rho >> 4, i = rho & 15; return 8 * (i >> 2) + 4 * n + (i & 3); }

struct Unit { int pm, pn; };
struct Gemm { const bf16_t* A; const bf16_t* Bt; int M, N, K, lda; };

struct StaticOrder {
    int nM, nN, nwg, G, c;
    __host__ __device__ void init(int M, int N, int G_, int c_) { nM = M / BM; nN = N / BM; nwg = nM * nN; G = G_; c = c_; }
    __host__ __device__ bool next(int i, Unit& u) const {
        const long L = (long)i * G + c; if (L >= nwg) return false;
        int wgid = (int)L; { const int q = nwg / NXCD, r = nwg % NXCD, xcd = wgid % NXCD, off = wgid / NXCD; wgid = (xcd < r ? xcd * (q + 1) : r * (q + 1) + (xcd - r) * q) + off; }
        const int nig = WGM * nN, gid = wgid / nig, fm = gid * WGM, gsz = (nM - fm) < WGM ? (nM - fm) : WGM;
        u.pm = fm + ((wgid % nig) % gsz); u.pn = (wgid % nig) / gsz; return true;
    }
    __device__ __forceinline__ void a_ready(const Unit&) const {}
    __device__ __forceinline__ void done(const Unit&) const {}
};
template <class Epi, class Sched, bool ALIGN_EPI = false, bool SP2 = false>
__device__ __forceinline__ void gemm_phase(PG8_LAS unsigned char* lds, const Gemm g, const Sched& S, const Epi& E) {
    const int tid = threadIdx.x, wid = __builtin_amdgcn_readfirstlane(tid >> 6), lane = tid & 63, wr = wid >> 2, wc = wid & 3, fr = lane & 15, fq = lane >> 4;
    const int K = g.K, nt = K / BK;
    unsigned voffA[2], voffB[2];
#pragma unroll
    for (int i = 0; i < 2; ++i) { int R, C; stage_rc(tid * 16 + i * 8192, R, C); const int Rb = Epi::PERM ? ((R & ~31) + perm32(R & 31)) : R;
        voffA[i] = (unsigned)(R * g.lda + C) * 2u; voffB[i] = (unsigned)(Rb * K + C) * 2u; }
    const size_t kstep = (size_t)(BK * 2);
    const size_t hstepB = (size_t)HALF * K * 2, hstepA = (size_t)HALF * g.lda * 2;
    const size_t tstepB = 2 * hstepB, tstepA = 2 * hstepA;
    const unsigned ldsw = (unsigned)wid * 1024u;
    const int aoff = lds_byte(wr * 64 + fr, fq * 8), boff = lds_byte(wc * 32 + fr, fq * 8);
#define PG8_SA(b, h) (((b) * 2 + (h)) * HTB)
#define PG8_SB(b, h) ((4 + (b) * 2 + (h)) * HTB)
#define PG8_STAGE(bufoff, gbase, voff) do { _Pragma("unroll") for (int _i = 0; _i < 2; ++_i) \
        __builtin_amdgcn_global_load_lds((const unsigned*)((const char*)(gbase) + (voff)[_i]), (PG8_LAS unsigned*)(lds + (bufoff) + ldsw + _i * 8192), 16, 0, 0); } while (0)
#define PG8_LDA(dst, b, h) do { _Pragma("unroll") for (int m = 0; m < 4; ++m) _Pragma("unroll") for (int k = 0; k < 2; ++k) dst[m][k] = *(const PG8_LAS bf16x8*)(lds + PG8_SA(b, h) + aoff + m * 2048 + k * 1024); } while (0)
#define PG8_LDB(dst, b, h) do { _Pragma("unroll") for (int n = 0; n < 2; ++n) _Pragma("unroll") for (int k = 0; k < 2; ++k) dst[n][k] = *(const PG8_LAS bf16x8*)(lds + PG8_SB(b, h) + boff + n * 2048 + k * 1024); } while (0)
#define PG8_MMA(ai, bj, At, Bt) do { __builtin_amdgcn_s_setprio(1); _Pragma("unroll") for (int m = 0; m < 4; ++m) _Pragma("unroll") for (int n = 0; n < 2; ++n) _Pragma("unroll") for (int k = 0; k < 2; ++k) \
        acc[ai][bj][m][n] = __builtin_amdgcn_mfma_f32_16x16x32_bf16(Bt[n][k], At[m][k], acc[ai][bj][m][n], 0, 0, 0); __builtin_amdgcn_s_setprio(0); } while (0)
#define PG8_WAIT_V(n) asm volatile("s_waitcnt vmcnt(" #n ")" ::: "memory")
#define PG8_WAIT_L(n) asm volatile("s_waitcnt lgkmcnt(" #n ")" ::: "memory")
#define PG8_BAR __builtin_amdgcn_s_barrier()
#define PG8_SCHED __builtin_amdgcn_sched_barrier(0)
    Unit cur, nxt; int ui = 0;
    if (!S.next(0, cur)) return;
    f32x4 acc[2][2][4][2];
#pragma unroll
    for (int a = 0; a < 2; ++a)
#pragma unroll
        for (int b = 0; b < 2; ++b)
#pragma unroll
            for (int m = 0; m < 4; ++m)
#pragma unroll
                for (int n = 0; n < 2; ++n) acc[a][b][m][n] = (f32x4){0.f, 0.f, 0.f, 0.f};
    bf16x8 At[4][2], B0[2][2], B1[2][2];
    const char* cA = (const char*)g.A + (size_t)cur.pm * tstepA; const char* cB = (const char*)g.Bt + (size_t)cur.pn * tstepB;
    S.a_ready(cur);
    if constexpr (SP2) {
        PG8_STAGE(PG8_SB(0, 0), cB, voffB); PG8_STAGE(PG8_SB(0, 1), cB + hstepB, voffB); PG8_STAGE(PG8_SA(0, 0), cA, voffA); PG8_STAGE(PG8_SA(0, 1), cA + hstepA, voffA);
        if (wr == 1) PG8_BAR;
        PG8_WAIT_V(2); PG8_BAR;
        PG8_STAGE(PG8_SB(1, 0), cB + kstep, voffB); PG8_STAGE(PG8_SA(1, 0), cA + kstep, voffA); PG8_STAGE(PG8_SB(1, 1), cB + hstepB + kstep, voffB);
        PG8_WAIT_V(6); PG8_BAR;
    } else {
        PG8_STAGE(PG8_SB(0, 0), cB, voffB); PG8_STAGE(PG8_SA(0, 0), cA, voffA); PG8_STAGE(PG8_SB(0, 1), cB + hstepB, voffB); PG8_STAGE(PG8_SA(0, 1), cA + hstepA, voffA);
        if (wr == 1) PG8_BAR;
        PG8_WAIT_V(4); PG8_BAR;
        PG8_STAGE(PG8_SB(1, 0), cB + kstep, voffB); PG8_STAGE(PG8_SA(1, 0), cA + kstep, voffA); PG8_STAGE(PG8_SB(1, 1), cB + hstepB + kstep, voffB);
        PG8_WAIT_V(6); PG8_BAR;
    }
    for (;;) {
        const bool has_next = S.next(ui + 1, nxt);
        const char* nA = has_next ? (const char*)g.A + (size_t)nxt.pm * tstepA : cA; const char* nB = has_next ? (const char*)g.Bt + (size_t)nxt.pn * tstepB : cB;
        for (int t = 0; t < nt; t += 2) {
            const bool last = (t == nt - 2);
            const char* a1 = cA + (size_t)(t + 1) * kstep;
            const char* a2 = last ? nA : cA + (size_t)(t + 2) * kstep; const char* b2 = last ? nB : cB + (size_t)(t + 2) * kstep;
            const char* a3 = a2 + kstep; const char* b3 = b2 + kstep;
            if (last && has_next) S.a_ready(nxt);
            if constexpr (SP2) {
            PG8_LDB(B0, 0, 0); PG8_LDB(B1, 0, 1); PG8_SCHED; PG8_LDA(At, 0, 0); PG8_STAGE(PG8_SA(1, 1), a1 + hstepA, voffA);
            PG8_WAIT_V(8); PG8_WAIT_L(0); PG8_BAR; PG8_MMA(0, 0, At, B0); PG8_MMA(0, 1, At, B1); PG8_BAR; PG8_SCHED;
            PG8_LDA(At, 0, 1); PG8_STAGE(PG8_SB(0, 0), b2, voffB); PG8_STAGE(PG8_SB(0, 1), b2 + hstepB, voffB); PG8_STAGE(PG8_SA(0, 0), a2, voffA);
            PG8_WAIT_V(8); PG8_WAIT_L(0); PG8_BAR; PG8_MMA(1, 0, At, B0); PG8_MMA(1, 1, At, B1); PG8_BAR; PG8_SCHED;
            PG8_LDB(B0, 1, 0); PG8_LDB(B1, 1, 1); PG8_SCHED; PG8_LDA(At, 1, 0); PG8_STAGE(PG8_SA(0, 1), a2 + hstepA, voffA);
            PG8_WAIT_V(8); PG8_WAIT_L(0); PG8_BAR; PG8_MMA(0, 0, At, B0); PG8_MMA(0, 1, At, B1); PG8_BAR; PG8_SCHED;
            PG8_LDA(At, 1, 1); PG8_STAGE(PG8_SB(1, 0), b3, voffB); PG8_STAGE(PG8_SB(1, 1), b3 + hstepB, voffB); PG8_STAGE(PG8_SA(1, 0), a3, voffA);
            PG8_WAIT_V(8); PG8_WAIT_L(0); PG8_BAR; PG8_MMA(1, 0, At, B0); PG8_MMA(1, 1, At, B1); PG8_BAR; PG8_SCHED;
            } else {
            PG8_LDB(B0, 0, 0); PG8_SCHED; PG8_LDA(At, 0, 0); PG8_STAGE(PG8_SA(1, 1), a1 + hstepA, voffA);
            PG8_WAIT_L(8); PG8_BAR; PG8_WAIT_L(0); PG8_MMA(0, 0, At, B0); PG8_BAR; PG8_SCHED;
            PG8_LDB(B1, 0, 1); PG8_STAGE(PG8_SB(0, 0), b2, voffB);
            PG8_BAR; PG8_WAIT_L(0); PG8_MMA(0, 1, At, B1); PG8_BAR;
            PG8_LDA(At, 0, 1); PG8_STAGE(PG8_SA(0, 0), a2, voffA);
            PG8_BAR; PG8_WAIT_L(0); PG8_MMA(1, 0, At, B0); PG8_BAR; PG8_SCHED;
            PG8_STAGE(PG8_SB(0, 1), b2 + hstepB, voffB);
            PG8_WAIT_V(6); PG8_BAR; PG8_MMA(1, 1, At, B1); PG8_BAR;
            PG8_LDB(B0, 1, 0); PG8_SCHED; PG8_LDA(At, 1, 0); PG8_STAGE(PG8_SA(0, 1), a2 + hstepA, voffA);
            PG8_WAIT_L(8); PG8_BAR; PG8_WAIT_L(0); PG8_MMA(0, 0, At, B0); PG8_BAR; PG8_SCHED;
            PG8_LDB(B1, 1, 1); PG8_STAGE(PG8_SB(1, 0), b3, voffB);
            PG8_BAR; PG8_WAIT_L(0); PG8_MMA(0, 1, At, B1); PG8_BAR;
            PG8_LDA(At, 1, 1); PG8_STAGE(PG8_SA(1, 0), a3, voffA);
            PG8_BAR; PG8_WAIT_L(0); PG8_MMA(1, 0, At, B0); PG8_BAR; PG8_SCHED;
            PG8_STAGE(PG8_SB(1, 1), b3 + hstepB, voffB);
            PG8_WAIT_V(6); PG8_BAR; PG8_MMA(1, 1, At, B1); PG8_BAR;
            }
        }
        if constexpr (ALIGN_EPI) { if (wr == 0) PG8_BAR; }
        if constexpr (!Epi::AFTER_DRAIN) { E(acc, cur, wr, wc, fr, fq); S.done(cur); }
        if (!has_next) break;
#pragma unroll
        for (int a = 0; a < 2; ++a)
#pragma unroll
            for (int b = 0; b < 2; ++b)
#pragma unroll
                for (int m = 0; m < 4; ++m)
#pragma unroll
                    for (int n = 0; n < 2; ++n) acc[a][b][m][n] = (f32x4){0.f, 0.f, 0.f, 0.f};
        cur = nxt; cA = nA; cB = nB; ++ui;
        if constexpr (ALIGN_EPI) { if (wr == 1) PG8_BAR; }
    }
    PG8_WAIT_V(0);
    if constexpr (!ALIGN_EPI) { if (wr == 0) PG8_BAR; }
    PG8_BAR;
    if constexpr (Epi::AFTER_DRAIN) { E.fused(acc, cur, wr, wc, fr, fq, lds, wid, lane); S.done(cur); }
#undef PG8_SA
#undef PG8_SB
#undef PG8_STAGE
#undef PG8_LDA
#undef PG8_LDB
#undef PG8_MMA
#undef PG8_WAIT_V
#undef PG8_WAIT_L
#undef PG8_BAR
#undef PG8_SCHED
}
}
#define EPI_ROWS_BEGIN  _Pragma("unroll") for (int ai = 0; ai < 2; ++ai) _Pragma("unroll") for (int m = 0; m < 4; ++m) { const int row = u.pm * 256 + ai * 128 + wr * 64 + m * 16 + fr;
#define EPI_ROWS_END    }
__device__ __forceinline__ u32x4 pack8(const f32x4 a, const f32x4 b) { u32x4 w; w.x = cvt_pk_bf16(a[0], a[1]); w.y = cvt_pk_bf16(a[2], a[3]); w.z = cvt_pk_bf16(b[0], b[1]); w.w = cvt_pk_bf16(b[2], b[3]); return w; }
__device__ __forceinline__ void unpack8(const u32x4 w, f32x4& a, f32x4& b) { a = (f32x4){bf_lo(w.x), bf_hi(w.x), bf_lo(w.y), bf_hi(w.y)}; b = (f32x4){bf_lo(w.z), bf_hi(w.z), bf_lo(w.w), bf_hi(w.w)}; }
__device__ __forceinline__ f32x4 sig4(const f32x4 x) { return (f32x4){sigmoidf_(x[0]), sigmoidf_(x[1]), sigmoidf_(x[2]), sigmoidf_(x[3])}; }

__device__ __forceinline__ void ssq_add(float* ssq, int row, float part, int fq) { part += __shfl_xor(part, 16); part += __shfl_xor(part, 32); if (fq == 0) atomicAdd(ssq + row, part); }
__device__ __forceinline__ float sq4(const f32x4 a) { return (a[0] * a[0] + a[1] * a[1]) + (a[2] * a[2] + a[3] * a[3]); }
template <int RS, bool SSQ> struct EpiStoreBf16 {
    static constexpr bool PERM = true, AFTER_DRAIN = false;
    bf16_t* O; int ldc; const float* rs; float* ssq;
    __device__ __forceinline__ void operator()(const f32x4 (&acc)[2][2][4][2], const pg8::Unit& u, int wr, int wc, int fr, int fq) const {
        const int col0 = u.pn * 256 + wc * 32 + 8 * fq;
        EPI_ROWS_BEGIN
            bf16_t* rowp = O + (size_t)row * ldc + col0;
            float sc = 1.f; if (RS == 1) sc = rs[row]; if (RS == 2) sc = 1.0f / sqrtf(rs[row] * (1.f / DM) + EPS);
            float part = 0.f;
#pragma unroll
            for (int bj = 0; bj < 2; ++bj) { const f32x4 v0 = acc[ai][bj][m][0] * sc, v1 = acc[ai][bj][m][1] * sc; if (SSQ) part += sq4(v0) + sq4(v1); *(u32x4*)(rowp + bj * 128) = pack8(v0, v1); }
            if (SSQ) ssq_add(ssq, row, part, fq);
        EPI_ROWS_END
    }
};
struct EpiGlu {
    static constexpr bool PERM = true, AFTER_DRAIN = false;
    const bf16_t* Z; bf16_t* O; int ldc;
    __device__ __forceinline__ void operator()(const f32x4 (&acc)[2][2][4][2], const pg8::Unit& u, int wr, int wc, int fr, int fq) const {
        const int col0 = u.pn * 256 + wc * 32 + 8 * fq;
        EPI_ROWS_BEGIN
#pragma unroll
            for (int bj = 0; bj < 2; ++bj) { const size_t o = (size_t)row * ldc + col0 + bj * 128; f32x4 z0, z1; unpack8(*(const u32x4*)(Z + o), z0, z1);
                *(u32x4*)(O + o) = pack8(z0 * sig4(acc[ai][bj][m][0]), z1 * sig4(acc[ai][bj][m][1])); }
        EPI_ROWS_END
    }
};
template <bool ADD> struct EpiGate {
    static constexpr bool PERM = true, AFTER_DRAIN = false;
    const bf16_t* Gt; int ldg; bf16_t* O; int ldc;
    __device__ __forceinline__ void operator()(const f32x4 (&acc)[2][2][4][2], const pg8::Unit& u, int wr, int wc, int fr, int fq) const {
        const int col0 = u.pn * 256 + wc * 32 + 8 * fq;
        EPI_ROWS_BEGIN
#pragma unroll
            for (int bj = 0; bj < 2; ++bj) { f32x4 g0, g1; unpack8(*(const u32x4*)(Gt + (size_t)row * ldg + col0 + bj * 128), g0, g1);
                f32x4 r0 = sig4(g0) * acc[ai][bj][m][0], r1 = sig4(g1) * acc[ai][bj][m][1]; bf16_t* op = O + (size_t)row * ldc + col0 + bj * 128;
                if (ADD) { f32x4 o0, o1; unpack8(*(const u32x4*)op, o0, o1); r0 += o0; r1 += o1; }
                *(u32x4*)op = pack8(r0, r1); }
        EPI_ROWS_END
    }
};
struct EpiResidBf {
    static constexpr bool PERM = true, AFTER_DRAIN = false;
    bf16_t* X; float* ssq;
    __device__ __forceinline__ void operator()(const f32x4 (&acc)[2][2][4][2], const pg8::Unit& u, int wr, int wc, int fr, int fq) const {
        const int col0 = u.pn * 256 + wc * 32 + 8 * fq;
        EPI_ROWS_BEGIN
            bf16_t* rowp = X + (size_t)row * DM + col0; float part = 0.f;
#pragma unroll
            for (int bj = 0; bj < 2; ++bj) { f32x4 x0, x1; unpack8(*(const u32x4*)(rowp + bj * 128), x0, x1); x0 += acc[ai][bj][m][0]; x1 += acc[ai][bj][m][1]; part += sq4(x0) + sq4(x1); *(u32x4*)(rowp + bj * 128) = pack8(x0, x1); }
            ssq_add(ssq, row, part, fq);
        EPI_ROWS_END
    }
};
struct EpiPg {
    static constexpr bool PERM = false, AFTER_DRAIN = false;
    float* out; const bf16_t* x2; const bf16_t* pr; const float* ssq2; const float* ssqp; const float* gp;
    __device__ __forceinline__ void operator()(const f32x4 (&acc)[2][2][4][2], const pg8::Unit& u, int wr, int wc, int fr, int fq) const {
        const int col0 = u.pn * 256 + wc * 32 + 4 * fq;
        f32x4 gv[2][2];
#pragma unroll
        for (int bj = 0; bj < 2; ++bj)
#pragma unroll
            for (int n = 0; n < 2; ++n) gv[bj][n] = *(const f32x4*)(gp + col0 + bj * 128 + n * 16);
        EPI_ROWS_BEGIN
            if (row < MR) { const float r2 = 1.0f / sqrtf(ssq2[row] * (1.f / DM) + EPS), rp = 1.0f / sqrtf(ssqp[row] * (1.f / DM) + EPS);
                float* o = out + (size_t)row * DM + col0; const bf16_t* p = pr + (size_t)row * DM + col0; const bf16_t* xx = x2 + (size_t)row * DM + col0;
#pragma unroll
                for (int bj = 0; bj < 2; ++bj)
#pragma unroll
                    for (int n = 0; n < 2; ++n) { const u32x2 w = *(const u32x2*)(p + bj * 128 + n * 16); const f32x4 pv = (f32x4){bf_lo(w.x), bf_hi(w.x), bf_lo(w.y), bf_hi(w.y)};
                        const u32x2 xw = *(const u32x2*)(xx + bj * 128 + n * 16); const f32x4 xv = (f32x4){bf_lo(xw.x), bf_hi(xw.x), bf_lo(xw.y), bf_hi(xw.y)};
                        *(f32x4*)(o + bj * 128 + n * 16) = xv + sig4(acc[ai][bj][m][n] * r2) * pv * gv[bj][n] * rp; } }
        EPI_ROWS_END
    }
};
template <class Epi>
__device__ __forceinline__ void skinny_gemm(LAS unsigned char* lds, const bf16_t* __restrict__ A, int lda, const bf16_t* __restrict__ Bt, int K, int N, const Epi& E, int vcu, int G, int wave, int lane) {
    const int rg = wave & 3, kh = wave >> 2, cq = lane >> 4, Kh = K >> 1;
    LAS f32x4* red = (LAS f32x4*)lds;
    for (int u = vcu; u < N / 8; u += G) {
        const int cs = u >> 1, rh = u & 1; const int row = TP + 64 * rh + 16 * rg + (lane & 15);
        const bf16_t* ap = A + (size_t)row * lda + kh * Kh + 8 * cq;
        const bf16_t* bp = Bt + (size_t)(16 * cs + (lane & 15)) * K + kh * Kh + 8 * cq;
        f32x4 acc = {0.f, 0.f, 0.f, 0.f};
#pragma unroll 8
        for (int k0 = 0; k0 < Kh; k0 += 32) acc = __builtin_amdgcn_mfma_f32_16x16x32_bf16(*(const bf16x8*)(bp + k0), *(const bf16x8*)(ap + k0), acc, 0, 0, 0);
        if (kh == 1) red[rg * 64 + lane] = acc;
        __syncthreads();
        if (kh == 0) { acc += red[rg * 64 + lane]; E(row, 16 * cs + 4 * cq, acc, lane); }
        __syncthreads();
    }
}
__device__ __forceinline__ f32x4 ld4bf(const bf16_t* p) { const u32x2 w = *(const u32x2*)p; return (f32x4){bf_lo(w.x), bf_hi(w.x), bf_lo(w.y), bf_hi(w.y)}; }
__device__ __forceinline__ void st4bf(bf16_t* p, const f32x4 v) { u32x2 w; w.x = cvt_pk_bf16(v[0], v[1]); w.y = cvt_pk_bf16(v[2], v[3]); *(u32x2*)p = w; }
struct SkGlu { const bf16_t* Z; bf16_t* O; __device__ __forceinline__ void operator()(int row, int col, f32x4 acc, int) const { const size_t o = (size_t)row * 512 + col; st4bf(O + o, ld4bf(Z + o) * sig4(acc)); } };
template <bool ADD> struct SkGate { const bf16_t* Gt; int ldg; bf16_t* O;
    __device__ __forceinline__ void operator()(int row, int col, f32x4 acc, int) const { f32x4 r = sig4(ld4bf(Gt + (size_t)row * ldg + col)) * acc; bf16_t* op = O + (size_t)row * DM + col; if (ADD) r += ld4bf(op); st4bf(op, r); } };
struct SkResid { bf16_t* X; float* ssq;
    __device__ __forceinline__ void operator()(int row, int col, f32x4 acc, int lane) const { bf16_t* p = X + (size_t)row * DM + col; const f32x4 x = ld4bf(p) + acc; st4bf(p, x);
        float part = sq4(x); part += __shfl_xor(part, 16); part += __shfl_xor(part, 32); if (lane < 16) atomicAdd(ssq + row, part); } };
struct SkPg { float* out; const bf16_t* x2; const bf16_t* pr; const float* ssq2; const float* ssqp; const float* gp;
    __device__ __forceinline__ void operator()(int row, int col, f32x4 acc, int) const { const float r2 = 1.0f / sqrtf(ssq2[row] * (1.f / DM) + EPS), rp = 1.0f / sqrtf(ssqp[row] * (1.f / DM) + EPS);
        const size_t o = (size_t)row * DM + col; *(f32x4*)(out + o) = ld4bf(x2 + o) + sig4(acc * r2) * ld4bf(pr + o) * *(const f32x4*)(gp + col) * rp; } };
#define XB_TMO      128
#define XB_XCNT(j)  (256  + 64 * (j))
#define XB_XSUB(j)  (1280 + 64 * (j))
#define XB_XGEN(j)  (2304 + 64 * (j))
#define XB_TOP      3328
#define XB_TOPGEN   3392
#define XCD_BAR_WORDS 3456
#define XB_SPIN_CAP (1u << 18)

__device__ __forceinline__ unsigned xb_ld(unsigned* p)              { return __hip_atomic_load(p, __ATOMIC_RELAXED, __HIP_MEMORY_SCOPE_AGENT); }
__device__ __forceinline__ unsigned xb_add(unsigned* p, unsigned v) { return __hip_atomic_fetch_add(p, v, __ATOMIC_RELAXED, __HIP_MEMORY_SCOPE_AGENT); }
__device__ __forceinline__ unsigned xb_xcc_id() { return (unsigned)__builtin_amdgcn_s_getreg((3 << 11) | 20) & 0xFu; }
#define XB_SPIN(cond, bar) do { unsigned _sp = 0; while (cond) { __builtin_amdgcn_s_sleep(1); \
    if ((++_sp & 255u) == 0u) { if (xb_ld(&(bar)[XB_TMO])) break; if (_sp > XB_SPIN_CAP) { atomicAdd(&(bar)[XB_TMO], 1u); break; } } } } while (0)

struct XcdBarrier {
    unsigned* bar; unsigned x;
    volatile LAS unsigned* st;
};

__device__ __forceinline__ XcdBarrier xcd_barrier_post(unsigned* bar, volatile LAS unsigned* st) {
    XcdBarrier b; b.bar = bar; b.x = xb_xcc_id(); b.st = st;
    if (threadIdx.x == 0) (void)xb_add(&bar[XB_XCNT(b.x)], 1u);
    return b;
}
__device__ __forceinline__ void xcd_barrier_complete(unsigned* bar, unsigned x, unsigned& nloc, unsigned& nx) {
    const unsigned G = gridDim.x * gridDim.y * gridDim.z;
    unsigned sum, cnt, mine, sp = 0u;
    for (;;) {
        sum = 0u; cnt = 0u; mine = 0u;
#pragma unroll
        for (unsigned j = 0; j < 16; ++j) { const unsigned c = xb_ld(&bar[XB_XCNT(j)]); sum += c; cnt += (c > 0u) ? 1u : 0u; mine = (j == x) ? c : mine; }
        if (sum == G) break;
        __builtin_amdgcn_s_sleep(1);
        if ((++sp & 255u) == 0u) { if (xb_ld(&bar[XB_TMO])) break; if (sp > XB_SPIN_CAP) { atomicAdd(&bar[XB_TMO], 1u); break; } }
    }
    nloc = mine > 0u ? mine : 1u; nx = cnt > 0u ? cnt : 1u;
}

__device__ __forceinline__ void xcd_barrier(const XcdBarrier& b) {
    asm volatile("s_waitcnt vmcnt(0)" ::: "memory");
    __syncthreads();
    if (threadIdx.x == 0) {
        unsigned* bar = b.bar;
        __builtin_amdgcn_s_waitcnt(0);
        unsigned nloc = b.st[0], nx = b.st[1];
        if (nloc == 0u) { xcd_barrier_complete(bar, b.x, nloc, nx); b.st[0] = nloc; b.st[1] = nx; }
        const unsigned old = xb_add(&bar[XB_XSUB(b.x)], 1u);
        const unsigned gen = old / nloc;
        if (old + 1u == (gen + 1u) * nloc) {
            __builtin_amdgcn_fence(__ATOMIC_RELEASE, "agent");
            asm volatile("s_waitcnt vmcnt(0)" ::: "memory");
            const unsigned og = xb_add(&bar[XB_TOP], 1u);
            const unsigned tg = og / nx;
            if (og + 1u == (tg + 1u) * nx) xb_add(&bar[XB_TOPGEN], 1u);
            else XB_SPIN(xb_ld(&bar[XB_TOPGEN]) == tg, bar);
            __builtin_amdgcn_fence(__ATOMIC_ACQUIRE, "agent");
            xb_add(&bar[XB_XGEN(b.x)], 1u);
            asm volatile("s_waitcnt vmcnt(0)" ::: "memory");
        } else {
            XB_SPIN(xb_ld(&bar[XB_XGEN(b.x)]) == gen, bar);
            __builtin_amdgcn_fence(__ATOMIC_ACQUIRE, "agent");
            asm volatile("s_waitcnt vmcnt(0)" ::: "memory");
        }
    }
    __syncthreads();
}
__device__ __forceinline__ void cexp_d(double re, double im, int k, double& ore, double& oim) {
    const double sc = 1.0 / (double)(1ull << k); const double zr = re * sc, zi = im * sc;
    double tr = 1.0, ti = 0.0, sr = 1.0, si = 0.0;
#pragma unroll 1
    for (int n = 1; n <= 12; ++n) { const double inv = 1.0 / (double)n; const double nr = (tr * zr - ti * zi) * inv, ni = (tr * zi + ti * zr) * inv; tr = nr; ti = ni; sr += tr; si += ti; }
#pragma unroll 1
    for (int i = 0; i < k; ++i) { const double nr = sr * sr - si * si, ni = 2.0 * sr * si; sr = nr; si = ni; }
    ore = sr; oim = si;
}

__device__ __forceinline__ void transpose_item(const float* __restrict__ W, int K, int N, bf16_t* __restrict__ WT, int nblk, LAS float* scr, int item, int lane, const float* __restrict__ gk = nullptr) {
    const int kb = item / nblk, nb = item % nblk, k0 = 64 * kb, n0 = 32 * nb;
    const int nn = n0 + (lane & 31); const bool ok = nn < N;
#pragma unroll 8
    for (int i = 0; i < 32; ++i) { const int kk = 2 * i + (lane >> 5); float w = ok ? W[(size_t)(k0 + kk) * N + nn] : 0.f; if (gk) w *= gk[k0 + kk]; scr[kk * 33 + (lane & 31)] = w; }
    LDS_WAIT(); asm volatile("" ::: "memory");
    const int c = lane & 7;
#pragma unroll
    for (int j = 0; j < 4; ++j) { const int n = (lane >> 3) + 8 * j; const LAS float* s = scr + (8 * c) * 33 + n;
        u32x4 o; o.x = cvt_pk_bf16(s[0 * 33], s[1 * 33]); o.y = cvt_pk_bf16(s[2 * 33], s[3 * 33]); o.z = cvt_pk_bf16(s[4 * 33], s[5 * 33]); o.w = cvt_pk_bf16(s[6 * 33], s[7 * 33]);
        *(u32x4*)(WT + (size_t)(n0 + n) * K + k0 + 8 * c) = o; }
    LDS_WAIT(); asm volatile("" ::: "memory");
}
__device__ __forceinline__ void row_to_bf16_rstd(const float* __restrict__ xrow, bf16_t* __restrict__ orow, float* __restrict__ rs, int lane) {
    const f32x4* xr = (const f32x4*)xrow + lane;
    f32x4 v[8]; float s = 0.f;
#pragma unroll
    for (int j = 0; j < 8; ++j) { v[j] = xr[64 * j]; s += (v[j].x * v[j].x + v[j].y * v[j].y) + (v[j].z * v[j].z + v[j].w * v[j].w); }
    s = wave_sum(s);
    u32x2* o8 = (u32x2*)orow + lane;
#pragma unroll
    for (int j = 0; j < 8; ++j) { u32x2 w; w.x = cvt_pk_bf16(v[j].x, v[j].y); w.y = cvt_pk_bf16(v[j].z, v[j].w); o8[64 * j] = w; }
    if (lane == 0) *rs = 1.0f / sqrtf(s * (1.f / DM) + EPS);
}
__device__ __forceinline__ void ld16bf(const bf16_t* p, float (&v)[16]) {
    const u32x4 a = *(const u32x4*)p, b = *(const u32x4*)(p + 8);
    v[0] = bf_lo(a.x); v[1] = bf_hi(a.x); v[2] = bf_lo(a.y); v[3] = bf_hi(a.y); v[4] = bf_lo(a.z); v[5] = bf_hi(a.z); v[6] = bf_lo(a.w); v[7] = bf_hi(a.w);
    v[8] = bf_lo(b.x); v[9] = bf_hi(b.x); v[10] = bf_lo(b.y); v[11] = bf_hi(b.y); v[12] = bf_lo(b.z); v[13] = bf_hi(b.z); v[14] = bf_lo(b.w); v[15] = bf_hi(b.w);
}
__device__ __forceinline__ void st16bf(bf16_t* p, const float (&v)[16]) {
    u32x4 a, b; a.x = cvt_pk_bf16(v[0], v[1]); a.y = cvt_pk_bf16(v[2], v[3]); a.z = cvt_pk_bf16(v[4], v[5]); a.w = cvt_pk_bf16(v[6], v[7]);
    b.x = cvt_pk_bf16(v[8], v[9]); b.y = cvt_pk_bf16(v[10], v[11]); b.z = cvt_pk_bf16(v[12], v[13]); b.w = cvt_pk_bf16(v[14], v[15]);
    *(u32x4*)p = a; *(u32x4*)(p + 8) = b;
}
__device__ __forceinline__ void st16f(float* p, const float (&v)[16]) {
#pragma unroll
    for (int j = 0; j < 4; ++j) *(f32x4*)(p + 4 * j) = (f32x4){v[4 * j], v[4 * j + 1], v[4 * j + 2], v[4 * j + 3]};
}
__device__ __forceinline__ void norm_rope128(float (&v)[16], int sub, const float* __restrict__ g, const float* __restrict__ rt) {
    float ss = 0.f;
#pragma unroll
    for (int e = 0; e < 16; ++e) ss += v[e] * v[e];
    ss += __shfl_xor(ss, 1); ss += __shfl_xor(ss, 2); ss += __shfl_xor(ss, 4);
    const float rstd = 1.0f / sqrtf(ss * (1.f / 128.f) + EPS);
#pragma unroll
    for (int e = 0; e < 16; ++e) v[e] = v[e] * rstd * g[sub * 16 + e];
#pragma unroll
    for (int e = 0; e < 16; ++e) { const float o = __shfl_xor(v[e], 1); const float c = rt[e], s = rt[16 + e];
        const float r0 = v[e] * c - o * s, r1 = v[e] * c + o * s;
        v[e] = sub == 0 ? r0 : (sub == 1 ? r1 : v[e]); }
}
__device__ __forceinline__ void rope64(float (&v)[16], const float* __restrict__ rt) {
#pragma unroll
    for (int i = 0; i < 8; ++i) { const float c = rt[32 + i], s = rt[40 + i]; const float x1 = v[i], x2 = v[8 + i]; v[i] = x1 * c - x2 * s; v[8 + i] = x2 * c + x1 * s; }
}
__device__ __forceinline__ void up16(const u32x4 a, const u32x4 b, float (&v)[16]) {
    v[0] = bf_lo(a.x); v[1] = bf_hi(a.x); v[2] = bf_lo(a.y); v[3] = bf_hi(a.y); v[4] = bf_lo(a.z); v[5] = bf_hi(a.z); v[6] = bf_lo(a.w); v[7] = bf_hi(a.w);
    v[8] = bf_lo(b.x); v[9] = bf_hi(b.x); v[10] = bf_lo(b.y); v[11] = bf_hi(b.y); v[12] = bf_lo(b.z); v[13] = bf_hi(b.z); v[14] = bf_lo(b.w); v[15] = bf_hi(b.w);
}
struct TaRaw { u32x4 q0, q1, k0, k1, v0, v1, i0, i1, j0, j1; unsigned w; };
__device__ __forceinline__ void ta_load(int row, int lane, const bf16_t* __restrict__ proj, TaRaw& R) {
    const bf16_t* pr = proj + (size_t)row * INWP; const int l15 = lane & 15, l3 = lane & 3;
    R.q0 = *(const u32x4*)(pr + C_Q + 16 * lane); R.q1 = *(const u32x4*)(pr + C_Q + 16 * lane + 8);
    R.k0 = *(const u32x4*)(pr + C_K + 16 * l15); R.k1 = *(const u32x4*)(pr + C_K + 16 * l15 + 8);
    R.v0 = *(const u32x4*)(pr + C_V + 16 * l15); R.v1 = *(const u32x4*)(pr + C_V + 16 * l15 + 8);
    R.i0 = *(const u32x4*)(pr + C_IQ + 16 * lane); R.i1 = *(const u32x4*)(pr + C_IQ + 16 * lane + 8);
    R.j0 = *(const u32x4*)(pr + C_IK + 16 * l3); R.j1 = *(const u32x4*)(pr + C_IK + 16 * l3 + 8);
    R.w = pr[C_IW + l15];
}
__device__ __forceinline__ void ta_compute(int row, int lane, const TaRaw& R, const float* __restrict__ RT, const float* __restrict__ gq, const float* __restrict__ gk,
                                           bf16_t* __restrict__ qn, bf16_t* __restrict__ kn, bf16_t* __restrict__ vb, bf16_t* __restrict__ iqr, bf16_t* __restrict__ ikr, float* __restrict__ iws, float* __restrict__ out) {
    const int pi = row < TP ? (row & (SEQ - 1)) : SEQ + ((row - TP) & 3);
    const float* rt = RT + pi * 48;
    const bool isp = row < TP; const int rs = isp ? row : row - TP;
    float v[16];
    up16(R.q0, R.q1, v); norm_rope128(v, lane & 7, gq, rt); st16bf(qn + (size_t)row * 1024 + 16 * lane, v);
    { const int l = lane & 15; up16(R.k0, R.k1, v); norm_rope128(v, l & 7, gk, rt);
      if (lane < 16) { st16bf(kn + (size_t)row * 256 + 16 * l, v); st16f(out + (isp ? O_KP : O_KS) + (size_t)rs * 256 + 16 * l, v); } }
    if (lane < 16) { up16(R.v0, R.v1, v); *(u32x4*)(vb + (size_t)row * 256 + 16 * lane) = R.v0; *(u32x4*)(vb + (size_t)row * 256 + 16 * lane + 8) = R.v1; st16f(out + (isp ? O_VP : O_VS) + (size_t)rs * 256 + 16 * lane, v); }
    up16(R.i0, R.i1, v); if ((lane & 3) == 0) rope64(v, rt); st16bf(iqr + (size_t)row * 1024 + 16 * lane, v);
    if (lane < 4) { up16(R.j0, R.j1, v); if (lane == 0) rope64(v, rt); st16bf(ikr + (size_t)row * 64 + 16 * lane, v); st16f(out + (isp ? O_IKP : O_IKS) + (size_t)rs * 64 + 16 * lane, v); }
    if (lane < 16) iws[(size_t)row * 16 + lane] = bf2f((bf16_t)R.w) * IDX_SCALE;
}
__device__ __forceinline__ bf16x8 as_bf16x8(const u32x4 w) { return __builtin_bit_cast(bf16x8, w); }
__device__ __forceinline__ void idx_load_a(const bf16_t* __restrict__ iqr, size_t row0, int lane, bf16x8 (&a)[4]) {
    const int rho = lane & 31, h = lane >> 5; const int tok = (rho >> 2) & 1, head = (rho & 3) + 4 * (rho >> 3);
    const bf16_t* p = iqr + (row0 + tok) * 1024 + head * 64 + 8 * h;
#pragma unroll
    for (int kk = 0; kk < 4; ++kk) a[kk] = *(const bf16x8*)(p + 16 * kk);
}
__device__ __forceinline__ float idx_reduce(const f32x16& acc, const f32x4 (&wv)[4]) {
    float s = 0.f;
#pragma unroll
    for (int r = 0; r < 16; ++r) s += wv[r >> 2][r & 3] * fmaxf(acc[r], 0.f);
    return s;
}
__device__ __forceinline__ void idx_prompt_block(int b, int qb, int wave, int lane, const bf16_t* __restrict__ iqr, const bf16_t* __restrict__ ikr, const float* __restrict__ iws, float* __restrict__ sc) {
    const int h = lane >> 5, kl = lane & 31;
    bf16x8 a[4][4]; f32x4 wv[4][4]; size_t rowi[4];
#pragma unroll
    for (int i = 0; i < 4; ++i) { const size_t row0 = (size_t)b * SEQ + 64 * qb + 2 * (4 * wave + i); rowi[i] = row0 + h; idx_load_a(iqr, row0, lane, a[i]);
#pragma unroll
        for (int j = 0; j < 4; ++j) wv[i][j] = *(const f32x4*)(iws + (row0 + h) * 16 + 4 * j); }
    const int ntile = 2 * qb + 2;
    const bf16_t* kp = ikr + ((size_t)b * SEQ + kl) * 64 + 8 * h;
    bf16x8 bc[4], bn[4];
#pragma unroll
    for (int kk = 0; kk < 4; ++kk) bc[kk] = *(const bf16x8*)(kp + 16 * kk);
    for (int kt = 0; kt < ntile; ++kt) {
        if (kt + 1 < ntile) {
#pragma unroll
            for (int kk = 0; kk < 4; ++kk) bn[kk] = *(const bf16x8*)(kp + (size_t)(kt + 1) * 32 * 64 + 16 * kk); }
#pragma unroll
        for (int i = 0; i < 4; ++i) { f32x16 acc = {};
#pragma unroll
            for (int kk = 0; kk < 4; ++kk) acc = __builtin_amdgcn_mfma_f32_32x32x16_bf16(a[i][kk], bc[kk], acc, 0, 0, 0);
            sc[rowi[i] * SEQ + 32 * kt + kl] = idx_reduce(acc, wv[i]); }
#pragma unroll
        for (int kk = 0; kk < 4; ++kk) bc[kk] = bn[kk];
    }
}
__device__ __forceinline__ void idx_sample_unit(int b, int c, int wave, int lane, const bf16_t* __restrict__ iqr, const bf16_t* __restrict__ ikr, const float* __restrict__ iws,
                                                const float* __restrict__ cik, const int* __restrict__ pt, float* __restrict__ ssc) {
    const int h = lane >> 5, kl = lane & 31;
    bf16x8 a[2][4]; f32x4 wv[2][4];
#pragma unroll
    for (int i = 0; i < 2; ++i) { const size_t row0 = (size_t)TP + 4 * b + 2 * i; idx_load_a(iqr, row0, lane, a[i]);
#pragma unroll
        for (int j = 0; j < 4; ++j) wv[i][j] = *(const f32x4*)(iws + (row0 + h) * 16 + 4 * j); }
    const int pgl = 8 * c + wave; const int page = pt[b * NPG + pgl];
#pragma unroll 1
    for (int kt = 0; kt < 4; ++kt) {
        const float* p = cik + ((size_t)page * PAGE + 32 * kt + kl) * 64 + 8 * h; bf16x8 bc[4];
#pragma unroll
        for (int kk = 0; kk < 4; ++kk) { const f32x4 x0 = *(const f32x4*)(p + 16 * kk), x1 = *(const f32x4*)(p + 16 * kk + 4); bc[kk] = as_bf16x8(pack8(x0, x1)); }
#pragma unroll
        for (int i = 0; i < 2; ++i) { f32x16 acc = {};
#pragma unroll
            for (int kk = 0; kk < 4; ++kk) acc = __builtin_amdgcn_mfma_f32_32x32x16_bf16(a[i][kk], bc[kk], acc, 0, 0, 0);
            ssc[(size_t)(b * 4 + 2 * i + h) * SSTR + pgl * PAGE + 32 * kt + kl] = idx_reduce(acc, wv[i]); }
    }
    if (c == 15 && wave == 0) {
        const bf16_t* p = ikr + ((size_t)TP + 4 * b + (kl & 3)) * 64 + 8 * h; bf16x8 bc[4];
#pragma unroll
        for (int kk = 0; kk < 4; ++kk) bc[kk] = *(const bf16x8*)(p + 16 * kk);
#pragma unroll
        for (int i = 0; i < 2; ++i) { f32x16 acc = {};
#pragma unroll
            for (int kk = 0; kk < 4; ++kk) acc = __builtin_amdgcn_mfma_f32_32x32x16_bf16(a[i][kk], bc[kk], acc, 0, 0, 0);
            const float s = idx_reduce(acc, wv[i]); if (kl < 4) ssc[(size_t)(b * 4 + 2 * i + h) * SSTR + PAST + kl] = s; }
    }
}
__device__ __forceinline__ unsigned fkey(float v) { const unsigned u = __float_as_uint(v); return (u >> 31) ? ~u : (u | 0x80000000u); }
__device__ __forceinline__ float fkey_inv(unsigned k) { return __uint_as_float((k >> 31) ? (k ^ 0x80000000u) : ~k); }
struct Bracket { float a, b, fa, fb, thr; int side, it; bool done; };
__device__ __forceinline__ void br_init(Bracket& B, float lo, float hi, int n, int cnt_hi) {
    B.a = lo; B.b = hi; B.fa = (float)(n - 256); B.fb = (float)(cnt_hi - 256); B.thr = lo; B.side = 0; B.it = 0; B.done = false;
    if (cnt_hi >= 256) { B.thr = hi; B.done = true; }
    if (n <= 256) { B.thr = lo; B.done = true; }
}
__device__ __forceinline__ float br_next(Bracket& B) {
    float c;
    if (B.it % 3 == 2) { const unsigned ka = fkey(B.a), kb = fkey(B.b); if (kb - ka <= 1u) { B.done = true; return B.a; } c = fkey_inv(ka + ((kb - ka) >> 1)); }
    else { c = B.a + (B.b - B.a) * (B.fa / (B.fa - B.fb)); if (!(c > B.a) || !(c < B.b)) c = 0.5f * (B.a + B.b);
           if (!(c > B.a) || !(c < B.b)) { const unsigned ka = fkey(B.a), kb = fkey(B.b); if (kb - ka <= 1u) { B.done = true; return B.a; } c = fkey_inv(ka + ((kb - ka) >> 1)); } }
    ++B.it; if (B.it > 120) B.done = true;
    return c;
}
__device__ __forceinline__ void br_update(Bracket& B, float c, int cnt) {
    const float f = (float)(cnt - 256);
    if (cnt == 256) { B.thr = c; B.done = true; return; }
    if (cnt > 256) { B.a = c; B.fa = f; B.thr = c; if (B.side == 1) B.fb *= 0.5f; B.side = 1; }
    else { B.b = c; B.fb = f; if (B.side == -1) B.fa *= 0.5f; B.side = -1; }
}
__device__ __forceinline__ void select_prompt_row(int row, int lane, const float* __restrict__ sc, u64* __restrict__ bm) {
    const int t = row & (SEQ - 1);
    u64 myword = 0ull;
    if (t < 256) {
        const int n = t + 1 - 64 * lane; myword = n >= 64 ? ~0ull : (n > 0 ? ((1ull << n) - 1ull) : 0ull);
    } else {
        float v[32]; const int nreg = (t >> 6) + 1; const float* sr = sc + (size_t)row * SEQ; const float NINF = -__builtin_inff();
#pragma unroll
        for (int j = 0; j < 32; ++j) { v[j] = NINF; if (j < nreg) { const int s = 64 * j + lane; if (s <= t) v[j] = sr[s]; } }
        float mx = v[0], mn = (lane <= t) ? v[0] : __builtin_inff();
#pragma unroll
        for (int j = 1; j < 32; ++j) { mx = fmaxf(mx, v[j]); mn = fminf(mn, v[j] == NINF ? __builtin_inff() : v[j]); }
#pragma unroll
        for (int o = 1; o < 64; o <<= 1) { mx = fmaxf(mx, __shfl_xor(mx, o)); mn = fminf(mn, __shfl_xor(mn, o)); }
#define CNT_GE(c, dst) do { int cnt_ = 0; _Pragma("unroll") for (int gq = 0; gq < 4; ++gq) if (8 * gq < nreg) { _Pragma("unroll") for (int j = 8 * gq; j < 8 * gq + 8; ++j) cnt_ += __popcll(__ballot(v[j] >= (c))); __builtin_amdgcn_sched_barrier(0); } dst = cnt_; } while (0)
        mx = __builtin_bit_cast(float, __builtin_amdgcn_readfirstlane(__builtin_bit_cast(int, mx))); mn = __builtin_bit_cast(float, __builtin_amdgcn_readfirstlane(__builtin_bit_cast(int, mn)));
        int chi; CNT_GE(mx, chi);
        Bracket B; br_init(B, mn, mx, t + 1, chi);
#pragma unroll 1
        while (!B.done) { const float c = br_next(B); if (B.done) break; int cnt; CNT_GE(c, cnt); br_update(B, c, cnt); }
        const float thr = B.thr;
#pragma unroll
        for (int j = 0; j < 32; ++j) { const u64 w = __ballot(v[j] >= thr); if (lane == j) myword = w; if ((j & 7) == 7) __builtin_amdgcn_sched_barrier(0); }
#undef CNT_GE
    }
    if (lane < 32) bm[(size_t)row * 32 + lane] = myword;
}
__device__ __forceinline__ void select_sample_row(int r, int tid, int lane, int wave, const float* __restrict__ ssc, int* __restrict__ sidx, LAS unsigned* red) {
    const int L = PAST + 1 + (r & 3); const float NINF = -__builtin_inff();
    float v[33]; const float* sr = ssc + (size_t)r * SSTR;
#pragma unroll
    for (int j = 0; j < 33; ++j) { const int s = j * 512 + tid; v[j] = s < L ? sr[s] : NINF; }
    LAS float* redf = (LAS float*)red;
    float mx = v[0], mn = v[0];
#pragma unroll
    for (int j = 1; j < 33; ++j) { mx = fmaxf(mx, v[j]); mn = fminf(mn, v[j] == NINF ? __builtin_inff() : v[j]); }
#pragma unroll
    for (int o = 1; o < 64; o <<= 1) { mx = fmaxf(mx, __shfl_xor(mx, o)); mn = fminf(mn, __shfl_xor(mn, o)); }
    if (lane == 0) { redf[32 + wave] = mx; redf[40 + wave] = mn; }
    __syncthreads();
#pragma unroll
    for (int w = 0; w < 8; ++w) { mx = fmaxf(mx, redf[32 + w]); mn = fminf(mn, redf[40 + w]); }
    mx = __builtin_bit_cast(float, __builtin_amdgcn_readfirstlane(__builtin_bit_cast(int, mx))); mn = __builtin_bit_cast(float, __builtin_amdgcn_readfirstlane(__builtin_bit_cast(int, mn)));
    int par = 0;
#define BCNT_GE(c, dst) do { int c_ = 0; _Pragma("unroll") for (int j = 0; j < 33; ++j) c_ += (v[j] >= (c)) ? 1 : 0; _Pragma("unroll") for (int o = 1; o < 64; o <<= 1) c_ += __shfl_xor(c_, o); \
        LAS unsigned* buf_ = red + par * 8; par ^= 1; if (lane == 0) buf_[wave] = (unsigned)c_; __syncthreads(); int tot_ = 0; _Pragma("unroll") for (int w = 0; w < 8; ++w) tot_ += (int)buf_[w]; dst = __builtin_amdgcn_readfirstlane(tot_); } while (0)
    int chi; BCNT_GE(mx, chi);
    Bracket B; br_init(B, mn, mx, L, chi);
#pragma unroll 1
    while (!B.done) { const float c = br_next(B); if (B.done) break; int cnt; BCNT_GE(c, cnt); br_update(B, c, cnt); }
#undef BCNT_GE
    const float thr = B.thr;
    int c = 0;
#pragma unroll
    for (int j = 0; j < 33; ++j) c += (v[j] >= thr) ? 1 : 0;
    int incl = c;
#pragma unroll
    for (int o = 1; o < 64; o <<= 1) { const int x = __shfl_up(incl, o); if (lane >= o) incl += x; }
    __syncthreads();
    if (lane == 63) red[16 + wave] = (unsigned)incl;
    __syncthreads();
    int base = incl - c;
#pragma unroll
    for (int w = 0; w < 8; ++w) if (w < wave) base += (int)red[16 + w];
    int* so = sidx + r * 256;
#pragma unroll
    for (int j = 0; j < 33; ++j) if (v[j] >= thr) { if (base < 256) so[base] = j * 512 + tid; ++base; }
    __syncthreads();
}
struct SsmConst { const float* abar; const float* a32; const bf16_t* bbt; const bf16_t* cmt; };
template <int MODE>
__device__ __forceinline__ void ssm_task(int set, int g, int chunk, int lane, const SsmConst sc, const bf16_t* __restrict__ proj, const float* __restrict__ dvec,
                                         f32x2* __restrict__ SE, const f32x2* __restrict__ SIN, const float* __restrict__ s0re, const float* __restrict__ s0im,
                                         bf16_t* __restrict__ zb, float* __restrict__ ore, float* __restrict__ oim) {
    const int bq = lane & 15, q = lane >> 4; const int b = set * 16 + bq;
    bf16x4 bbt[8];
#pragma unroll
    for (int j = 0; j < 8; ++j) bbt[j] = *(const bf16x4*)(sc.bbt + ((size_t)(g * 128 + 16 * j + bq)) * 16 + 4 * q);
    float ar[16], ai[16], sr[16], si[16];
#pragma unroll
    for (int m = 0; m < 16; ++m) { const f32x2 a = *(const f32x2*)(sc.abar + ((size_t)(g * 64 + 16 * q + m)) * 2); ar[m] = a.x; ai[m] = a.y; sr[m] = 0.f; si[m] = 0.f; }
    bf16x8 cmt[4]; f32x4 dv = {0.f, 0.f, 0.f, 0.f};
    if (MODE != 0) {
#pragma unroll
        for (int j = 0; j < 4; ++j) cmt[j] = *(const bf16x8*)(sc.cmt + ((size_t)(g * 16 + bq)) * 128 + 32 * j + 8 * q);
        dv = *(const f32x4*)(dvec + 16 * g + 4 * q);
    }
    size_t row0; int nstep;
    if (MODE == 2) { row0 = (size_t)TP + 4 * b; nstep = DT;
#pragma unroll
        for (int m = 0; m < 16; ++m) { sr[m] = s0re[((size_t)b * SG + g) * SN + 16 * q + m]; si[m] = s0im[((size_t)b * SG + g) * SN + 16 * q + m]; } }
    else { row0 = (size_t)b * SEQ + (size_t)chunk * SSM_L; nstep = SSM_L;
        if (MODE == 1) {
#pragma unroll
            for (int m = 0; m < 16; ++m) { const f32x2 s = SIN[(((size_t)b * SSM_NCH + chunk) * SG + g) * SN + 16 * q + m]; sr[m] = s.x; si[m] = s.y; } } }
    const bf16_t* up = proj + row0 * INWP + C_U + 16 * g + 4 * q;
    constexpr int UB = 4;
    bf16x4 ub[UB], un[UB];
#pragma unroll
    for (int i = 0; i < UB; ++i) ub[i] = *(const bf16x4*)(up + (size_t)i * INWP);
#pragma unroll 1
    for (int t0 = 0; t0 < nstep; t0 += UB) {
        if (t0 + UB < nstep) {
#pragma unroll
            for (int i = 0; i < UB; ++i) un[i] = *(const bf16x4*)(up + (size_t)(t0 + UB + i) * INWP); }
#pragma unroll
        for (int i = 0; i < UB; ++i) {
            const bf16x4 ucur = ub[i]; const int t = t0 + i;
            f32x4 y = {0.f, 0.f, 0.f, 0.f};
#pragma unroll
            for (int jh = 0; jh < 4; ++jh) {
                const f32x4 bur = __builtin_amdgcn_mfma_f32_16x16x16bf16_1k(bbt[2 * jh], ucur, (f32x4){0.f, 0.f, 0.f, 0.f}, 0, 0, 0);
                const f32x4 bui = __builtin_amdgcn_mfma_f32_16x16x16bf16_1k(bbt[2 * jh + 1], ucur, (f32x4){0.f, 0.f, 0.f, 0.f}, 0, 0, 0);
#pragma unroll
                for (int ii = 0; ii < 4; ++ii) { const int m = 4 * jh + ii; const float nr = ar[m] * sr[m] - ai[m] * si[m] + bur[ii], ni = ar[m] * si[m] + ai[m] * sr[m] + bui[ii]; sr[m] = nr; si[m] = ni; }
                if (MODE != 0) { u32x4 w; w.x = cvt_pk_bf16(sr[4 * jh], sr[4 * jh + 1]); w.y = cvt_pk_bf16(sr[4 * jh + 2], sr[4 * jh + 3]); w.z = cvt_pk_bf16(si[4 * jh], si[4 * jh + 1]); w.w = cvt_pk_bf16(si[4 * jh + 2], si[4 * jh + 3]);
                    y = __builtin_amdgcn_mfma_f32_16x16x32_bf16(cmt[jh], as_bf16x8(w), y, 0, 0, 0); }
            }
            if (MODE != 0) {
                const u32x2 uw = __builtin_bit_cast(u32x2, ucur);
                const f32x4 uf = (f32x4){bf_lo(uw.x), bf_hi(uw.x), bf_lo(uw.y), bf_hi(uw.y)};
                y += dv * uf;
                u32x2 zo; zo.x = cvt_pk_bf16(gelu_tanh(y[0]), gelu_tanh(y[1])); zo.y = cvt_pk_bf16(gelu_tanh(y[2]), gelu_tanh(y[3]));
                *(u32x2*)(zb + (row0 + t) * SSMW + 16 * g + 4 * q) = zo;
            }
            __builtin_amdgcn_sched_barrier(0);
        }
#pragma unroll
        for (int i = 0; i < UB; ++i) ub[i] = un[i];
    }
    if (MODE == 0) {
        f32x2* e = SE + (((size_t)b * SSM_NCH + chunk) * SG + g) * SN + 16 * q;
#pragma unroll
        for (int m = 0; m < 16; ++m) e[m] = (f32x2){sr[m], si[m]};
    }
    if (MODE == 2) {
#pragma unroll
        for (int m = 0; m < 16; ++m) { ore[((size_t)b * SG + g) * SN + 16 * q + m] = sr[m]; oim[((size_t)b * SG + g) * SN + 16 * q + m] = si[m]; }
    }
}
__device__ __forceinline__ void ssm_carry(int idx  , const float* __restrict__ a32, const f32x2* __restrict__ SE, f32x2* __restrict__ SIN, float* __restrict__ ore, float* __restrict__ oim) {
    const int b = idx >> 11, gn = idx & 2047;
    const f32x2 a = *(const f32x2*)(a32 + (size_t)gn * 2);
    float sr = 0.f, si = 0.f;
#pragma unroll 1
    for (int jb = 0; jb < SSM_NCH; jb += 16) {
        f32x2 e[16];
#pragma unroll
        for (int i = 0; i < 16; ++i) e[i] = SE[((size_t)b * SSM_NCH + jb + i) * (SG * SN) + gn];
#pragma unroll
        for (int i = 0; i < 16; ++i) { SIN[((size_t)b * SSM_NCH + jb + i) * (SG * SN) + gn] = (f32x2){sr, si}; const float nr = a.x * sr - a.y * si + e[i].x, ni = a.x * si + a.y * sr + e[i].y; sr = nr; si = ni; }
    }
    ore[(size_t)b * (SG * SN) + gn] = sr; oim[(size_t)b * (SG * SN) + gn] = si;
}
__device__ __forceinline__ void ssm_constants(int gn, const float* __restrict__ a_re, const float* __restrict__ a_im, const float* __restrict__ log_dt, const float* __restrict__ b_re, const float* __restrict__ b_im,
                                              const float* __restrict__ c_re, const float* __restrict__ c_im, unsigned char* __restrict__ ssc) {
    const int g = gn >> 6, n = gn & 63;
    double dt, dum; cexp_d((double)log_dt[g], 0.0, 10, dt, dum);
    const double lr = (double)a_re[gn], li = (double)a_im[gn];
    double abr, abi; cexp_d(lr * dt, li * dt, 10, abr, abi);
    double p32r = abr, p32i = abi;
#pragma unroll 1
    for (int i = 0; i < 5; ++i) { const double nr = p32r * p32r - p32i * p32i, ni = 2.0 * p32r * p32i; p32r = nr; p32i = ni; }
    const double den = lr * lr + li * li;
    const double fr = ((abr - 1.0) * lr + abi * li) / den, fi = (abi * lr - (abr - 1.0) * li) / den;
    float* ab = (float*)(ssc + SSC_ABAR) + (size_t)gn * 2; ab[0] = (float)abr; ab[1] = (float)abi;
    float* a3 = (float*)(ssc + SSC_A32) + (size_t)gn * 2; a3[0] = (float)p32r; a3[1] = (float)p32i;
    bf16_t* bbt = (bf16_t*)(ssc + SSC_BBT); bf16_t* cmt = (bf16_t*)(ssc + SSC_CMT);
    const int qq = n >> 4, jh = (n >> 2) & 3, i = n & 3;
#pragma unroll
    for (int ri = 0; ri < 2; ++ri) {
        const int rowl = 16 * (2 * jh + ri) + 4 * qq + i;
        const int kap = 32 * jh + 8 * qq + 4 * ri + i;
#pragma unroll 1
        for (int c = 0; c < 16; ++c) {
            const double br = (double)b_re[(size_t)gn * 16 + c], bi = (double)b_im[(size_t)gn * 16 + c];
            const double v = ri == 0 ? (fr * br - fi * bi) : (fr * bi + fi * br);
            bbt[((size_t)g * 128 + rowl) * 16 + c] = (bf16_t)(cvt_pk_bf16((float)v, 0.f) & 0xffffu);
            const float cv = ri == 0 ? c_re[((size_t)g * 16 + c) * 64 + n] : -c_im[((size_t)g * 16 + c) * 64 + n];
            cmt[((size_t)g * 16 + c) * 128 + kap] = (bf16_t)(cvt_pk_bf16(cv, 0.f) & 0xffffu);
        }
    }
}
namespace att {
constexpr int D = 128, NW = 8, QBLK = 32, KVBLK = 64, QB = NW * QBLK;
constexpr int SHM_V = KVBLK * D * 2, SHM_K = KVBLK * D * 2;
constexpr int LDS_BYTES_ATT = 2 * SHM_V + 2 * SHM_K + NW * 64 * 4;
constexpr int QS = 1024, KS = 256;
constexpr float SCALE = 0.08838834764831845f, THR = 8.f;
#define KSWZ(row, colB) ((row) * 256 + ((colB) ^ (((row) & 7) << 4)))
#define SBAR() __builtin_amdgcn_sched_barrier(0)
__device__ __forceinline__ int v_st(int k, int c) { const int kk = (k & ~0xC) | ((k & 4) << 1) | ((k & 8) >> 1); return ((kk >> 3) * 4 + (c >> 5)) * 512 + ((kk & 7) * 32 + (c & 31)) * 2; }
__device__ __forceinline__ int v_rd_base(int lane) { return ((lane & 3) << 3) | (((lane >> 2) & 3) << 6) | (((lane >> 4) & 1) << 5) | (((lane >> 5) & 1) << 8); }
constexpr int v_rd_off(int d0, int ks, int half) { return d0 * 512 + ks * 4096 + half * 2048; }
__device__ __forceinline__ int crow(int r, int hi) { return (r & 3) + 8 * (r >> 2) + 4 * hi; }
__device__ __forceinline__ bf16x8 load8(const bf16_t* p) { return *reinterpret_cast<const bf16x8*>(p); }
__device__ __forceinline__ void mask_bits(f32x16& p0, f32x16& p1, u64 w, int hi) {
    const float NEG = -__builtin_inff();
    const unsigned lo = (unsigned)w >> (4 * hi), hh = (unsigned)(w >> 32) >> (4 * hi);
#pragma unroll
    for (int r = 0; r < 16; ++r) {
        const int c = (r & 3) + 8 * (r >> 2);
        if (!((lo >> c) & 1u)) p0[r] = NEG;
        if (!((hh >> c) & 1u)) p1[r] = NEG;
    }
}
__device__ __forceinline__ void partialSM(f32x16& p0, f32x16& p1, float& m_reg, float& mn, float& alpha) {
    float pmax = p0[0]; for (int r = 1; r < 16; ++r) pmax = fmaxf(pmax, p0[r]); for (int r = 0; r < 16; ++r) pmax = fmaxf(pmax, p1[r]);
    { auto rr = __builtin_amdgcn_permlane32_swap(__float_as_uint(pmax), __float_as_uint(pmax), false, false);
      pmax = fmaxf(__uint_as_float(rr[0]), __uint_as_float(rr[1])); }
    constexpr float C2 = 1.4426950408889634f * SCALE;
    if (__builtin_expect(__all((pmax - m_reg) * SCALE <= THR), 1)) { mn = m_reg; alpha = 1.f; }
    else { mn = fmaxf(m_reg, pmax); alpha = __builtin_amdgcn_exp2f((m_reg - mn) * C2); m_reg = mn; }
    const float mnL = -mn * C2;
    for (int r = 0; r < 16; ++r) p0[r] = fmaf(p0[r], C2, mnL); for (int r = 0; r < 16; ++r) p1[r] = fmaf(p1[r], C2, mnL);
    for (int r = 0; r < 16; ++r) p0[r] = __builtin_amdgcn_exp2f(p0[r]);
}
__device__ __forceinline__ void finishSM(f32x16& p0, f32x16& p1, float alpha, float& l_reg, bf16x8& pa0, bf16x8& pa1, bf16x8& pa2, bf16x8& pa3) {
    for (int r = 0; r < 16; ++r) p1[r] = __builtin_amdgcn_exp2f(p1[r]);
    float ps = 0; for (int r = 0; r < 16; ++r) ps += p0[r]; for (int r = 0; r < 16; ++r) ps += p1[r];
    { auto rr = __builtin_amdgcn_permlane32_swap(__float_as_uint(ps), __float_as_uint(ps), false, false);
      ps = __uint_as_float(rr[0]) + __uint_as_float(rr[1]); }
    l_reg = l_reg * alpha + ps;
#define PK4(P, B_, OUT) do { unsigned a0 = cvt_pk_bf16(P[B_+0], P[B_+1]), a1 = cvt_pk_bf16(P[B_+2], P[B_+3]);                          \
        unsigned b0 = cvt_pk_bf16(P[B_+4], P[B_+5]), b1 = cvt_pk_bf16(P[B_+6], P[B_+7]);                                             \
        auto r0 = __builtin_amdgcn_permlane32_swap(a0, b0, false, false); auto r1 = __builtin_amdgcn_permlane32_swap(a1, b1, false, false); \
        u32x4 w = {r0[0], r1[0], r0[1], r1[1]}; OUT = *reinterpret_cast<bf16x8*>(&w); } while (0)
    PK4(p0, 0, pa0); PK4(p0, 8, pa1); PK4(p1, 0, pa2); PK4(p1, 8, pa3);
#undef PK4
}
template <int KB>
__device__ __forceinline__ void qkt(f32x16& p0, f32x16& p1, const char* K_lds, int r32, int hi, const bf16x8* qr) {
    p0 = f32x16{}; p1 = f32x16{};
    const char* kb[4];
#pragma unroll
    for (int dd = 0; dd < 4; ++dd) kb[dd] = K_lds + KB * SHM_K + KSWZ(r32, (dd * 16 + hi * 8) * 2);
#pragma unroll
    for (int d0 = 0; d0 < 8; ++d0) { const char* a = kb[d0 & 3] + (d0 >> 2) * 128;
        bf16x8 b0 = *reinterpret_cast<const bf16x8*>(a);
        bf16x8 b1 = *reinterpret_cast<const bf16x8*>(a + 32 * 256);
        p0 = __builtin_amdgcn_mfma_f32_32x32x16_bf16(b0, qr[d0], p0, 0, 0, 0);
        p1 = __builtin_amdgcn_mfma_f32_32x32x16_bf16(b1, qr[d0], p1, 0, 0, 0); }
}
typedef short s16x4 __attribute__((ext_vector_type(4)));
template <int VB>
__device__ __forceinline__ void pv_tile(f32x16* o, int vb0, bf16x8 pa0, bf16x8 pa1, bf16x8 pa2, bf16x8 pa3) {
#define TRRD(dst, off) asm volatile("ds_read_b64_tr_b16 %0, %1 offset:%2" : "=&v"(dst) : "v"(vb0), "i"(off) : "memory")
#define PV_D0(d0) do { s16x4 l0, l1, l2, l3, h0, h1, h2, h3; constexpr int b_ = VB * SHM_V + v_rd_off(d0, 0, 0); \
        TRRD(l0, b_); TRRD(h0, b_ + 2048); TRRD(l1, b_ + 4096); TRRD(h1, b_ + 6144); TRRD(l2, b_ + 8192); TRRD(h2, b_ + 10240); TRRD(l3, b_ + 12288); TRRD(h3, b_ + 14336); \
        asm volatile("s_waitcnt lgkmcnt(0)" ::: "memory"); SBAR();   \
        o[d0] = __builtin_amdgcn_mfma_f32_32x32x16_bf16(pa0, (bf16x8){l0[0], l0[1], l0[2], l0[3], h0[0], h0[1], h0[2], h0[3]}, o[d0], 0, 0, 0);   \
        o[d0] = __builtin_amdgcn_mfma_f32_32x32x16_bf16(pa1, (bf16x8){l1[0], l1[1], l1[2], l1[3], h1[0], h1[1], h1[2], h1[3]}, o[d0], 0, 0, 0);   \
        o[d0] = __builtin_amdgcn_mfma_f32_32x32x16_bf16(pa2, (bf16x8){l2[0], l2[1], l2[2], l2[3], h2[0], h2[1], h2[2], h2[3]}, o[d0], 0, 0, 0);   \
        o[d0] = __builtin_amdgcn_mfma_f32_32x32x16_bf16(pa3, (bf16x8){l3[0], l3[1], l3[2], l3[3], h3[0], h3[1], h3[2], h3[3]}, o[d0], 0, 0, 0); } while (0)
    PV_D0(0); PV_D0(1); PV_D0(2); PV_D0(3);
#undef PV_D0
#undef TRRD
}
struct BlockRef { const bf16_t* Q; const bf16_t* K; const bf16_t* V; bf16_t* O; const u64* MB; int P0; };
struct Seam { bf16x8 qr[8]; bf16x8 st_v0, st_v1, st_k0, st_k1; };
#define ROWK(p, k0, rr) ((p) + (size_t)((k0) + (rr)) * KS + sc)
#define VMW() asm volatile("s_waitcnt vmcnt(0)" ::: "memory")
#define VMWN(n) asm volatile("s_waitcnt vmcnt(%0)" :: "i"(n) : "memory")
#define SLOAD_H(Kp, Vp, k0) do { S.st_v0 = load8(ROWK(Vp, k0, sr)); S.st_v1 = load8(ROWK(Vp, k0, 32 + sr));              \
                         S.st_k0 = load8(ROWK(Kp, k0, sr)); S.st_k1 = load8(ROWK(Kp, k0, 32 + sr)); } while (0)
#define SWRITE_HK(bf) do { *(bf16x8*)(K_lds + (bf) * SHM_K + kws) = S.st_k0; *(bf16x8*)(K_lds + (bf) * SHM_K + kws + 32 * 256) = S.st_k1; } while (0)
#define SWRITE_HV(bf) do { *(bf16x8*)(V_lds + (bf) * SHM_V + vst0) = S.st_v0; *(bf16x8*)(V_lds + (bf) * SHM_V + vst1) = S.st_v1; } while (0)
#define SWRITE_H(bf) do { SWRITE_HV(bf); SWRITE_HK(bf); } while (0)
__device__ __forceinline__ void attn_prime(const BlockRef& cur, char* lds, Seam& S) {
    const int tid = threadIdx.x, wid = __builtin_amdgcn_readfirstlane(tid >> 6), lane = tid & 63, r32 = lane & 31, hi = lane >> 5;
    const int sr = tid >> 4, sc = (tid & 15) * 8, kws = KSWZ(sr, sc * 2); char* K_lds = lds + 2 * SHM_V;
    for (int d0 = 0; d0 < 8; ++d0) S.qr[d0] = load8(cur.Q + (size_t)(wid * QBLK + r32) * QS + d0 * 16 + hi * 8);
    SLOAD_H(cur.K, cur.V, 0); VMW(); SWRITE_HK(0);
    __syncthreads();
}
__device__ __forceinline__ void attn_block(const BlockRef& cur, const BlockRef& nxt, char* lds, Seam& S) {
    const int tid = threadIdx.x, wid = __builtin_amdgcn_readfirstlane(tid >> 6), lane = tid & 63, r32 = lane & 31, hi = lane >> 5;
    const int NT = cur.P0 / KVBLK + QB / KVBLK;
    char* V_lds = lds; char* K_lds = lds + 2 * SHM_V;
    float* ws = (float*)(lds + 2 * SHM_V + 2 * SHM_K) + wid * 64; float* li_l = ws, * al_l = ws + 32;
    float m_reg = -1e30f, l_reg = 0; f32x16 o[4] = {};
    const int sr = tid >> 4, sc = (tid & 15) * 8, vst0 = v_st(sr, sc), vst1 = v_st(32 + sr, sc), kws = KSWZ(sr, sc * 2);
    const int vb0 = (int)(uintptr_t)V_lds + v_rd_base(lane);
    const bf16_t* Kh = cur.K; const bf16_t* Vh = cur.V;
    const u64* mrow = cur.MB + (size_t)(wid * QBLK + r32) * 32;
    u64 mw;
#define RESC(a) do { if (__any((a) < 1.f)) { if (hi == 0) al_l[r32] = (a); asm volatile("s_waitcnt lgkmcnt(0)" ::: "memory");              \
                     for (int d_ = 0; d_ < 4; ++d_) for (int r = 0; r < 16; ++r) o[d_][r] *= al_l[crow(r, hi)]; } } while (0)
#define KBASE(t) ((t) * KVBLK)
    constexpr int NQL = 8;
#define SEAM_K0() do { VMWN(NQL); SWRITE_HK(0); SBAR(); } while (0)
    f32x16 pA0, pA1, pB0, pB1; float mnA, mnB, alA, alB; bf16x8 pa0, pa1, pa2, pa3;
    SWRITE_HV(0); SBAR();
    if (NT > 1) { SLOAD_H(Kh, Vh, KBASE(1)); }
    mw = mrow[0];
    SBAR(); qkt<0>(pA0, pA1, K_lds, r32, hi, S.qr);
    mask_bits(pA0, pA1, mw, hi); partialSM(pA0, pA1, m_reg, mnA, alA);
    if (NT > 1) { VMW(); SWRITE_H(1); }
    __syncthreads();
#define HALF_STEP(PX0, PX1, mnX, alX, PY0, PY1, alY, t, KB, VB, SB) do {                                                      \
        SBAR(); mw = mrow[(t)]; qkt<KB>(PX0, PX1, K_lds, r32, hi, S.qr);                                             \
        finishSM(PY0, PY1, alY, l_reg, pa0, pa1, pa2, pa3); SBAR();                                                           \
        if ((t) + 1 < NT) { SLOAD_H(Kh, Vh, KBASE((t) + 1)); SBAR(); }                                               \
        pv_tile<VB>(o, vb0, pa0, pa1, pa2, pa3); mask_bits(PX0, PX1, mw, hi); partialSM(PX0, PX1, m_reg, mnX, alX);                                        \
        __syncthreads();                                                                                                      \
        if ((t) + 1 < NT) { VMW(); SWRITE_H(SB); }                                                                          \
        RESC(alX); __syncthreads(); } while (0)
    for (int t = 1; t + 1 < NT; t += 2) {
        HALF_STEP(pB0, pB1, mnB, alB, pA0, pA1, alA, t, 1, 0, 0);
        HALF_STEP(pA0, pA1, mnA, alA, pB0, pB1, alB, t + 1, 0, 1, 1);
    }
    SBAR(); mw = mrow[NT - 1]; qkt<1>(pB0, pB1, K_lds, r32, hi, S.qr); SBAR();
    SLOAD_H(nxt.K, nxt.V, 0); SBAR();
#pragma unroll
    for (int d0 = 0; d0 < 8; ++d0) S.qr[d0] = load8(nxt.Q + (size_t)(wid * QBLK + r32) * QS + d0 * 16 + hi * 8);
    SBAR();
    finishSM(pA0, pA1, alA, l_reg, pa0, pa1, pa2, pa3); SBAR();
    pv_tile<0>(o, vb0, pa0, pa1, pa2, pa3);
    mask_bits(pB0, pB1, mw, hi); partialSM(pB0, pB1, m_reg, mnB, alB); __syncthreads(); RESC(alB);
    finishSM(pB0, pB1, alB, l_reg, pa0, pa1, pa2, pa3); SBAR(); pv_tile<1>(o, vb0, pa0, pa1, pa2, pa3);
    SBAR(); SEAM_K0();
    if (hi == 0) li_l[r32] = l_reg; asm volatile("s_waitcnt lgkmcnt(0)" ::: "memory");
    float rli[16];
#pragma unroll
    for (int r = 0; r < 16; ++r) rli[r] = __builtin_amdgcn_rcpf(li_l[crow(r, hi)]);
    bf16_t* Ow = cur.O + (size_t)(wid * QBLK) * QS;
#pragma unroll
    for (int r = 0; r < 16; ++r) { const int orow = crow(r, hi);
#pragma unroll
        for (int d0 = 0; d0 < 4; ++d0) { const float v = o[d0][r] * rli[r];
            const float vn = __shfl_xor(v, 1);
            if ((r32 & 1) == 0) *(unsigned*)(Ow + (size_t)orow * QS + d0 * 32 + r32) = cvt_pk_bf16(v, vn); } }
    __syncthreads();
#undef RESC
#undef KBASE
#undef SEAM_K0
#undef HALF_STEP
}
#undef ROWK
#undef VMW
#undef VMWN
#undef SLOAD_H
#undef SWRITE_HK
#undef SWRITE_HV
#undef SWRITE_H
#undef KSWZ
}
__device__ __forceinline__ void sample_attn_unit(int u, int tid, int lane, int wave, LAS unsigned char* lds, const bf16_t* __restrict__ qn, const int* __restrict__ sidx, const int* __restrict__ pt,
                                                 const float* __restrict__ ck, const float* __restrict__ cv, const float* __restrict__ out, bf16_t* __restrict__ oatt) {
    const int b = u >> 3, t = (u >> 1) & 3, kvh = u & 1; const size_t row = (size_t)TP + 4 * b + t;
    LAS unsigned char* kv = lds; LAS int* lidx = (LAS int*)(lds + 69632); LAS float* lq = (LAS float*)(lds + 70656); LAS float* lp = (LAS float*)(lds + 72704);
    LAS float* lred = (LAS float*)(lds + 76800); LAS float* lo2 = (LAS float*)(lds + 77056);
    if (tid < 256) lidx[tid] = sidx[(b * 4 + t) * 256 + tid];
    lq[tid] = bf2f(qn[row * 1024 + kvh * 512 + tid]);
    __syncthreads();
#pragma unroll 4
    for (int kk = 0; kk < 32; ++kk) { const int key = wave * 32 + kk; const int idx = lidx[key];
        const float* src = idx < PAST ? ck + (((size_t)pt[b * NPG + (idx >> 7)] * PAGE + (idx & 127)) * 2 + kvh) * 128 : out + O_KS + ((size_t)(b * 4 + idx - PAST) * 2 + kvh) * 128;
        const f32x2 v = *(const f32x2*)(src + 2 * lane); *(LAS unsigned*)(kv + key * 272 + 4 * lane) = cvt_pk_bf16(v.x, v.y); }
    __syncthreads();
    const int key = tid & 255, hp = tid >> 8;
    float s0 = 0.f, s1 = 0.f;
    { const LAS unsigned char* kr = kv + key * 272; const LAS float* q0 = lq + (2 * hp) * 128; const LAS float* q1 = q0 + 128;
#pragma unroll
      for (int c = 0; c < 16; ++c) { const u32x4 w = *(const LAS u32x4*)(kr + 16 * c); f32x4 a, bb; unpack8(w, a, bb);
          const f32x4 qa = *(const LAS f32x4*)(q0 + 8 * c), qb = *(const LAS f32x4*)(q0 + 8 * c + 4), ra = *(const LAS f32x4*)(q1 + 8 * c), rb = *(const LAS f32x4*)(q1 + 8 * c + 4);
          s0 += (a[0] * qa[0] + a[1] * qa[1]) + (a[2] * qa[2] + a[3] * qa[3]) + (bb[0] * qb[0] + bb[1] * qb[1]) + (bb[2] * qb[2] + bb[3] * qb[3]);
          s1 += (a[0] * ra[0] + a[1] * ra[1]) + (a[2] * ra[2] + a[3] * ra[3]) + (bb[0] * rb[0] + bb[1] * rb[1]) + (bb[2] * rb[2] + bb[3] * rb[3]); } }
    s0 *= 0.08838834764831845f; s1 *= 0.08838834764831845f;
    float m0 = s0, m1 = s1;
#pragma unroll
    for (int o = 1; o < 64; o <<= 1) { m0 = fmaxf(m0, __shfl_xor(m0, o)); m1 = fmaxf(m1, __shfl_xor(m1, o)); }
    if (lane == 0) { lred[wave * 2] = m0; lred[wave * 2 + 1] = m1; }
    __syncthreads();
    { const int w0 = hp * 4; m0 = fmaxf(fmaxf(lred[w0 * 2], lred[w0 * 2 + 2]), fmaxf(lred[w0 * 2 + 4], lred[w0 * 2 + 6])); m1 = fmaxf(fmaxf(lred[w0 * 2 + 1], lred[w0 * 2 + 3]), fmaxf(lred[w0 * 2 + 5], lred[w0 * 2 + 7])); }
    const float p0 = __expf(s0 - m0), p1 = __expf(s1 - m1);
    lp[(2 * hp) * 256 + key] = p0; lp[(2 * hp + 1) * 256 + key] = p1;
    const float t0 = wave_sum(p0), t1 = wave_sum(p1);
    if (lane == 0) { lred[16 + wave * 2] = t0; lred[16 + wave * 2 + 1] = t1; }
    __syncthreads();
#pragma unroll 4
    for (int kk = 0; kk < 32; ++kk) { const int ky = wave * 32 + kk; const int idx = lidx[ky];
        const float* src = idx < PAST ? cv + (((size_t)pt[b * NPG + (idx >> 7)] * PAGE + (idx & 127)) * 2 + kvh) * 128 : out + O_VS + ((size_t)(b * 4 + idx - PAST) * 2 + kvh) * 128;
        const f32x2 v = *(const f32x2*)(src + 2 * lane); *(LAS unsigned*)(kv + ky * 256 + 4 * lane) = cvt_pk_bf16(v.x, v.y); }
    __syncthreads();
    const int dp = lane, head = wave & 3, kh = wave >> 2;
    float o0 = 0.f, o1 = 0.f;
#pragma unroll 8
    for (int k = kh * 128; k < kh * 128 + 128; ++k) { const unsigned w = *(const LAS unsigned*)(kv + k * 256 + 4 * dp); const float p = lp[head * 256 + k]; o0 += p * bf_lo(w); o1 += p * bf_hi(w); }
    if (kh == 1) { lo2[head * 128 + 2 * dp] = o0; lo2[head * 128 + 2 * dp + 1] = o1; }
    __syncthreads();
    if (kh == 0) { const int hq = head >> 1, hb = head & 1; const int w0 = hq * 4;
        const float sum = (lred[16 + w0 * 2 + hb] + lred[16 + w0 * 2 + 2 + hb]) + (lred[16 + w0 * 2 + 4 + hb] + lred[16 + w0 * 2 + 6 + hb]);
        const float inv = 1.0f / sum; o0 = (o0 + lo2[head * 128 + 2 * dp]) * inv; o1 = (o1 + lo2[head * 128 + 2 * dp + 1]) * inv;
        *(unsigned*)(oatt + row * 1024 + (kvh * 4 + head) * 128 + 2 * dp) = cvt_pk_bf16(o0, o1); }
    __syncthreads();
}
__device__ __forceinline__ void ld8bf(const bf16_t* p, float (&v)[8]) { const u32x4 a = *(const u32x4*)p; v[0] = bf_lo(a.x); v[1] = bf_hi(a.x); v[2] = bf_lo(a.y); v[3] = bf_hi(a.y); v[4] = bf_lo(a.z); v[5] = bf_hi(a.z); v[6] = bf_lo(a.w); v[7] = bf_hi(a.w); }
__device__ __forceinline__ void ld8f(const float* p, float (&v)[8]) { const f32x4 a = *(const f32x4*)p, b = *(const f32x4*)(p + 4); v[0] = a.x; v[1] = a.y; v[2] = a.z; v[3] = a.w; v[4] = b.x; v[5] = b.y; v[6] = b.z; v[7] = b.w; }
__device__ __forceinline__ void st8f(float* p, const float (&v)[8]) { *(f32x4*)p = (f32x4){v[0], v[1], v[2], v[3]}; *(f32x4*)(p + 4) = (f32x4){v[4], v[5], v[6], v[7]}; }
__device__ __forceinline__ void conv_item(int rblk, int cg, int lane, const bf16_t* __restrict__ up, bf16_t* __restrict__ act, const float* __restrict__ cw, const float* __restrict__ cb,
                                          const float* __restrict__ sconv, float* __restrict__ out) {
    const int col = 512 * cg + 8 * lane; if (col >= DFF) return;
    float wg[3][8], wv[3][8], bg[8], bv[8], g2[8], g1[8], v2[8], v1[8];
#pragma unroll
    for (int j = 0; j < 3; ++j) { ld8f(cw + (size_t)j * DFF2 + col, wg[j]); ld8f(cw + (size_t)j * DFF2 + DFF + col, wv[j]); }
    ld8f(cb + col, bg); ld8f(cb + DFF + col, bv);
    size_t row0; int nrows; int tbase; int b; const bool samp = rblk >= 512;
    if (!samp) { b = rblk >> 5; tbase = (rblk & 31) * 64; row0 = (size_t)b * SEQ + tbase; nrows = 64;
        if (tbase == 0) {
#pragma unroll
            for (int e = 0; e < 8; ++e) { g2[e] = 0.f; g1[e] = 0.f; v2[e] = 0.f; v1[e] = 0.f; } }
        else { ld8bf(up + (row0 - 2) * DFF2 + col, g2); ld8bf(up + (row0 - 1) * DFF2 + col, g1); ld8bf(up + (row0 - 2) * DFF2 + DFF + col, v2); ld8bf(up + (row0 - 1) * DFF2 + DFF + col, v1); } }
    else { b = rblk - 512; tbase = 0; row0 = (size_t)TP + 4 * b; nrows = 4;
        ld8f(sconv + ((size_t)b * 2 + 0) * DFF2 + col, g2); ld8f(sconv + ((size_t)b * 2 + 1) * DFF2 + col, g1); ld8f(sconv + ((size_t)b * 2 + 0) * DFF2 + DFF + col, v2); ld8f(sconv + ((size_t)b * 2 + 1) * DFF2 + DFF + col, v1); }
#pragma unroll 2
    for (int r = 0; r < nrows; ++r) {
        float gc[8], vc[8], a[8];
        ld8bf(up + (row0 + r) * DFF2 + col, gc); ld8bf(up + (row0 + r) * DFF2 + DFF + col, vc);
#pragma unroll
        for (int e = 0; e < 8; ++e) { const float cgt = wg[0][e] * g2[e] + wg[1][e] * g1[e] + wg[2][e] * gc[e] + bg[e]; const float cvl = wv[0][e] * v2[e] + wv[1][e] * v1[e] + wv[2][e] * vc[e] + bv[e]; a[e] = gelu_tanh(cgt) * cvl; }
        u32x4 w; w.x = cvt_pk_bf16(a[0], a[1]); w.y = cvt_pk_bf16(a[2], a[3]); w.z = cvt_pk_bf16(a[4], a[5]); w.w = cvt_pk_bf16(a[6], a[7]);
        *(u32x4*)(act + (row0 + r) * DFF + col) = w;
        const int t = tbase + r;
        if (!samp && t >= SEQ - 2) { float* o = out + O_CVP + ((size_t)b * 2 + (t - (SEQ - 2))) * DFF2; st8f(o + col, gc); st8f(o + DFF + col, vc); }
        if (samp && t >= DT - 2) { float* o = out + O_CVS + ((size_t)b * 2 + (t - (DT - 2))) * DFF2; st8f(o + col, gc); st8f(o + DFF + col, vc); }
#pragma unroll
        for (int e = 0; e < 8; ++e) { g2[e] = g1[e]; g1[e] = gc[e]; v2[e] = v1[e]; v1[e] = vc[e]; }
    }
}
constexpr int NPH = 13;
#ifndef MK_REP
#define MK_REP {1,1,1,1,1,1,1,1,1,1,1,1,1}
#endif
__device__ constexpr int kRep[NPH] = MK_REP;
#ifndef MK_N_LAUNCHES
#define MK_N_LAUNCHES 1
#endif
#ifndef MUL_TA
#define MUL_TA 1
#endif
#ifndef MUL_SSMA
#define MUL_SSMA 1
#endif
#ifndef MUL_SEL
#define MUL_SEL 1
#endif
#ifndef MUL_SSMC
#define MUL_SSMC 1
#endif
#ifndef MUL_ATT
#define MUL_ATT 1
#endif
#ifndef MUL_SATT
#define MUL_SATT 1
#endif
#ifndef MUL_CONV
#define MUL_CONV 1
#endif
#ifndef MUL_IDXP
#define MUL_IDXP 1
#endif
#ifndef MUL_IDXS
#define MUL_IDXS 1
#endif
#ifndef MUL_CARRY
#define MUL_CARRY 1
#endif
struct Args { const void* in[36]; float* out; unsigned char* ws; int ph_lo, ph_hi, bar_region, pad; };

__global__ void __launch_bounds__(NWAVES * 64, 2) fwd(Args args) {
    extern __shared__ __attribute__((aligned(16))) unsigned char lds_raw[];
    LAS unsigned char* lds = (LAS unsigned char*)lds_raw;
    const int tid = threadIdx.x, lane = tid & 63, wave = __builtin_amdgcn_readfirstlane(tid >> 6);
    const int G = gridDim.x; const int bx = blockIdx.x; const int vcu = (G % 8 == 0) ? (bx % 8) * (G / 8) + bx / 8 : bx;
    const int gw = vcu * NWAVES + wave, NGW = G * NWAVES;
    unsigned char* ws = args.ws; float* out = args.out;
    const float* x_p = (const float*)args.in[0]; const float* x_s = (const float*)args.in[1];
    const float* cache_k = (const float*)args.in[2]; const float* cache_v = (const float*)args.in[3]; const float* cache_ik = (const float*)args.in[4];
    const float* st_re = (const float*)args.in[5]; const float* st_im = (const float*)args.in[6]; const float* st_conv = (const float*)args.in[7];
    const int* ptab = (const int*)args.in[8]; const float* p_p = (const float*)args.in[9]; const float* p_s = (const float*)args.in[10];
    const float* g_mix = (const float*)args.in[11]; const float* w_in = (const float*)args.in[12]; const float* g_q = (const float*)args.in[13]; const float* g_k = (const float*)args.in[14];
    const float* a_re = (const float*)args.in[15]; const float* a_im = (const float*)args.in[16]; const float* log_dt = (const float*)args.in[17];
    const float* sb_re = (const float*)args.in[18]; const float* sb_im = (const float*)args.in[19]; const float* sc_re = (const float*)args.in[20]; const float* sc_im = (const float*)args.in[21];
    const float* ssm_d = (const float*)args.in[22]; const float* w_glu = (const float*)args.in[23]; const float* w_att = (const float*)args.in[24]; const float* w_ssm = (const float*)args.in[25];
    const float* w_o = (const float*)args.in[26]; const float* g_ffn = (const float*)args.in[27]; const float* w_up = (const float*)args.in[28]; const float* conv_w = (const float*)args.in[29];
    const float* conv_b = (const float*)args.in[30]; const float* w_down = (const float*)args.in[31]; const float* w_ple = (const float*)args.in[32]; const float* g_ple = (const float*)args.in[33];
    const float* g_pg = (const float*)args.in[34]; const float* w_pg = (const float*)args.in[35];
    float* RT = (float*)(ws + WS_RT); unsigned char* SSC = ws + WS_SSC;
    bf16_t* WIN = (bf16_t*)(ws + WS_WIN); bf16_t* WGLU = (bf16_t*)(ws + WS_WGLU); bf16_t* WATT = (bf16_t*)(ws + WS_WATT); bf16_t* WSSM = (bf16_t*)(ws + WS_WSSM); bf16_t* WO = (bf16_t*)(ws + WS_WO);
    bf16_t* WUP = (bf16_t*)(ws + WS_WUP); bf16_t* WDN = (bf16_t*)(ws + WS_WDN); bf16_t* WPLE = (bf16_t*)(ws + WS_WPLE); bf16_t* WPG = (bf16_t*)(ws + WS_WPG);
    bf16_t* H = (bf16_t*)(ws + WS_H); bf16_t* PBF = (bf16_t*)(ws + WS_PBF); bf16_t* PLER = (bf16_t*)(ws + WS_PLER); float* RS0 = (float*)(ws + WS_RSP); float* SSQ1 = (float*)(ws + WS_RSP + 262144); float* SSQ2 = (float*)(ws + WS_RSP + 524288); float* SSQP = (float*)(ws + WS_RSP + 786432);
    bf16_t* PROJ = (bf16_t*)(ws + WS_PROJ); bf16_t* QN = (bf16_t*)(ws + WS_QN); bf16_t* KN = (bf16_t*)(ws + WS_KN); bf16_t* VB = (bf16_t*)(ws + WS_VB); bf16_t* IQ = (bf16_t*)(ws + WS_IQ);
    bf16_t* IKR = (bf16_t*)(ws + WS_IKR); float* IW = (float*)(ws + WS_IW); float* SC = (float*)(ws + WS_SC); float* SSC2 = (float*)(ws + WS_SSC2); u64* BMK = (u64*)(ws + WS_BM); int* SIDX = (int*)(ws + WS_SIDX);
    bf16_t* OATT = (bf16_t*)(ws + WS_OATT); bf16_t* Z = (bf16_t*)(ws + WS_Z); bf16_t* Z2 = (bf16_t*)(ws + WS_Z2); f32x2* SE = (f32x2*)(ws + WS_SE); f32x2* SIN = (f32x2*)(ws + WS_SIN);
    bf16_t* MRG = (bf16_t*)(ws + WS_MRG); bf16_t* UP = (bf16_t*)(ws + WS_UP); bf16_t* ACT = (bf16_t*)(ws + WS_ACT);

    for (int u = tid; u < (LDS_BYTES - LDSCTL_OFF) / 4; u += NWAVES * 64) ((LAS unsigned*)(lds + LDSCTL_OFF))[u] = 0u;
    __syncthreads();
    const int lo = args.ph_lo, hi = args.ph_hi;
    XcdBarrier bar; bar.bar = (unsigned*)(ws + WS_CTL) + CW_BAR + args.bar_region * XCD_BAR_WORDS; bar.x = 0; bar.st = nullptr;
    if (hi - lo > 1) bar = xcd_barrier_post((unsigned*)(ws + WS_CTL) + CW_BAR + args.bar_region * XCD_BAR_WORDS, (volatile LAS unsigned*)(lds + MISC_OFF) + 8);
#define IN(k) (lo <= (k) && (k) < hi)
#define SEAM(k) do { if (IN(k) && IN((k) + 1)) xcd_barrier(bar); } while (0)
#define XROW(m) ((m) < TP ? x_p + (size_t)(m) * DM : x_s + (size_t)((m) - TP) * DM)
    const SsmConst sscn{(const float*)(SSC + SSC_ABAR), (const float*)(SSC + SSC_A32), (const bf16_t*)(SSC + SSC_BBT), (const bf16_t*)(SSC + SSC_CMT)};

    if (IN(0)) for (int rep_ = 0; rep_ < kRep[0]; ++rep_) {
        LAS float* scr = (LAS float*)(lds + wave * 16384);
        constexpr int I0 = (DM / 64) * (INWP / 32), I1 = (512 / 64) * (512 / 32), I2 = (1024 / 64) * (DM / 32), I3 = (512 / 64) * (DM / 32), I4 = (DM / 64) * (DM / 32),
                      I5 = (DM / 64) * (DFF2 / 32), I6 = (DFF / 64) * (DM / 32), I7 = (PLE / 64) * (DM / 32), I8 = (DM / 64) * (DM / 32);
        constexpr int NITEMS = I0 + I1 + I2 + I3 + I4 + I5 + I6 + I7 + I8;
        for (int it = gw; it < NITEMS; it += NGW) {
            int r = it;
            if (r < I0) { transpose_item(w_in, DM, INW, WIN, INWP / 32, scr, r, lane, g_mix); continue; } r -= I0;
            if (r < I1) { transpose_item(w_glu, 512, 512, WGLU, 512 / 32, scr, r, lane); continue; } r -= I1;
            if (r < I2) { transpose_item(w_att, 1024, DM, WATT, DM / 32, scr, r, lane); continue; } r -= I2;
            if (r < I3) { transpose_item(w_ssm, 512, DM, WSSM, DM / 32, scr, r, lane); continue; } r -= I3;
            if (r < I4) { transpose_item(w_o, DM, DM, WO, DM / 32, scr, r, lane); continue; } r -= I4;
            if (r < I5) { transpose_item(w_up, DM, DFF2, WUP, DFF2 / 32, scr, r, lane, g_ffn); continue; } r -= I5;
            if (r < I6) { transpose_item(w_down, DFF, DM, WDN, DM / 32, scr, r, lane); continue; } r -= I6;
            if (r < I7) { transpose_item(w_ple, PLE, DM, WPLE, DM / 32, scr, r, lane); continue; } r -= I7;
            transpose_item(w_pg, DM, DM, WPG, DM / 32, scr, r, lane, g_pg);
        }
        for (int m = gw; m < MR; m += NGW) {
            row_to_bf16_rstd(XROW(m), H + (size_t)m * DM, RS0 + m, lane);
            const float* pr = m < TP ? p_p + (size_t)m * PLE : p_s + (size_t)(m - TP) * PLE;
            const f32x4 v = *((const f32x4*)pr + lane); u32x2 w; w.x = cvt_pk_bf16(v.x, v.y); w.y = cvt_pk_bf16(v.z, v.w); *((u32x2*)(PBF + (size_t)m * PLE) + lane) = w;
        }
        for (int e = gw * 64 + lane; e < (SEQ + DT) * 24; e += NGW * 64) {
            const int pi = e / 24, i = e % 24; const double pos = pi < SEQ ? (double)pi : (double)(PAST + pi - SEQ);
            const double ex = i < 16 ? (double)i / 16.0 : (double)(i - 16) / 8.0; double inv, dum; cexp_d(-ex * 13.122363377404328, 0.0, 10, inv, dum);
            double c, s; cexp_d(0.0, pos * inv, 20, c, s);
            if (i < 16) { RT[pi * 48 + i] = (float)c; RT[pi * 48 + 16 + i] = (float)s; } else { RT[pi * 48 + 32 + (i - 16)] = (float)c; RT[pi * 48 + 40 + (i - 16)] = (float)s; }
        }
        for (int m = gw * 64 + lane; m < MP; m += NGW * 64) { SSQ1[m] = 0.f; SSQ2[m] = 0.f; SSQP[m] = 0.f; }
        for (int gn = gw * 64 + lane; gn < SG * SN; gn += NGW * 64) ssm_constants(gn, a_re, a_im, log_dt, sb_re, sb_im, sc_re, sc_im, SSC);
    }
    SEAM(0);
    if (IN(1)) for (int rep_ = 0; rep_ < kRep[1]; ++rep_) {
        { pg8::Gemm g{H, WIN, MP, INWP, DM, DM}; pg8::StaticOrder S; S.init(MP, INWP, G, bx); EpiStoreBf16<1, false> E{PROJ, INWP, RS0, nullptr};
          pg8::gemm_phase<EpiStoreBf16<1, false>, pg8::StaticOrder, true, true>(lds, g, S, E); }
        { pg8::Gemm g{PBF, WPLE, MP, DM, PLE, PLE}; pg8::StaticOrder S; S.init(MP, DM, G, bx); EpiStoreBf16<0, true> E{PLER, DM, nullptr, SSQP};
          pg8::gemm_phase<EpiStoreBf16<0, true>, pg8::StaticOrder, true, true>(lds, g, S, E); }
    }
    SEAM(1);
    if (IN(2)) for (int rep_ = 0; rep_ < kRep[2]; ++rep_) {
        for (int task_ = gw; task_ < MUL_SSMA * SSM_NCH * SG; task_ += NGW) { const int task = task_ % (SSM_NCH * SG); ssm_task<0>(0, task & 31, task >> 5, lane, sscn, PROJ, ssm_d, SE, SIN, nullptr, nullptr, Z, nullptr, nullptr); }
        { TaRaw Ra, Rb; if (gw < MR) ta_load(gw, lane, PROJ, Ra);
          for (int row_ = gw; row_ < MUL_TA * MR; row_ += NGW) { const int row = row_ % MR; const int nx = row_ + NGW; if (nx < MUL_TA * MR) ta_load(nx % MR, lane, PROJ, Rb); ta_compute(row, lane, Ra, RT, g_q, g_k, QN, KN, VB, IQ, IKR, IW, out); Ra = Rb; } }
    }
    SEAM(2);
    if (IN(3)) for (int rep_ = 0; rep_ < kRep[3]; ++rep_) {
        for (int u_ = vcu; u_ < MUL_IDXP * 256; u_ += G) { const int u = u_ & 255; const int b = u >> 4, y = u & 15; idx_prompt_block(b, y, wave, lane, IQ, IKR, IW, SC); idx_prompt_block(b, 31 - y, wave, lane, IQ, IKR, IW, SC); }
        for (int u_ = vcu; u_ < MUL_IDXS * 512; u_ += G) { const int u = u_ & 511; idx_sample_unit(u >> 4, u & 15, wave, lane, IQ, IKR, IW, cache_ik, ptab, SSC2); }
        if (lane < 16) for (int idx_ = gw * 16 + lane; idx_ < MUL_CARRY * NB * SG * SN; idx_ += NGW * 16) { const int idx = idx_ % (NB * SG * SN); ssm_carry(idx, sscn.a32, SE, SIN, out + O_SRP, out + O_SIP); }
    }
    SEAM(3);
    if (IN(4)) for (int rep_ = 0; rep_ < kRep[4]; ++rep_) {
        for (int r = vcu; r < TS; r += G) select_sample_row(r, tid, lane, wave, SSC2, SIDX, (LAS unsigned*)lds);
        for (int k_ = gw; k_ < MUL_SEL * TP; k_ += NGW) { const int k = k_ % TP; const int b = k >> 11, t0 = k & (SEQ - 1); const int t = (b & 1) ? (SEQ - 1 - t0) : t0; select_prompt_row(__builtin_amdgcn_readfirstlane(b * SEQ + t), lane, SC, BMK); }
        for (int task_ = gw; task_ < MUL_SSMC * (SSM_NCH * SG + 2 * SG); task_ += NGW) { const int task = task_ % (SSM_NCH * SG + 2 * SG);
            if (task < SSM_NCH * SG) ssm_task<1>(0, task & 31, task >> 5, lane, sscn, PROJ, ssm_d, SE, SIN, nullptr, nullptr, Z, nullptr, nullptr);
            else { const int k = task - SSM_NCH * SG; ssm_task<2>(k >> 5, k & 31, 0, lane, sscn, PROJ, ssm_d, SE, SIN, st_re, st_im, Z, out + O_SRS, out + O_SIS); }
        }
    }
    SEAM(4);
    if (IN(5)) for (int rep_ = 0; rep_ < kRep[5]; ++rep_) {
        {
            const int total = MUL_ATT * NB * NH * 4;
            auto mkref = [&](int L_, int pass) { const int L = L_ % (NB * NH * 4); const int gq = L & 3, y = (L >> 2) & 3, kvh = (L >> 4) & 1, b = L >> 5; const int h = kvh * 4 + gq, qb = pass ? 7 - y : y;
                att::BlockRef r; const size_t q0 = ((size_t)b * SEQ + (size_t)qb * 256) * 1024 + h * 128;
                r.Q = QN + q0; r.O = OATT + q0; r.K = KN + (size_t)b * SEQ * 256 + kvh * 128; r.V = VB + (size_t)b * SEQ * 256 + kvh * 128; r.MB = BMK + ((size_t)b * SEQ + (size_t)qb * 256) * 32; r.P0 = qb * 256; return r; };
            int L = vcu;
            if (L < total) {
                int pass = 0; att::BlockRef cur = mkref(L, 0); att::Seam S;
                att::attn_prime(cur, (char*)lds_raw, S);
                for (;;) {
                    const bool more_pass = pass == 0, more_item = L + G < total, last = !more_pass && !more_item;
                    int passn = pass + 1, Ln = L; if (!more_pass) { passn = 0; Ln = more_item ? L + G : L; }
                    const att::BlockRef nxt = last ? cur : mkref(Ln, passn);
                    att::attn_block(cur, nxt, (char*)lds_raw, S);
                    if (last) break;
                    cur = nxt; pass = passn; L = Ln;
                }
            }
            VM_WAIT(); __syncthreads();
        }
        for (int u_ = vcu; u_ < MUL_SATT * 256; u_ += G) { const int u = u_ & 255; sample_attn_unit(u, tid, lane, wave, lds, QN, SIDX, ptab, cache_k, cache_v, out, OATT); }
        { SkGlu Es{Z, Z2}; skinny_gemm(lds, Z, 512, WGLU, 512, 512, Es, vcu, G, wave, lane); }
        { pg8::Gemm g{Z, WGLU, TP, 512, 512, 512}; pg8::StaticOrder S; S.init(TP, 512, G, bx); EpiGlu E{Z, Z2, 512};
          pg8::gemm_phase<EpiGlu, pg8::StaticOrder, true, true>(lds, g, S, E); }
    }
    SEAM(5);
    if (IN(6)) for (int rep_ = 0; rep_ < kRep[6]; ++rep_) { { SkGate<false> Es{PROJ + C_GA, INWP, MRG}; skinny_gemm(lds, OATT, 1024, WATT, 1024, DM, Es, vcu, G, wave, lane); }
        pg8::Gemm g{OATT, WATT, TP, DM, 1024, 1024}; pg8::StaticOrder S; S.init(TP, DM, G, bx); EpiGate<false> E{PROJ + C_GA, INWP, MRG, DM};
        pg8::gemm_phase<EpiGate<false>, pg8::StaticOrder, true, true>(lds, g, S, E); }
    SEAM(6);
    if (IN(7)) { { SkGate<true> Es{PROJ + C_GS, INWP, MRG}; skinny_gemm(lds, Z2, 512, WSSM, 512, DM, Es, vcu, G, wave, lane); }
        pg8::Gemm g{Z2, WSSM, TP, DM, 512, 512}; pg8::StaticOrder S; S.init(TP, DM, G, bx); EpiGate<true> E{PROJ + C_GS, INWP, MRG, DM};
        pg8::gemm_phase<EpiGate<true>, pg8::StaticOrder, true, true>(lds, g, S, E); }
    SEAM(7);
    if (IN(8)) for (int rep_ = 0; rep_ < kRep[8]; ++rep_) { { SkResid Es{H, SSQ1}; skinny_gemm(lds, MRG, DM, WO, DM, DM, Es, vcu, G, wave, lane); }
        pg8::Gemm g{MRG, WO, TP, DM, DM, DM}; pg8::StaticOrder S; S.init(TP, DM, G, bx); EpiResidBf E{H, SSQ1};
        pg8::gemm_phase<EpiResidBf, pg8::StaticOrder, true, true>(lds, g, S, E); }
    SEAM(8);
    if (IN(9)) for (int rep_ = 0; rep_ < kRep[9]; ++rep_) { pg8::Gemm g{H, WUP, MP, DFF2, DM, DM}; pg8::StaticOrder S; S.init(MP, DFF2, G, bx); EpiStoreBf16<2, false> E{UP, DFF2, SSQ1, nullptr};
        pg8::gemm_phase<EpiStoreBf16<2, false>, pg8::StaticOrder, true, true>(lds, g, S, E); }
    SEAM(9);
    if (IN(10)) for (int rep_ = 0; rep_ < kRep[10]; ++rep_) { for (int it_ = gw; it_ < MUL_CONV * (512 + DB) * 11; it_ += NGW) { const int it = it_ % ((512 + DB) * 11); conv_item(it / 11, it % 11, lane, UP, ACT, conv_w, conv_b, st_conv, out); } }
    SEAM(10);
    if (IN(11)) { { SkResid Es{H, SSQ2}; skinny_gemm(lds, ACT, DFF, WDN, DFF, DM, Es, vcu, G, wave, lane); }
        pg8::Gemm g{ACT, WDN, TP, DM, DFF, DFF}; pg8::StaticOrder S; S.init(TP, DM, G, bx); EpiResidBf E{H, SSQ2};
        pg8::gemm_phase<EpiResidBf, pg8::StaticOrder, true, true>(lds, g, S, E); }
    SEAM(11);
    if (IN(12)) { { SkPg Es{out + O_Y, H, PLER, SSQ2, SSQP, g_ple}; skinny_gemm(lds, H, DM, WPG, DM, DM, Es, vcu, G, wave, lane); }
        pg8::Gemm g{H, WPG, TP, DM, DM, DM}; pg8::StaticOrder S; S.init(TP, DM, G, bx); EpiPg E{out + O_Y, H, PLER, SSQ2, SSQP, g_ple};
        pg8::gemm_phase<EpiPg, pg8::StaticOrder, true, true>(lds, g, S, E); }
#undef IN
#undef SEAM
#undef XROW
}

extern "C" void kernel_launch(void* const* d_in, const int* in_sizes, int n_in, void* d_out, int out_size, void* d_ws, size_t ws_size, hipStream_t stream) {
    static int grid = 0;
    if (grid == 0) {
        if (n_in != 36 || out_size != (int)O_END || ws_size < WS_END) { fprintf(stderr, "kernel_launch: unexpected shapes (n_in %d, out %d, ws %zu; want 36, %zu, >= %zu)\n", n_in, out_size, ws_size, (size_t)O_END, (size_t)WS_END); grid = -1; return; }
        int dev = 0, cus = 0, per_cu = 0;
        if (hipGetDevice(&dev) != hipSuccess || hipDeviceGetAttribute(&cus, hipDeviceAttributeMultiprocessorCount, dev) != hipSuccess) { grid = -1; return; }
        if (hipFuncSetAttribute((const void*)fwd, hipFuncAttributeMaxDynamicSharedMemorySize, LDS_BYTES) != hipSuccess) { fprintf(stderr, "kernel_launch: hipFuncSetAttribute failed\n"); grid = -1; return; }
        if (hipOccupancyMaxActiveBlocksPerMultiprocessor(&per_cu, (const void*)fwd, NWAVES * 64, LDS_BYTES) != hipSuccess || per_cu < 1) fprintf(stderr, "kernel_launch: occupancy query reports %d\n", per_cu);
        (void)hipGetLastError();
        grid = cus;
    }
    if (grid < 0) return;
    if (hipMemsetAsync((char*)d_ws + WS_CTL, 0, CTL_ZERO_BYTES, stream) != hipSuccess) return;
    Args a{};
    for (int i = 0; i < 36; ++i) a.in[i] = d_in[i];
    a.out = (float*)d_out; a.ws = (unsigned char*)d_ws;
    const int nl = MK_N_LAUNCHES;
    for (int li = 0; li < nl; ++li) {
        a.ph_lo = (NPH * li) / nl; a.ph_hi = (NPH * (li + 1)) / nl; a.bar_region = li; a.pad = 0;
        hipLaunchKernelGGL(fwd, dim3(grid), dim3(NWAVES * 64), LDS_BYTES, stream, a);
    }
}
```

```cpp
#include <hip/hip_runtime.h>
#include <cstdio>
#include <cstdint>

#define LAS __attribute__((address_space(3)))
#define GAS __attribute__((address_space(1)))
typedef unsigned short bf16_t;
typedef short bf16x8 __attribute__((ext_vector_type(8)));
typedef short bf16x4 __attribute__((ext_vector_type(4)));
typedef float f32x4 __attribute__((ext_vector_type(4)));
typedef float f32x2 __attribute__((ext_vector_type(2)));
typedef float f32x16 __attribute__((ext_vector_type(16)));
typedef unsigned u32x4 __attribute__((ext_vector_type(4)));
typedef unsigned u32x2 __attribute__((ext_vector_type(2)));
typedef unsigned long long u64;

constexpr int DM = 2048, NB = 16, SEQ = 2048, DB = 32, DT = 4, PAST = 16384, PAGE = 128, NPG = 128;
constexpr int TP = NB * SEQ, TS = DB * DT, MR = TP + TS, MP = 33024;
constexpr int NH = 8, NKV = 2, HD = 128, IH = 16, IDD = 64;
constexpr int SSMW = 512, SG = 32, SN = 64;
constexpr int DFF = 5504, DFF2 = 11008, PLE = 256;
constexpr int INW = 7248, INWP = 7424;
constexpr int C_Q = 0, C_K = 1024, C_V = 1280, C_IQ = 1536, C_IK = 2560, C_IW = 2624, C_U = 2640, C_GA = 3152, C_GS = 5200;
constexpr float EPS = 1e-6f, IDX_SCALE = 0.03125f;
constexpr int SSM_L = 32, SSM_NCH = SEQ / SSM_L;
constexpr int SLEN = PAST + DT, SSTR = 16400;

constexpr size_t O_Y = 0;
constexpr size_t O_KP = (size_t)MR * DM;
constexpr size_t O_VP = O_KP + (size_t)TP * 256;
constexpr size_t O_IKP = O_VP + (size_t)TP * 256;
constexpr size_t O_SRP = O_IKP + (size_t)TP * 64;
constexpr size_t O_SIP = O_SRP + (size_t)NB * SG * SN;
constexpr size_t O_CVP = O_SIP + (size_t)NB * SG * SN;
constexpr size_t O_KS = O_CVP + (size_t)NB * 2 * DFF2;
constexpr size_t O_VS = O_KS + (size_t)TS * 256;
constexpr size_t O_IKS = O_VS + (size_t)TS * 256;
constexpr size_t O_SRS = O_IKS + (size_t)TS * 64;
constexpr size_t O_SIS = O_SRS + (size_t)DB * SG * SN;
constexpr size_t O_CVS = O_SIS + (size_t)DB * SG * SN;
constexpr size_t O_END = O_CVS + (size_t)DB * 2 * DFF2;
static_assert(O_END == 87572480, "output size");

constexpr size_t MiB = 1u << 20;
constexpr size_t al(size_t x) { return (x + MiB - 1) & ~(MiB - 1); }
constexpr size_t WS_CTL = 0, CTL_ZERO_BYTES = 65536;
constexpr size_t WS_RT = WS_CTL + MiB;
constexpr size_t WS_SSC = WS_RT + MiB;
constexpr size_t WS_WIN = WS_SSC + MiB;
constexpr size_t WS_WGLU = WS_WIN + al((size_t)INWP * DM * 2);
constexpr size_t WS_WATT = WS_WGLU + al((size_t)512 * 512 * 2);
constexpr size_t WS_WSSM = WS_WATT + al((size_t)DM * 1024 * 2);
constexpr size_t WS_WO = WS_WSSM + al((size_t)DM * 512 * 2);
constexpr size_t WS_WUP = WS_WO + al((size_t)DM * DM * 2);
constexpr size_t WS_WDN = WS_WUP + al((size_t)DFF2 * DM * 2);
constexpr size_t WS_WPLE = WS_WDN + al((size_t)DM * DFF * 2);
constexpr size_t WS_WPG = WS_WPLE + al((size_t)DM * PLE * 2);
constexpr size_t WS_H = WS_WPG + al((size_t)DM * DM * 2);
constexpr size_t WS_PBF = WS_H + al((size_t)MP * DM * 2);
constexpr size_t WS_PLER = WS_PBF + al((size_t)MP * PLE * 2);
constexpr size_t WS_RSP = WS_PLER + al((size_t)MP * DM * 2);
constexpr size_t WS_A0 = WS_RSP + MiB;
constexpr size_t WS_PROJ = WS_A0;
constexpr size_t WS_QN = WS_PROJ + al((size_t)MP * INWP * 2);
constexpr size_t WS_KN = WS_QN + al((size_t)MP * 1024 * 2);
constexpr size_t WS_VB = WS_KN + al((size_t)MP * 256 * 2);
constexpr size_t WS_IQ = WS_VB + al((size_t)MP * 256 * 2);
constexpr size_t WS_IKR = WS_IQ + al((size_t)MP * 1024 * 2);
constexpr size_t WS_IW = WS_IKR + al((size_t)MP * 64 * 2);
constexpr size_t WS_SC = WS_IW + al((size_t)MP * 16 * 4);
constexpr size_t WS_SSC2 = WS_SC + al((size_t)NB * SEQ * SEQ * 4);
constexpr size_t WS_BM = WS_SSC2 + al((size_t)TS * SSTR * 4);
constexpr size_t WS_SIDX = WS_BM + al((size_t)TP * 32 * 8);
constexpr size_t WS_OATT = WS_SIDX + MiB;
constexpr size_t WS_Z = WS_OATT + al((size_t)MP * 1024 * 2);
constexpr size_t WS_Z2 = WS_Z + al((size_t)MP * 512 * 2);
constexpr size_t WS_SE = WS_Z2 + al((size_t)MP * 512 * 2);
constexpr size_t WS_SIN = WS_SE + al((size_t)NB * SSM_NCH * SG * SN * 8);
constexpr size_t WS_MRG = WS_SIN + al((size_t)NB * SSM_NCH * SG * SN * 8);
constexpr size_t WS_A_END = WS_MRG + al((size_t)MP * DM * 2);
constexpr size_t WS_UP = WS_A0;
constexpr size_t WS_ACT = WS_UP + al((size_t)MP * DFF2 * 2);
constexpr size_t WS_B_END = WS_ACT + al((size_t)MP * DFF * 2);
constexpr size_t WS_END = WS_A_END > WS_B_END ? WS_A_END : WS_B_END;
static_assert(WS_END < (size_t)2600 * MiB, "d_ws map too large");
constexpr size_t SSC_ABAR = 0, SSC_A32 = 16384, SSC_BBT = 32768, SSC_CMT = 32768 + 131072, SSC_END = SSC_CMT + 131072;
static_assert(SSC_END <= MiB, "ssc");
constexpr int CW_BAR = 4096;

constexpr int RING_BYTES = 131072;
constexpr int LDSCTL_OFF = RING_BYTES, MISC_OFF = LDSCTL_OFF + 320;
constexpr int LDS_BYTES = 147456;
constexpr int NWAVES = 8;

__device__ __forceinline__ unsigned cvt_pk_bf16(float lo, float hi) { unsigned r; asm volatile("v_cvt_pk_bf16_f32 %0, %1, %2" : "=v"(r) : "v"(lo), "v"(hi)); return r; }
__device__ __forceinline__ float bf_lo(unsigned w) { return __uint_as_float(w << 16); }
__device__ __forceinline__ float bf_hi(unsigned w) { return __uint_as_float(w & 0xffff0000u); }
__device__ __forceinline__ float bf2f(bf16_t x) { return __uint_as_float(((unsigned)x) << 16); }
__device__ __forceinline__ float sigmoidf_(float x) { return __builtin_amdgcn_rcpf(1.0f + __expf(-x)); }
__device__ __forceinline__ float gelu_tanh(float y) { const float t = 1.5957691216057308f * (y + 0.044715f * y * y * y); return y * __builtin_amdgcn_rcpf(1.0f + __expf(-t)); }
__device__ __forceinline__ float wave_sum(float v) {
#pragma unroll
    for (int o = 1; o < 64; o <<= 1) v += __shfl_xor(v, o);
    return v;
}
__device__ __forceinline__ int lane_id_() { int l; asm volatile("v_mbcnt_lo_u32_b32 %0, -1, 0\n\tv_mbcnt_hi_u32_b32 %0, -1, %0" : "=v"(l)); return l; }
#define LDS_WAIT() asm volatile("s_waitcnt lgkmcnt(0)" ::: "memory")
#define VM_WAIT() asm volatile("s_waitcnt vmcnt(0)" ::: "memory")
namespace pg8 {
#define PG8_LAS __attribute__((address_space(3)))
constexpr int BM = 256, BK = 64, HALF = 128, HTB = HALF * BK * 2  , STAGE_BYTES = 8 * HTB, NXCD = 8;

__host__ __device__ __forceinline__ int lds_byte(int r, int c) { const int st = (r >> 4) * 2 + (c >> 5), rr = r & 15, cc = c & 31, ob = rr * 64 + cc * 2; return st * 1024 + (ob ^ (((ob >> 9) & 1) << 5)); }
__host__ __device__ __forceinline__ void stage_rc(int b, int& R, int& C) { const int st = b / 1024, sb = b % 1024, swz = sb ^ (((sb >> 9) & 1) << 5); R = (st >> 1) * 16 + swz / 64; C = (st & 1) * 32 + (swz % 64) / 2; }
__host__ __device__ __forceinline__ int perm32(int rho) { const int n = rho >> 4, i = rho & 15; return 8 * (i >> 2) + 4 * n + (i & 3); }

struct Unit { int pm, pn; };
struct Gemm { const bf16_t* A; const bf16_t* Bt; int M, N, K, lda, tag; };

struct StaticOrder {
    int nM, nN, nwg, G, c, WGM;
    __host__ __device__ void init(int M, int N, int G_, int c_, int wgm = 2) { nM = M / BM; nN = N / BM; nwg = nM * nN; G = G_; c = c_; WGM = wgm; }
    __host__ __device__ bool next(int i, Unit& u) const {
        const long L = (long)i * G + c; if (L >= nwg) return false;
        int wgid = (int)L; { const int q = nwg / NXCD, r = nwg % NXCD, xcd = wgid % NXCD, off = wgid / NXCD; wgid = (xcd < r ? xcd * (q + 1) : r * (q + 1) + (xcd - r) * q) + off; }
        const int nig = WGM * nN, gid = wgid / nig, fm = gid * WGM, gsz = (nM - fm) < WGM ? (nM - fm) : WGM;
        u.pm = fm + ((wgid % nig) % gsz); u.pn = (wgid % nig) / gsz; return true;
    }
    __device__ __forceinline__ void a_ready(const Unit&) const {}
    __device__ __forceinline__ void done(const Unit&) const {}
};
template <class Epi, class Sched, bool ALIGN_EPI = false, bool SP2 = false>
__device__ __forceinline__ void gemm_phase(PG8_LAS unsigned char* lds, const Gemm g, const Sched& S, const Epi& E, int wid) {
    const int lane = lane_id_(), tid = wid * 64 + lane, wr = wid >> 2, wc = wid & 3, fr = lane & 15, fq = lane >> 4;
    const int K = g.K, nt = K / BK;
    unsigned voffA[2], voffB[2];
#pragma unroll
    for (int i = 0; i < 2; ++i) { int R, C; stage_rc(tid * 16 + i * 8192, R, C); const int Rb = Epi::PERM ? ((R >> 5) * 64 + perm32(R & 31)) : R;
        voffA[i] = (unsigned)(R * g.lda + C) * 2u; voffB[i] = (unsigned)(Rb * K + C) * 2u; }
    const size_t kstep = (size_t)(BK * 2);
    const size_t hstepB = (size_t)(Epi::PERM ? 32 : HALF) * K * 2, hstepA = (size_t)HALF * g.lda * 2;
    const size_t tstepB = (size_t)BM * K * 2, tstepA = 2 * hstepA;
    const unsigned ldsw = (unsigned)wid * 1024u;
    const int aoff = lds_byte(wr * 64 + fr, fq * 8), boff = lds_byte(wc * 32 + fr, fq * 8);
#define PG8_SA(b, h) (((b) * 2 + (h)) * HTB)
#define PG8_SB(b, h) ((4 + (b) * 2 + (h)) * HTB)
#define PG8_STAGE(bufoff, gbase, voff) do { _Pragma("unroll") for (int _i = 0; _i < 2; ++_i) \
        __builtin_amdgcn_global_load_lds((const unsigned*)((const char*)(gbase) + (voff)[_i]), (PG8_LAS unsigned*)(lds + (bufoff) + ldsw + _i * 8192), 16, 0, 0); } while (0)
#define PG8_LDA(dst, b, h) do { _Pragma("unroll") for (int m = 0; m < 4; ++m) _Pragma("unroll") for (int k = 0; k < 2; ++k) dst[m][k] = *(const PG8_LAS bf16x8*)(lds + PG8_SA(b, h) + aoff + m * 2048 + k * 1024); } while (0)
#define PG8_LDB(dst, b, h) do { _Pragma("unroll") for (int n = 0; n < 2; ++n) _Pragma("unroll") for (int k = 0; k < 2; ++k) dst[n][k] = *(const PG8_LAS bf16x8*)(lds + PG8_SB(b, h) + boff + n * 2048 + k * 1024); } while (0)
#define PG8_MMA(ai, bj, At, Bt) do { __builtin_amdgcn_s_setprio(1); _Pragma("unroll") for (int m = 0; m < 4; ++m) _Pragma("unroll") for (int n = 0; n < 2; ++n) _Pragma("unroll") for (int k = 0; k < 2; ++k) \
        acc[ai][bj][m][n] = __builtin_amdgcn_mfma_f32_16x16x32_bf16(Bt[n][k], At[m][k], acc[ai][bj][m][n], 0, 0, 0); __builtin_amdgcn_s_setprio(0); } while (0)
#define PG8_WAIT_V(n) asm volatile("s_waitcnt vmcnt(" #n ")" ::: "memory")
#define PG8_WAIT_L(n) asm volatile("s_waitcnt lgkmcnt(" #n ")" ::: "memory")
#define PG8_BAR __builtin_amdgcn_s_barrier()
#define PG8_SCHED __builtin_amdgcn_sched_barrier(0)
    Unit cur, nxt; int ui = 0;
    if (!S.next(0, cur)) return;
    f32x4 acc[2][2][4][2];
#pragma unroll
    for (int a = 0; a < 2; ++a)
#pragma unroll
        for (int b = 0; b < 2; ++b)
#pragma unroll
            for (int m = 0; m < 4; ++m)
#pragma unroll
                for (int n = 0; n < 2; ++n) acc[a][b][m][n] = (f32x4){0.f, 0.f, 0.f, 0.f};
    bf16x8 At[4][2], B0[2][2], B1[2][2];
    const char* cA = (const char*)g.A + (size_t)cur.pm * tstepA; const char* cB = (const char*)g.Bt + (size_t)cur.pn * tstepB;
    S.a_ready(cur);
    if constexpr (SP2) {
        PG8_STAGE(PG8_SB(0, 0), cB, voffB); PG8_STAGE(PG8_SB(0, 1), cB + hstepB, voffB); PG8_STAGE(PG8_SA(0, 0), cA, voffA); PG8_STAGE(PG8_SA(0, 1), cA + hstepA, voffA);
        if (wr == 1) PG8_BAR;
        PG8_WAIT_V(2); PG8_BAR;
        PG8_STAGE(PG8_SB(1, 0), cB + kstep, voffB); PG8_STAGE(PG8_SA(1, 0), cA + kstep, voffA); PG8_STAGE(PG8_SB(1, 1), cB + hstepB + kstep, voffB);
        PG8_WAIT_V(6); PG8_BAR;
    } else {
        PG8_STAGE(PG8_SB(0, 0), cB, voffB); PG8_STAGE(PG8_SA(0, 0), cA, voffA); PG8_STAGE(PG8_SB(0, 1), cB + hstepB, voffB); PG8_STAGE(PG8_SA(0, 1), cA + hstepA, voffA);
        if (wr == 1) PG8_BAR;
        PG8_WAIT_V(4); PG8_BAR;
        PG8_STAGE(PG8_SB(1, 0), cB + kstep, voffB); PG8_STAGE(PG8_SA(1, 0), cA + kstep, voffA); PG8_STAGE(PG8_SB(1, 1), cB + hstepB + kstep, voffB);
        PG8_WAIT_V(6); PG8_BAR;
    }
    for (;;) {
        const bool has_next = S.next(ui + 1, nxt);
        const char* nA = has_next ? (const char*)g.A + (size_t)nxt.pm * tstepA : cA; const char* nB = has_next ? (const char*)g.Bt + (size_t)nxt.pn * tstepB : cB;
#ifdef PROBE_KLOOP
        const unsigned long long pk_t0 = __builtin_amdgcn_s_memrealtime();
#endif
        for (int t = 0; t < nt; t += 2) {
            const bool last = (t == nt - 2);
            const char* a1 = cA + (size_t)(t + 1) * kstep;
            const char* a2 = last ? nA : cA + (size_t)(t + 2) * kstep; const char* b2 = last ? nB : cB + (size_t)(t + 2) * kstep;
            const char* a3 = a2 + kstep; const char* b3 = b2 + kstep;
            if (last && has_next) S.a_ready(nxt);
            if constexpr (SP2) {
            PG8_LDB(B0, 0, 0); PG8_LDB(B1, 0, 1); PG8_SCHED; PG8_LDA(At, 0, 0); PG8_STAGE(PG8_SA(1, 1), a1 + hstepA, voffA);
            PG8_WAIT_V(8); PG8_WAIT_L(0); PG8_BAR; PG8_MMA(0, 0, At, B0); PG8_MMA(0, 1, At, B1); PG8_BAR; PG8_SCHED;
            PG8_LDA(At, 0, 1); PG8_STAGE(PG8_SB(0, 0), b2, voffB); PG8_STAGE(PG8_SB(0, 1), b2 + hstepB, voffB); PG8_STAGE(PG8_SA(0, 0), a2, voffA);
            PG8_WAIT_V(8); PG8_WAIT_L(0); PG8_BAR; PG8_MMA(1, 0, At, B0); PG8_MMA(1, 1, At, B1); PG8_BAR; PG8_SCHED;
            PG8_LDB(B0, 1, 0); PG8_LDB(B1, 1, 1); PG8_SCHED; PG8_LDA(At, 1, 0); PG8_STAGE(PG8_SA(0, 1), a2 + hstepA, voffA);
            PG8_WAIT_V(8); PG8_WAIT_L(0); PG8_BAR; PG8_MMA(0, 0, At, B0); PG8_MMA(0, 1, At, B1); PG8_BAR; PG8_SCHED;
            PG8_LDA(At, 1, 1); PG8_STAGE(PG8_SB(1, 0), b3, voffB); PG8_STAGE(PG8_SB(1, 1), b3 + hstepB, voffB); PG8_STAGE(PG8_SA(1, 0), a3, voffA);
            PG8_WAIT_V(8); PG8_WAIT_L(0); PG8_BAR; PG8_MMA(1, 0, At, B0); PG8_MMA(1, 1, At, B1); PG8_BAR; PG8_SCHED;
            } else {
            PG8_LDB(B0, 0, 0); PG8_SCHED; PG8_LDA(At, 0, 0); PG8_STAGE(PG8_SA(1, 1), a1 + hstepA, voffA);
            PG8_WAIT_L(8); PG8_BAR; PG8_WAIT_L(0); PG8_MMA(0, 0, At, B0); PG8_BAR; PG8_SCHED;
            PG8_LDB(B1, 0, 1); PG8_STAGE(PG8_SB(0, 0), b2, voffB);
            PG8_BAR; PG8_WAIT_L(0); PG8_MMA(0, 1, At, B1); PG8_BAR;
            PG8_LDA(At, 0, 1); PG8_STAGE(PG8_SA(0, 0), a2, voffA);
            PG8_BAR; PG8_WAIT_L(0); PG8_MMA(1, 0, At, B0); PG8_BAR; PG8_SCHED;
            PG8_STAGE(PG8_SB(0, 1), b2 + hstepB, voffB);
            PG8_WAIT_V(6); PG8_BAR; PG8_MMA(1, 1, At, B1); PG8_BAR;
            PG8_LDB(B0, 1, 0); PG8_SCHED; PG8_LDA(At, 1, 0); PG8_STAGE(PG8_SA(0, 1), a2 + hstepA, voffA);
            PG8_WAIT_L(8); PG8_BAR; PG8_WAIT_L(0); PG8_MMA(0, 0, At, B0); PG8_BAR; PG8_SCHED;
            PG8_LDB(B1, 1, 1); PG8_STAGE(PG8_SB(1, 0), b3, voffB);
            PG8_BAR; PG8_WAIT_L(0); PG8_MMA(0, 1, At, B1); PG8_BAR;
            PG8_LDA(At, 1, 1); PG8_STAGE(PG8_SA(1, 0), a3, voffA);
            PG8_BAR; PG8_WAIT_L(0); PG8_MMA(1, 0, At, B0); PG8_BAR; PG8_SCHED;
            PG8_STAGE(PG8_SB(1, 1), b3 + hstepB, voffB);
            PG8_WAIT_V(6); PG8_BAR; PG8_MMA(1, 1, At, B1); PG8_BAR;
            }
        }
#ifdef PROBE_KLOOP
        if (PROBE_KLOOP == g.tag && tid == 0) *(PG8_LAS unsigned*)(lds + 131072 + 320 + 64) += (unsigned)(__builtin_amdgcn_s_memrealtime() - pk_t0);
#endif
        if constexpr (ALIGN_EPI) { if (wr == 0) PG8_BAR; }
#ifdef PROBE_EPI
        const unsigned long long pe_t0 = __builtin_amdgcn_s_memrealtime();
#endif
        if constexpr (!Epi::AFTER_DRAIN) { E(acc, cur, wr, wc, fr, fq); S.done(cur); }
#ifdef PROBE_EPI
        if (PROBE_EPI == g.tag && tid == 0) *(PG8_LAS unsigned*)(lds + 131072 + 320 + 64) += (unsigned)(__builtin_amdgcn_s_memrealtime() - pe_t0);
#endif
        if (!has_next) break;
#pragma unroll
        for (int a = 0; a < 2; ++a)
#pragma unroll
            for (int b = 0; b < 2; ++b)
#pragma unroll
                for (int m = 0; m < 4; ++m)
#pragma unroll
                    for (int n = 0; n < 2; ++n) acc[a][b][m][n] = (f32x4){0.f, 0.f, 0.f, 0.f};
        cur = nxt; cA = nA; cB = nB; ++ui;
        if constexpr (ALIGN_EPI) { if (wr == 1) PG8_BAR; }
    }
    PG8_WAIT_V(0);
    if constexpr (!ALIGN_EPI) { if (wr == 0) PG8_BAR; }
    PG8_BAR;
    if constexpr (Epi::AFTER_DRAIN) { E.fused(acc, cur, wr, wc, fr, fq, lds, wid, lane); S.done(cur); }
#undef PG8_SA
#undef PG8_SB
#undef PG8_STAGE
#undef PG8_LDA
#undef PG8_LDB
#undef PG8_MMA
#undef PG8_WAIT_V
#undef PG8_WAIT_L
#undef PG8_BAR
#undef PG8_SCHED
}
}
#define EPI_ROWS_BEGIN  _Pragma("unroll") for (int ai = 0; ai < 2; ++ai) _Pragma("unroll") for (int m = 0; m < 4; ++m) { const int row = u.pm * 256 + ai * 128 + wr * 64 + m * 16 + fr;
#define EPI_ROWS_END    }
__device__ __forceinline__ u32x4 pack8(const f32x4 a, const f32x4 b) { u32x4 w; w.x = cvt_pk_bf16(a[0], a[1]); w.y = cvt_pk_bf16(a[2], a[3]); w.z = cvt_pk_bf16(b[0], b[1]); w.w = cvt_pk_bf16(b[2], b[3]); return w; }
__device__ __forceinline__ void unpack8(const u32x4 w, f32x4& a, f32x4& b) { a = (f32x4){bf_lo(w.x), bf_hi(w.x), bf_lo(w.y), bf_hi(w.y)}; b = (f32x4){bf_lo(w.z), bf_hi(w.z), bf_lo(w.w), bf_hi(w.w)}; }
__device__ __forceinline__ f32x4 sig4(const f32x4 x) { return (f32x4){sigmoidf_(x[0]), sigmoidf_(x[1]), sigmoidf_(x[2]), sigmoidf_(x[3])}; }

__device__ __forceinline__ void ssq_add(float* ssq, int row, float part, int fq) { part += __shfl_xor(part, 16); part += __shfl_xor(part, 32); if (fq == 0) atomicAdd(ssq + row, part); }
__device__ __forceinline__ float sq4(const f32x4 a) { return (a[0] * a[0] + a[1] * a[1]) + (a[2] * a[2] + a[3] * a[3]); }
#define EPI_BJ 32
#define EPI_ROW(ai, m) (u.pm * 256 + (ai) * 128 + wr * 64 + (m) * 16 + fr)
template <int RS, bool SSQ, bool NT = true> struct EpiStoreBf16 {
    static constexpr bool PERM = true, AFTER_DRAIN = false;
    bf16_t* O; int ldc; const float* rs; float* ssq;
    __device__ __forceinline__ void operator()(const f32x4 (&acc)[2][2][4][2], const pg8::Unit& u, int wr, int wc, int, int) const { const int l_ = lane_id_(); const int fr = l_ & 15, fq = l_ >> 4;

        const int col0 = u.pn * 256 + wc * 64 + 8 * fq;
        float scv[2][4];
#pragma unroll
        for (int ai = 0; ai < 2; ++ai)
#pragma unroll
            for (int m = 0; m < 4; ++m) scv[ai][m] = RS ? rs[EPI_ROW(ai, m)] : 1.f;
#pragma unroll
        for (int ai = 0; ai < 2; ++ai)
#pragma unroll
            for (int m = 0; m < 4; ++m) { const int row = EPI_ROW(ai, m);
                bf16_t* rowp = O + (size_t)row * ldc + col0;
                float sc = scv[ai][m]; if (RS == 2) sc = 1.0f / sqrtf(sc * (1.f / DM) + EPS);
                float part = 0.f;
#pragma unroll
                for (int bj = 0; bj < 2; ++bj) { const f32x4 v0 = acc[ai][bj][m][0] * sc, v1 = acc[ai][bj][m][1] * sc; if (SSQ) part += sq4(v0) + sq4(v1); if (NT) __builtin_nontemporal_store(pack8(v0, v1), (u32x4*)(rowp + bj * EPI_BJ)); else *(u32x4*)(rowp + bj * EPI_BJ) = pack8(v0, v1); }
                if (SSQ) ssq_add(ssq, row, part, fq); }
    }
};
#define EPI_BARRIER() asm volatile("" ::: "memory")
#define EPI_PIN(ai, m) asm volatile("" :: "v"(acc[ai][0][m][0]), "v"(acc[ai][0][m][1]), "v"(acc[ai][1][m][0]), "v"(acc[ai][1][m][1]) : "memory")
struct EpiGlu {
    static constexpr bool PERM = true, AFTER_DRAIN = false;
    const bf16_t* Z; bf16_t* O; int ldc;
    __device__ __forceinline__ void operator()(f32x4 (&acc)[2][2][4][2], const pg8::Unit& u, int wr, int wc, int, int) const { const int l_ = lane_id_(); const int fr = l_ & 15, fq = l_ >> 4;

        const int col0 = u.pn * 256 + wc * 64 + 8 * fq;
#pragma unroll
        for (int g = 0; g < 8; ++g) { const int ai = g >> 2, m = g & 3; const unsigned off = (unsigned)EPI_ROW(ai, m) * (unsigned)ldc + col0;
            const u32x4 za = *(const u32x4*)(Z + off), zb = *(const u32x4*)(Z + off + EPI_BJ);
            { f32x4 z0, z1; unpack8(za, z0, z1); acc[ai][0][m][0] = z0 * sig4(acc[ai][0][m][0]); acc[ai][0][m][1] = z1 * sig4(acc[ai][0][m][1]); }
            { f32x4 z0, z1; unpack8(zb, z0, z1); acc[ai][1][m][0] = z0 * sig4(acc[ai][1][m][0]); acc[ai][1][m][1] = z1 * sig4(acc[ai][1][m][1]); }
            EPI_PIN(ai, m); }
#pragma unroll
        for (int g = 0; g < 8; ++g) { const int ai = g >> 2, m = g & 3; const unsigned off = (unsigned)EPI_ROW(ai, m) * (unsigned)ldc + col0;
            *(u32x4*)(O + off) = pack8(acc[ai][0][m][0], acc[ai][0][m][1]); *(u32x4*)(O + off + EPI_BJ) = pack8(acc[ai][1][m][0], acc[ai][1][m][1]); }
    }
};
template <bool ADD> struct EpiGate {
    static constexpr bool PERM = true, AFTER_DRAIN = false;
    const bf16_t* Gt; int ldg; bf16_t* O; int ldc;
    __device__ __forceinline__ void operator()(f32x4 (&acc)[2][2][4][2], const pg8::Unit& u, int wr, int wc, int, int) const { const int l_ = lane_id_(); const int fr = l_ & 15, fq = l_ >> 4;

        const int col0 = u.pn * 256 + wc * 64 + 8 * fq;
#pragma unroll
        for (int g = 0; g < 8; ++g) { const int ai = g >> 2, m = g & 3; const unsigned row = (unsigned)EPI_ROW(ai, m); const unsigned og = row * (unsigned)ldg + col0, oo = row * (unsigned)ldc + col0;
            const u32x4 ga = *(const u32x4*)(Gt + og), gb = *(const u32x4*)(Gt + og + EPI_BJ); u32x4 oa = {}, ob = {}; if (ADD) { oa = *(const u32x4*)(O + oo); ob = *(const u32x4*)(O + oo + EPI_BJ); }
            { f32x4 g0, g1; unpack8(ga, g0, g1); f32x4 r0 = sig4(g0) * acc[ai][0][m][0], r1 = sig4(g1) * acc[ai][0][m][1]; if (ADD) { f32x4 o0, o1; unpack8(oa, o0, o1); r0 += o0; r1 += o1; } acc[ai][0][m][0] = r0; acc[ai][0][m][1] = r1; }
            { f32x4 g0, g1; unpack8(gb, g0, g1); f32x4 r0 = sig4(g0) * acc[ai][1][m][0], r1 = sig4(g1) * acc[ai][1][m][1]; if (ADD) { f32x4 o0, o1; unpack8(ob, o0, o1); r0 += o0; r1 += o1; } acc[ai][1][m][0] = r0; acc[ai][1][m][1] = r1; }
            EPI_PIN(ai, m); }
#pragma unroll
        for (int g = 0; g < 8; ++g) { const int ai = g >> 2, m = g & 3; const unsigned oo = (unsigned)EPI_ROW(ai, m) * (unsigned)ldc + col0;
            *(u32x4*)(O + oo) = pack8(acc[ai][0][m][0], acc[ai][0][m][1]); *(u32x4*)(O + oo + EPI_BJ) = pack8(acc[ai][1][m][0], acc[ai][1][m][1]); }
    }
};
#define EPD 1
struct EpiResidBf {
    static constexpr bool PERM = true, AFTER_DRAIN = false;
    bf16_t* X; float* ssq;
    __device__ __forceinline__ void operator()(f32x4 (&acc)[2][2][4][2], const pg8::Unit& u, int wr, int wc, int, int) const { const int l_ = lane_id_(); const int fr = l_ & 15, fq = l_ >> 4;
        const int col0 = u.pn * 256 + wc * 64 + 8 * fq;
        float part[8]; u32x4 La[EPD + 1], Lb[EPD + 1];
#pragma unroll
        for (int g = 0; g < EPD; ++g) { const unsigned off = (unsigned)EPI_ROW(g >> 2, g & 3) * DM + col0; La[g] = *(const u32x4*)(X + off); Lb[g] = *(const u32x4*)(X + off + EPI_BJ); }
#pragma unroll
        for (int g = 0; g < 8; ++g) { const int ai = g >> 2, m = g & 3; const int nb = (g + EPD) % (EPD + 1), cb = g % (EPD + 1);
            if (g + EPD < 8) { const unsigned off = (unsigned)EPI_ROW((g + EPD) >> 2, (g + EPD) & 3) * DM + col0; La[nb] = *(const u32x4*)(X + off); Lb[nb] = *(const u32x4*)(X + off + EPI_BJ); }
            asm volatile("" :: "v"(La[nb]), "v"(Lb[nb]) : "memory");
            f32x4 x0, x1, x2, x3; unpack8(La[cb], x0, x1); unpack8(Lb[cb], x2, x3);
            x0 += acc[ai][0][m][0]; x1 += acc[ai][0][m][1]; x2 += acc[ai][1][m][0]; x3 += acc[ai][1][m][1];
            part[g] = (sq4(x0) + sq4(x1)) + (sq4(x2) + sq4(x3));
            acc[ai][0][m][0] = x0; acc[ai][0][m][1] = x1; acc[ai][1][m][0] = x2; acc[ai][1][m][1] = x3;
            EPI_PIN(ai, m); }
#pragma unroll
        for (int g = 0; g < 8; ++g) { const int ai = g >> 2, m = g & 3; const unsigned off = (unsigned)EPI_ROW(ai, m) * DM + col0;
            *(u32x4*)(X + off) = pack8(acc[ai][0][m][0], acc[ai][0][m][1]); *(u32x4*)(X + off + EPI_BJ) = pack8(acc[ai][1][m][0], acc[ai][1][m][1]); }
#pragma unroll
        for (int g = 0; g < 8; ++g) ssq_add(ssq, EPI_ROW(g >> 2, g & 3), part[g], fq);
    }
};
#define EPDP 1
struct EpiPg {
    static constexpr bool PERM = true, AFTER_DRAIN = false;
    float* out; const bf16_t* x2; const bf16_t* pr; const float* ssq2; const float* ssqp; const float* gp;
    __device__ __forceinline__ void operator()(f32x4 (&acc)[2][2][4][2], const pg8::Unit& u, int wr, int wc, int, int) const { const int l_ = lane_id_(); const int fr = l_ & 15, fq = l_ >> 4;
        const int col0 = u.pn * 256 + wc * 64 + 8 * fq;
        f32x4 gv[2][2]; u32x4 Lx[EPDP + 1][2], Lp[EPDP + 1][2]; float Ls[EPDP + 1][2];
#pragma unroll
        for (int bj = 0; bj < 2; ++bj)
#pragma unroll
            for (int n = 0; n < 2; ++n) gv[bj][n] = *(const f32x4*)(gp + col0 + bj * EPI_BJ + n * 4);
#pragma unroll
        for (int g = 0; g < EPDP; ++g) { const int row0_ = EPI_ROW(g >> 2, g & 3); Ls[g][0] = ssq2[row0_]; Ls[g][1] = ssqp[row0_]; const unsigned off = (unsigned)row0_ * DM + col0; Lx[g][0] = *(const u32x4*)(x2 + off); Lx[g][1] = *(const u32x4*)(x2 + off + EPI_BJ); Lp[g][0] = *(const u32x4*)(pr + off); Lp[g][1] = *(const u32x4*)(pr + off + EPI_BJ); }
#pragma unroll
        for (int g = 0; g < 8; ++g) { const int ai = g >> 2, m = g & 3; const int nb = (g + EPDP) % (EPDP + 1), cb = g % (EPDP + 1);
            if (g + EPDP < 8) { const int row1_ = EPI_ROW((g + EPDP) >> 2, (g + EPDP) & 3); Ls[nb][0] = ssq2[row1_]; Ls[nb][1] = ssqp[row1_]; const unsigned off = (unsigned)row1_ * DM + col0;
                Lx[nb][0] = *(const u32x4*)(x2 + off); Lx[nb][1] = *(const u32x4*)(x2 + off + EPI_BJ); Lp[nb][0] = *(const u32x4*)(pr + off); Lp[nb][1] = *(const u32x4*)(pr + off + EPI_BJ); }
            asm volatile("" :: "v"(Lx[nb][0]), "v"(Lx[nb][1]), "v"(Lp[nb][0]), "v"(Lp[nb][1]) : "memory");
            const float r2 = 1.0f / sqrtf(Ls[cb][0] * (1.f / DM) + EPS), rp = 1.0f / sqrtf(Ls[cb][1] * (1.f / DM) + EPS);
#pragma unroll
            for (int bj = 0; bj < 2; ++bj) { f32x4 x0, x1, p0, p1; unpack8(Lx[cb][bj], x0, x1); unpack8(Lp[cb][bj], p0, p1);
                acc[ai][bj][m][0] = x0 + sig4(acc[ai][bj][m][0] * r2) * p0 * gv[bj][0] * rp; acc[ai][bj][m][1] = x1 + sig4(acc[ai][bj][m][1] * r2) * p1 * gv[bj][1] * rp; }
            EPI_PIN(ai, m); }
#pragma unroll
        for (int ai = 0; ai < 2; ++ai)
#pragma unroll
            for (int m = 0; m < 4; ++m) { const int row = EPI_ROW(ai, m);
                if (row < MR) { const unsigned off = (unsigned)row * DM + col0;
#pragma unroll
                    for (int bj = 0; bj < 2; ++bj) { float* o = out + off + bj * EPI_BJ; *(f32x4*)o = acc[ai][bj][m][0]; *(f32x4*)(o + 4) = acc[ai][bj][m][1]; } } }
    }
};
template <class Epi>
__device__ __forceinline__ void skinny_gemm(LAS unsigned char* lds, const bf16_t* __restrict__ A, int lda, const bf16_t* __restrict__ Bt, int K, int N, const Epi& E, int vcu, int G, int wave, int lane) {
    const int kq = wave & 3, rgp = wave >> 2, cq = lane >> 4, Kq = K >> 2;
    LAS f32x4* red = (LAS f32x4*)lds;
    for (int u = vcu; u < N / 8; u += G) {
        const int cs = u >> 1, rh = u & 1; const int row0 = TP + 64 * rh + 32 * rgp + (lane & 15);
        const bf16_t* ap0 = A + (size_t)row0 * lda + kq * Kq + 8 * cq; const bf16_t* ap1 = ap0 + (size_t)16 * lda;
        const bf16_t* bp = Bt + (size_t)(16 * cs + (lane & 15)) * K + kq * Kq + 8 * cq;
        f32x4 acc0 = {0.f, 0.f, 0.f, 0.f}, acc1 = {0.f, 0.f, 0.f, 0.f};
#pragma unroll 8
        for (int k0 = 0; k0 < Kq; k0 += 32) { const bf16x8 bw = *(const bf16x8*)(bp + k0);
            acc0 = __builtin_amdgcn_mfma_f32_16x16x32_bf16(bw, *(const bf16x8*)(ap0 + k0), acc0, 0, 0, 0);
            acc1 = __builtin_amdgcn_mfma_f32_16x16x32_bf16(bw, *(const bf16x8*)(ap1 + k0), acc1, 0, 0, 0); }
        if (kq != 0) { red[((kq - 1) * 2 + rgp) * 128 + lane] = acc0; red[((kq - 1) * 2 + rgp) * 128 + 64 + lane] = acc1; }
        __syncthreads();
        if (kq == 0) {
#pragma unroll
            for (int q3 = 0; q3 < 3; ++q3) { acc0 += red[(q3 * 2 + rgp) * 128 + lane]; acc1 += red[(q3 * 2 + rgp) * 128 + 64 + lane]; }
            E(row0, 16 * cs + 4 * cq, acc0, lane); E(row0 + 16, 16 * cs + 4 * cq, acc1, lane); }
        __syncthreads();
    }
}
__device__ __forceinline__ f32x4 ld4bf(const bf16_t* p) { const u32x2 w = *(const u32x2*)p; return (f32x4){bf_lo(w.x), bf_hi(w.x), bf_lo(w.y), bf_hi(w.y)}; }
__device__ __forceinline__ void st4bf(bf16_t* p, const f32x4 v) { u32x2 w; w.x = cvt_pk_bf16(v[0], v[1]); w.y = cvt_pk_bf16(v[2], v[3]); *(u32x2*)p = w; }
struct SkGlu { const bf16_t* Z; bf16_t* O; __device__ __forceinline__ void operator()(int row, int col, f32x4 acc, int) const { const size_t o = (size_t)row * 512 + col; st4bf(O + o, ld4bf(Z + o) * sig4(acc)); } };
template <bool ADD> struct SkGate { const bf16_t* Gt; int ldg; bf16_t* O;
    __device__ __forceinline__ void operator()(int row, int col, f32x4 acc, int) const { f32x4 r = sig4(ld4bf(Gt + (size_t)row * ldg + col)) * acc; bf16_t* op = O + (size_t)row * DM + col; if (ADD) r += ld4bf(op); st4bf(op, r); } };
struct SkResid { bf16_t* X; float* ssq;
    __device__ __forceinline__ void operator()(int row, int col, f32x4 acc, int lane) const { bf16_t* p = X + (size_t)row * DM + col; const f32x4 x = ld4bf(p) + acc; st4bf(p, x);
        float part = sq4(x); part += __shfl_xor(part, 16); part += __shfl_xor(part, 32); if (lane < 16) atomicAdd(ssq + row, part); } };
struct SkPg { float* out; const bf16_t* x2; const bf16_t* pr; const float* ssq2; const float* ssqp; const float* gp;
    __device__ __forceinline__ void operator()(int row, int col, f32x4 acc, int) const { const float r2 = 1.0f / sqrtf(ssq2[row] * (1.f / DM) + EPS), rp = 1.0f / sqrtf(ssqp[row] * (1.f / DM) + EPS);
        const size_t o = (size_t)row * DM + col; *(f32x4*)(out + o) = ld4bf(x2 + o) + sig4(acc * r2) * ld4bf(pr + o) * *(const f32x4*)(gp + col) * rp; } };
struct SkStore { bf16_t* O; float* ssq;
    __device__ __forceinline__ void operator()(int row, int col, f32x4 acc, int lane) const { st4bf(O + (size_t)row * DM + col, acc);
        float part = sq4(acc); part += __shfl_xor(part, 16); part += __shfl_xor(part, 32); if (lane < 16) atomicAdd(ssq + row, part); } };
#define XB_TMO      128
#define XB_XCNT(j)  (256  + 64 * (j))
#define XB_XSUB(j)  (1280 + 64 * (j))
#define XB_XGEN(j)  (2304 + 64 * (j))
#define XB_TOP      3328
#define XB_TOPGEN   3392
#define XCD_BAR_WORDS 3456
#define XB_SPIN_CAP (1u << 18)

__device__ __forceinline__ unsigned xb_ld(unsigned* p)              { return __hip_atomic_load(p, __ATOMIC_RELAXED, __HIP_MEMORY_SCOPE_AGENT); }
__device__ __forceinline__ unsigned xb_add(unsigned* p, unsigned v) { return __hip_atomic_fetch_add(p, v, __ATOMIC_RELAXED, __HIP_MEMORY_SCOPE_AGENT); }
__device__ __forceinline__ unsigned xb_xcc_id() { return (unsigned)__builtin_amdgcn_s_getreg((3 << 11) | 20) & 0xFu; }
#define XB_SPIN(cond, bar) do { unsigned _sp = 0; while (cond) { __builtin_amdgcn_s_sleep(1); \
    if ((++_sp & 255u) == 0u) { if (xb_ld(&(bar)[XB_TMO])) break; if (_sp > XB_SPIN_CAP) { atomicAdd(&(bar)[XB_TMO], 1u); break; } } } } while (0)

struct XcdBarrier {
    unsigned* bar; unsigned x; int w0;
    volatile LAS unsigned* st;
};

__device__ __forceinline__ XcdBarrier xcd_barrier_post(unsigned* bar, volatile LAS unsigned* st) {
    XcdBarrier b; b.bar = bar; b.x = xb_xcc_id(); b.st = st; b.w0 = (__builtin_amdgcn_readfirstlane((int)threadIdx.x >> 6) == 0);
    if (b.w0 && lane_id_() == 0) (void)xb_add(&bar[XB_XCNT(b.x)], 1u);
    return b;
}
__device__ __forceinline__ void xcd_barrier_complete(unsigned* bar, unsigned x, unsigned& nloc, unsigned& nx) {
    const unsigned G = gridDim.x * gridDim.y * gridDim.z;
    unsigned sum, cnt, mine, sp = 0u;
    for (;;) {
        sum = 0u; cnt = 0u; mine = 0u;
#pragma unroll
        for (unsigned j = 0; j < 16; ++j) { const unsigned c = xb_ld(&bar[XB_XCNT(j)]); sum += c; cnt += (c > 0u) ? 1u : 0u; mine = (j == x) ? c : mine; }
        if (sum == G) break;
        __builtin_amdgcn_s_sleep(1);
        if ((++sp & 255u) == 0u) { if (xb_ld(&bar[XB_TMO])) break; if (sp > XB_SPIN_CAP) { atomicAdd(&bar[XB_TMO], 1u); break; } }
    }
    nloc = mine > 0u ? mine : 1u; nx = cnt > 0u ? cnt : 1u;
}

__device__ __forceinline__ void xcd_barrier(const XcdBarrier& b) {
    asm volatile("s_waitcnt vmcnt(0)" ::: "memory");
    __syncthreads();
    if (b.w0 && lane_id_() == 0) {
        unsigned* bar = b.bar;
        __builtin_amdgcn_s_waitcnt(0);
        unsigned nloc = b.st[0], nx = b.st[1];
        if (nloc == 0u) { xcd_barrier_complete(bar, b.x, nloc, nx); b.st[0] = nloc; b.st[1] = nx; }
        const unsigned old = xb_add(&bar[XB_XSUB(b.x)], 1u);
        const unsigned gen = old / nloc;
        if (old + 1u == (gen + 1u) * nloc) {
            __builtin_amdgcn_fence(__ATOMIC_RELEASE, "agent");
            asm volatile("s_waitcnt vmcnt(0)" ::: "memory");
            const unsigned og = xb_add(&bar[XB_TOP], 1u);
            const unsigned tg = og / nx;
            if (og + 1u == (tg + 1u) * nx) xb_add(&bar[XB_TOPGEN], 1u);
            else XB_SPIN(xb_ld(&bar[XB_TOPGEN]) == tg, bar);
            __builtin_amdgcn_fence(__ATOMIC_ACQUIRE, "agent");
            xb_add(&bar[XB_XGEN(b.x)], 1u);
            asm volatile("s_waitcnt vmcnt(0)" ::: "memory");
        } else {
            XB_SPIN(xb_ld(&bar[XB_XGEN(b.x)]) == gen, bar);
            __builtin_amdgcn_fence(__ATOMIC_ACQUIRE, "agent");
            asm volatile("s_waitcnt vmcnt(0)" ::: "memory");
        }
    }
    __syncthreads();
}
__device__ __forceinline__ void cexp_d(double re, double im, int k, double& ore, double& oim) {
    const double sc = 1.0 / (double)(1ull << k); const double zr = re * sc, zi = im * sc;
    double tr = 1.0, ti = 0.0, sr = 1.0, si = 0.0;
#pragma unroll 1
    for (int n = 1; n <= 12; ++n) { const double inv = 1.0 / (double)n; const double nr = (tr * zr - ti * zi) * inv, ni = (tr * zi + ti * zr) * inv; tr = nr; ti = ni; sr += tr; si += ti; }
#pragma unroll 1
    for (int i = 0; i < k; ++i) { const double nr = sr * sr - si * si, ni = 2.0 * sr * si; sr = nr; si = ni; }
    ore = sr; oim = si;
}

struct TrItem { const float* W; bf16_t* WT; const float* gk; int K, N, nblk, item; };
__device__ __forceinline__ void transpose_load(const TrItem& T, int lane, float (&w)[32]) {
    const int kb = T.item / T.nblk, nb = T.item % T.nblk, k0 = 64 * kb, n0 = 32 * nb;
    const int nn = n0 + (lane & 31); const int nc = nn < T.N ? nn : T.N - 1;
    const float* wp = T.W + (size_t)(k0 + (lane >> 5)) * T.N + nc;
    const size_t rs2 = (size_t)2 * T.N;
#pragma unroll
    for (int i = 0; i < 32; ++i) w[i] = wp[i * rs2];
    if (T.gk) {
        float gkv[32]; const float* gp = T.gk + k0 + (lane >> 5);
#pragma unroll
        for (int i = 0; i < 32; ++i) gkv[i] = gp[2 * i];
#pragma unroll
        for (int i = 0; i < 32; ++i) w[i] *= gkv[i];
    }
    if (nn >= T.N) {
#pragma unroll
        for (int i = 0; i < 32; ++i) w[i] = 0.f; }
}
__device__ __forceinline__ void transpose_store(const TrItem& T, int lane, const float (&w)[32], LAS float* scr) {
    const int kb = T.item / T.nblk, nb = T.item % T.nblk, k0 = 64 * kb, n0 = 32 * nb;
#pragma unroll
    for (int i = 0; i < 32; ++i) { const int kk = 2 * i + (lane >> 5); scr[kk * 33 + (lane & 31)] = w[i]; }
    LDS_WAIT(); asm volatile("" ::: "memory");
    const int c = lane & 7;
#pragma unroll
    for (int j = 0; j < 4; ++j) { const int n = (lane >> 3) + 8 * j; const LAS float* s = scr + (8 * c) * 33 + n;
        u32x4 o; o.x = cvt_pk_bf16(s[0 * 33], s[1 * 33]); o.y = cvt_pk_bf16(s[2 * 33], s[3 * 33]); o.z = cvt_pk_bf16(s[4 * 33], s[5 * 33]); o.w = cvt_pk_bf16(s[6 * 33], s[7 * 33]);
        *(u32x4*)(T.WT + (size_t)(n0 + n) * T.K + k0 + 8 * c) = o; }
    LDS_WAIT(); asm volatile("" ::: "memory");
}
__device__ __forceinline__ void row_to_bf16_rstd(const float* __restrict__ xrow, bf16_t* __restrict__ orow, float* __restrict__ rs, int lane) {
    const f32x4* xr = (const f32x4*)xrow + lane;
    f32x4 v[8]; float s = 0.f;
#pragma unroll
    for (int j = 0; j < 8; ++j) { v[j] = xr[64 * j]; s += (v[j].x * v[j].x + v[j].y * v[j].y) + (v[j].z * v[j].z + v[j].w * v[j].w); }
    s = wave_sum(s);
    u32x2* o8 = (u32x2*)orow + lane;
#pragma unroll
    for (int j = 0; j < 8; ++j) { u32x2 w; w.x = cvt_pk_bf16(v[j].x, v[j].y); w.y = cvt_pk_bf16(v[j].z, v[j].w); o8[64 * j] = w; }
    if (lane == 0) *rs = 1.0f / sqrtf(s * (1.f / DM) + EPS);
}
__device__ __forceinline__ void ld16bf(const bf16_t* p, float (&v)[16]) {
    const u32x4 a = *(const u32x4*)p, b = *(const u32x4*)(p + 8);
    v[0] = bf_lo(a.x); v[1] = bf_hi(a.x); v[2] = bf_lo(a.y); v[3] = bf_hi(a.y); v[4] = bf_lo(a.z); v[5] = bf_hi(a.z); v[6] = bf_lo(a.w); v[7] = bf_hi(a.w);
    v[8] = bf_lo(b.x); v[9] = bf_hi(b.x); v[10] = bf_lo(b.y); v[11] = bf_hi(b.y); v[12] = bf_lo(b.z); v[13] = bf_hi(b.z); v[14] = bf_lo(b.w); v[15] = bf_hi(b.w);
}
__device__ __forceinline__ void st16bf(bf16_t* p, const float (&v)[16]) {
    u32x4 a, b; a.x = cvt_pk_bf16(v[0], v[1]); a.y = cvt_pk_bf16(v[2], v[3]); a.z = cvt_pk_bf16(v[4], v[5]); a.w = cvt_pk_bf16(v[6], v[7]);
    b.x = cvt_pk_bf16(v[8], v[9]); b.y = cvt_pk_bf16(v[10], v[11]); b.z = cvt_pk_bf16(v[12], v[13]); b.w = cvt_pk_bf16(v[14], v[15]);
    *(u32x4*)p = a; *(u32x4*)(p + 8) = b;
}
__device__ __forceinline__ void st16f(float* p, const float (&v)[16]) {
#pragma unroll
    for (int j = 0; j < 4; ++j) __builtin_nontemporal_store((f32x4){v[4 * j], v[4 * j + 1], v[4 * j + 2], v[4 * j + 3]}, (f32x4*)(p + 4 * j));
}
__device__ __forceinline__ void norm_rope128(float (&v)[16], int sub, const float (&g)[16], const float (&cs)[16], const float (&sn)[16]) {
    float ss = 0.f;
#pragma unroll
    for (int e = 0; e < 16; ++e) ss += v[e] * v[e];
    ss += __shfl_xor(ss, 1); ss += __shfl_xor(ss, 2); ss += __shfl_xor(ss, 4);
    const float rstd = 1.0f / sqrtf(ss * (1.f / 128.f) + EPS);
    const float sg = sub == 0 ? -1.f : 1.f; const bool act = sub < 2;
#pragma unroll
    for (int e = 0; e < 16; ++e) v[e] = v[e] * rstd * g[e];
#pragma unroll
    for (int e = 0; e < 16; ++e) { const float o = __shfl_xor(v[e], 1); const float r = v[e] * cs[e] + sg * o * sn[e]; v[e] = act ? r : v[e]; }
}
__device__ __forceinline__ void ld16f(const float* p, float (&v)[16]) {
#pragma unroll
    for (int j = 0; j < 4; ++j) { const f32x4 a = *(const f32x4*)(p + 4 * j); v[4 * j] = a.x; v[4 * j + 1] = a.y; v[4 * j + 2] = a.z; v[4 * j + 3] = a.w; }
}
__device__ __forceinline__ void rope64(float (&v)[16], const float (&ci)[8], const float (&si)[8]) {
#pragma unroll
    for (int i = 0; i < 8; ++i) { const float x1 = v[i], x2 = v[8 + i]; v[i] = x1 * ci[i] - x2 * si[i]; v[8 + i] = x2 * ci[i] + x1 * si[i]; }
}
__device__ __forceinline__ void up16(const u32x4 a, const u32x4 b, float (&v)[16]) {
    v[0] = bf_lo(a.x); v[1] = bf_hi(a.x); v[2] = bf_lo(a.y); v[3] = bf_hi(a.y); v[4] = bf_lo(a.z); v[5] = bf_hi(a.z); v[6] = bf_lo(a.w); v[7] = bf_hi(a.w);
    v[8] = bf_lo(b.x); v[9] = bf_hi(b.x); v[10] = bf_lo(b.y); v[11] = bf_hi(b.y); v[12] = bf_lo(b.z); v[13] = bf_hi(b.z); v[14] = bf_lo(b.w); v[15] = bf_hi(b.w);
}
struct TaRaw { u32x4 q0, q1, k0, k1, v0, v1, i0, i1, j0, j1; unsigned w; };
__device__ __forceinline__ void ta_load(int row, int lane, const bf16_t* __restrict__ proj, TaRaw& R) {
    const bf16_t* pr = proj + (size_t)row * INWP; const int l15 = lane & 15, l3 = lane & 3;
    R.q0 = *(const u32x4*)(pr + C_Q + 16 * lane); R.q1 = *(const u32x4*)(pr + C_Q + 16 * lane + 8);
    R.k0 = *(const u32x4*)(pr + C_K + 16 * l15); R.k1 = *(const u32x4*)(pr + C_K + 16 * l15 + 8);
    R.v0 = *(const u32x4*)(pr + C_V + 16 * l15); R.v1 = *(const u32x4*)(pr + C_V + 16 * l15 + 8);
    R.i0 = *(const u32x4*)(pr + C_IQ + 16 * lane); R.i1 = *(const u32x4*)(pr + C_IQ + 16 * lane + 8);
    R.j0 = *(const u32x4*)(pr + C_IK + 16 * l3); R.j1 = *(const u32x4*)(pr + C_IK + 16 * l3 + 8);
    R.w = pr[C_IW + l15];
}
__device__ __forceinline__ void ta_compute(int row, int lane, const TaRaw& R, const float* __restrict__ RT, const float* __restrict__ gq, const float* __restrict__ gk,
                                           bf16_t* __restrict__ qn, bf16_t* __restrict__ kn, bf16_t* __restrict__ vb, bf16_t* __restrict__ iqr, bf16_t* __restrict__ ikr, float* __restrict__ iws, float* __restrict__ out) {
    const int pi = row < TP ? (row & (SEQ - 1)) : SEQ + ((row - TP) & 3);
    const float* rt = RT + pi * 48;
    const bool isp = row < TP; const int rs = isp ? row : row - TP;
    float cs[16], sn[16], ci[8], si[8], gqv[16], gkv[16];
    ld16f(rt, cs); ld16f(rt + 16, sn);
    { const f32x4 a = *(const f32x4*)(rt + 32), b = *(const f32x4*)(rt + 36), c = *(const f32x4*)(rt + 40), d = *(const f32x4*)(rt + 44);
      ci[0] = a.x; ci[1] = a.y; ci[2] = a.z; ci[3] = a.w; ci[4] = b.x; ci[5] = b.y; ci[6] = b.z; ci[7] = b.w; si[0] = c.x; si[1] = c.y; si[2] = c.z; si[3] = c.w; si[4] = d.x; si[5] = d.y; si[6] = d.z; si[7] = d.w; }
    ld16f(gq + (lane & 7) * 16, gqv); ld16f(gk + (lane & 7) * 16, gkv);
    float v[16];
    up16(R.q0, R.q1, v); norm_rope128(v, lane & 7, gqv, cs, sn); st16bf(qn + (size_t)row * 1024 + 16 * lane, v);
    { const int l = lane & 15; up16(R.k0, R.k1, v); norm_rope128(v, l & 7, gkv, cs, sn);
      if (lane < 16) { st16bf(kn + (size_t)row * 256 + 16 * l, v); st16f(out + (isp ? O_KP : O_KS) + (size_t)rs * 256 + 16 * l, v); } }
    if (lane < 16) { up16(R.v0, R.v1, v); *(u32x4*)(vb + (size_t)row * 256 + 16 * lane) = R.v0; *(u32x4*)(vb + (size_t)row * 256 + 16 * lane + 8) = R.v1; st16f(out + (isp ? O_VP : O_VS) + (size_t)rs * 256 + 16 * lane, v); }
    up16(R.i0, R.i1, v); if ((lane & 3) == 0) rope64(v, ci, si); st16bf(iqr + (size_t)row * 1024 + 16 * lane, v);
    if (lane < 4) { up16(R.j0, R.j1, v); if (lane == 0) rope64(v, ci, si); st16bf(ikr + (size_t)row * 64 + 16 * lane, v); st16f(out + (isp ? O_IKP : O_IKS) + (size_t)rs * 64 + 16 * lane, v); }
    if (lane < 16) iws[(size_t)row * 16 + lane] = bf2f((bf16_t)R.w) * IDX_SCALE;
}
__device__ __forceinline__ bf16x8 as_bf16x8(const u32x4 w) { return __builtin_bit_cast(bf16x8, w); }
__device__ __forceinline__ void idx_load_a(const bf16_t* __restrict__ iqr, size_t row0, int lane, bf16x8 (&a)[4]) {
    const int rho = lane & 31, h = lane >> 5; const int tok = (rho >> 2) & 1, head = (rho & 3) + 4 * (rho >> 3);
    const bf16_t* p = iqr + (row0 + tok) * 1024 + head * 64 + 8 * h;
#pragma unroll
    for (int kk = 0; kk < 4; ++kk) a[kk] = *(const bf16x8*)(p + 16 * kk);
}
__device__ __forceinline__ float idx_reduce(const f32x16& acc, const f32x4 (&wv)[4]) {
    float s = 0.f;
#pragma unroll
    for (int r = 0; r < 16; ++r) s += wv[r >> 2][r & 3] * fmaxf(acc[r], 0.f);
    return s;
}
__device__ __forceinline__ void idx_prompt_block(int b, int qb, int wave, int lane, const bf16_t* __restrict__ iqr, const bf16_t* __restrict__ ikr, const float* __restrict__ iws, float* __restrict__ sc) {
    const int h = lane >> 5, kl = lane & 31;
    bf16x8 a[4][4]; f32x4 wv[4][4]; size_t rowi[4];
#pragma unroll
    for (int i = 0; i < 4; ++i) { const size_t row0 = (size_t)b * SEQ + 64 * qb + 2 * (4 * wave + i); rowi[i] = row0 + h; idx_load_a(iqr, row0, lane, a[i]);
#pragma unroll
        for (int j = 0; j < 4; ++j) wv[i][j] = *(const f32x4*)(iws + (row0 + h) * 16 + 4 * j); }
    const int ntile = 2 * qb + 2;
    const bf16_t* kp = ikr + ((size_t)b * SEQ + kl) * 64 + 8 * h;
    bf16x8 bc[4], bn[4];
#pragma unroll
    for (int kk = 0; kk < 4; ++kk) bc[kk] = *(const bf16x8*)(kp + 16 * kk);
    for (int kt = 0; kt < ntile; ++kt) {
        if (kt + 1 < ntile) {
#pragma unroll
            for (int kk = 0; kk < 4; ++kk) bn[kk] = *(const bf16x8*)(kp + (size_t)(kt + 1) * 32 * 64 + 16 * kk); }
#pragma unroll
        for (int i = 0; i < 4; ++i) { f32x16 acc = {};
#pragma unroll
            for (int kk = 0; kk < 4; ++kk) acc = __builtin_amdgcn_mfma_f32_32x32x16_bf16(a[i][kk], bc[kk], acc, 0, 0, 0);
            sc[rowi[i] * SEQ + 32 * kt + kl] = idx_reduce(acc, wv[i]); }
#pragma unroll
        for (int kk = 0; kk < 4; ++kk) bc[kk] = bn[kk];
    }
}
__device__ __forceinline__ void idx_sample_unit(int b, int c, int wave, int lane, const bf16_t* __restrict__ iqr, const bf16_t* __restrict__ ikr, const float* __restrict__ iws,
                                                const float* __restrict__ cik, const int* __restrict__ pt, float* __restrict__ ssc) {
    const int h = lane >> 5, kl = lane & 31;
    bf16x8 a[2][4]; f32x4 wv[2][4];
#pragma unroll
    for (int i = 0; i < 2; ++i) { const size_t row0 = (size_t)TP + 4 * b + 2 * i; idx_load_a(iqr, row0, lane, a[i]);
#pragma unroll
        for (int j = 0; j < 4; ++j) wv[i][j] = *(const f32x4*)(iws + (row0 + h) * 16 + 4 * j); }
    const int pgl = 8 * c + wave; const int page = pt[b * NPG + pgl];
#pragma unroll 1
    for (int kt = 0; kt < 4; ++kt) {
        const float* p = cik + ((size_t)page * PAGE + 32 * kt + kl) * 64 + 8 * h; bf16x8 bc[4];
#pragma unroll
        for (int kk = 0; kk < 4; ++kk) { const f32x4 x0 = *(const f32x4*)(p + 16 * kk), x1 = *(const f32x4*)(p + 16 * kk + 4); bc[kk] = as_bf16x8(pack8(x0, x1)); }
#pragma unroll
        for (int i = 0; i < 2; ++i) { f32x16 acc = {};
#pragma unroll
            for (int kk = 0; kk < 4; ++kk) acc = __builtin_amdgcn_mfma_f32_32x32x16_bf16(a[i][kk], bc[kk], acc, 0, 0, 0);
            ssc[(size_t)(b * 4 + 2 * i + h) * SSTR + pgl * PAGE + 32 * kt + kl] = idx_reduce(acc, wv[i]); }
    }
    if (c == 15 && wave == 0) {
        const bf16_t* p = ikr + ((size_t)TP + 4 * b + (kl & 3)) * 64 + 8 * h; bf16x8 bc[4];
#pragma unroll
        for (int kk = 0; kk < 4; ++kk) bc[kk] = *(const bf16x8*)(p + 16 * kk);
#pragma unroll
        for (int i = 0; i < 2; ++i) { f32x16 acc = {};
#pragma unroll
            for (int kk = 0; kk < 4; ++kk) acc = __builtin_amdgcn_mfma_f32_32x32x16_bf16(a[i][kk], bc[kk], acc, 0, 0, 0);
            const float s = idx_reduce(acc, wv[i]); if (kl < 4) ssc[(size_t)(b * 4 + 2 * i + h) * SSTR + PAST + kl] = s; }
    }
}
__device__ __forceinline__ unsigned fkey(float v) { const unsigned u = __float_as_uint(v); return (u >> 31) ? ~u : (u | 0x80000000u); }
__device__ __forceinline__ float fkey_inv(unsigned k) { return __uint_as_float((k >> 31) ? (k ^ 0x80000000u) : ~k); }
struct Bracket { float a, b, fa, fb, thr; int side, it; bool done; };
__device__ __forceinline__ void br_init(Bracket& B, float lo, float hi, int n, int cnt_hi) {
    B.a = lo; B.b = hi; B.fa = (float)(n - 256); B.fb = (float)(cnt_hi - 256); B.thr = lo; B.side = 0; B.it = 0; B.done = false;
    if (cnt_hi >= 256) { B.thr = hi; B.done = true; }
    if (n <= 256) { B.thr = lo; B.done = true; }
}
__device__ __forceinline__ float br_next(Bracket& B) {
    float c;
    if (B.it % 3 == 2) { const unsigned ka = fkey(B.a), kb = fkey(B.b); if (kb - ka <= 1u) { B.done = true; return B.a; } c = fkey_inv(ka + ((kb - ka) >> 1)); }
    else { c = B.a + (B.b - B.a) * (B.fa / (B.fa - B.fb)); if (!(c > B.a) || !(c < B.b)) c = 0.5f * (B.a + B.b);
           if (!(c > B.a) || !(c < B.b)) { const unsigned ka = fkey(B.a), kb = fkey(B.b); if (kb - ka <= 1u) { B.done = true; return B.a; } c = fkey_inv(ka + ((kb - ka) >> 1)); } }
    ++B.it; if (B.it > 120) B.done = true;
    return c;
}
__device__ __forceinline__ void br_update(Bracket& B, float c, int cnt) {
    const float f = (float)(cnt - 256);
    if (cnt == 256) { B.thr = c; B.done = true; return; }
    if (cnt > 256) { B.a = c; B.fa = f; B.thr = c; if (B.side == 1) B.fb *= 0.5f; B.side = 1; }
    else { B.b = c; B.fb = f; if (B.side == -1) B.fa *= 0.5f; B.side = -1; }
}
__device__ __forceinline__ void select_prompt_load(int row, int lane, const float* __restrict__ sc, float (&v)[32]) {
    const int t = row & (SEQ - 1); const float NINF = -__builtin_inff();
    const int nreg = t < 256 ? 0 : (t >> 6) + 1; const float* sr = sc + (size_t)row * SEQ;
#pragma unroll
    for (int j = 0; j < 32; ++j) { v[j] = NINF; if (j < nreg) { const int s = 64 * j + lane; if (s <= t) v[j] = sr[s]; } }
}
__device__ __forceinline__ void select_prompt_compute(int row, int lane, float (&v)[32], u64* __restrict__ bm, LAS unsigned* hist  ) {
    const int t = row & (SEQ - 1);
    u64 myword = 0ull;
    if (t < 256) {
        const int n = t + 1 - 64 * lane; myword = n >= 64 ? ~0ull : (n > 0 ? ((1ull << n) - 1ull) : 0ull);
    } else {
        const int nreg = (t >> 6) + 1; const float NINF = -__builtin_inff();
        float mx = v[0], mn = v[0];
#pragma unroll
        for (int j = 1; j < 32; ++j) { mx = fmaxf(mx, v[j]); mn = fminf(mn, v[j] == NINF ? __builtin_inff() : v[j]); }
#pragma unroll
        for (int o = 1; o < 64; o <<= 1) { mx = fmaxf(mx, __shfl_xor(mx, o)); mn = fminf(mn, __shfl_xor(mn, o)); }
        mx = __builtin_bit_cast(float, __builtin_amdgcn_readfirstlane(__builtin_bit_cast(int, mx))); mn = __builtin_bit_cast(float, __builtin_amdgcn_readfirstlane(__builtin_bit_cast(int, mn)));
#define CNT_GE(c, dst) do { int cnt_ = 0; _Pragma("unroll") for (int gq = 0; gq < 4; ++gq) if (8 * gq < nreg) { _Pragma("unroll") for (int j = 8 * gq; j < 8 * gq + 8; ++j) cnt_ += __popcll(__ballot(v[j] >= (c))); __builtin_amdgcn_sched_barrier(0); } dst = cnt_; } while (0)
        float thr = mn; bool found = false;
        const float range = mx - mn;
        if (range > 0.f) {
            const float scale = 1023.0f / range;
            LAS u32x4* h4 = (LAS u32x4*)hist;
#pragma unroll
            for (int i = 0; i < 4; ++i) h4[lane * 4 + i] = (u32x4){0u, 0u, 0u, 0u};
            if (lane == 0) hist[1024] = 0u;
            LDS_WAIT();
#pragma unroll
            for (int gq = 0; gq < 4; ++gq) if (8 * gq < nreg) {
#pragma unroll
                for (int j = 8 * gq; j < 8 * gq + 8; ++j) if (v[j] != NINF) { const int bin = (int)((v[j] - mn) * scale); __hip_atomic_fetch_add(hist + bin, 1u, __ATOMIC_RELAXED, __HIP_MEMORY_SCOPE_WORKGROUP); } }
            LDS_WAIT();
            unsigned hb[16];
#pragma unroll
            for (int i = 0; i < 4; ++i) { const u32x4 w = h4[lane * 4 + i]; hb[4 * i] = w.x; hb[4 * i + 1] = w.y; hb[4 * i + 2] = w.z; hb[4 * i + 3] = w.w; }
            unsigned S = 0u;
#pragma unroll
            for (int i = 0; i < 16; ++i) S += hb[i];
            unsigned incl = S;
#pragma unroll
            for (int o = 1; o < 64; o <<= 1) { const unsigned x = __shfl_down(incl, o); if (lane + o < 64) incl += x; }
            const unsigned above = incl - S;
            const bool mine = above < 256u && incl >= 256u;
            int bstar = 0; unsigned cab = 0u, mcount = 0u;
            if (mine) { unsigned run = above; bool got = false;
#pragma unroll
                for (int i = 15; i >= 0; --i) { if (!got) { if (run + hb[i] >= 256u) { got = true; bstar = 16 * lane + i; cab = run; mcount = hb[i]; } else run += hb[i]; } } }
            const u64 mm = __ballot(mine); const int src = (int)__builtin_ctzll(mm | (1ull << 63));
            bstar = __shfl(bstar, src); cab = (unsigned)__shfl((int)cab, src); mcount = (unsigned)__shfl((int)mcount, src);
            const unsigned r = 256u - cab;
            if (mm != 0ull && mcount <= 64u) {
                LAS float* cand = (LAS float*)(hist + 1032);
#pragma unroll
                for (int gq = 0; gq < 4; ++gq) if (8 * gq < nreg) {
#pragma unroll
                    for (int j = 8 * gq; j < 8 * gq + 8; ++j) if (v[j] != NINF && (int)((v[j] - mn) * scale) == bstar) { const unsigned slot = __hip_atomic_fetch_add(hist + 1024, 1u, __ATOMIC_RELAXED, __HIP_MEMORY_SCOPE_WORKGROUP); if (slot < 64u) cand[slot] = v[j]; } }
                LDS_WAIT();
                const float x = (unsigned)lane < mcount ? cand[lane] : NINF; unsigned rank = 0u;
                for (unsigned i = 0; i < mcount; ++i) rank += (cand[i] >= x) ? 1u : 0u;
                float best = ((unsigned)lane < mcount && rank >= r) ? x : NINF;
#pragma unroll
                for (int o = 1; o < 64; o <<= 1) best = fmaxf(best, __shfl_xor(best, o));
                thr = best; found = true;
            }
        }
        if (!found) {
            int chi; CNT_GE(mx, chi);
            Bracket B; br_init(B, mn, mx, t + 1, chi);
#pragma unroll 1
            while (!B.done) { const float c = br_next(B); if (B.done) break; int cnt; CNT_GE(c, cnt); br_update(B, c, cnt); }
            thr = B.thr;
        }
#pragma unroll
        for (int j = 0; j < 32; ++j) { const u64 w = __ballot(v[j] >= thr); if (lane == j) myword = w; if ((j & 7) == 7) __builtin_amdgcn_sched_barrier(0); }
#undef CNT_GE
    }
    if (lane < 32) bm[(size_t)row * 32 + lane] = myword;
}
__device__ __forceinline__ void select_sample_row(int r, int tid, int lane, int wave, const float* __restrict__ ssc, int* __restrict__ sidx, LAS unsigned* red) {
    const int L = PAST + 1 + (r & 3); const float NINF = -__builtin_inff();
    float v[33]; const float* sr = ssc + (size_t)r * SSTR;
#pragma unroll
    for (int j = 0; j < 33; ++j) { const int s = j * 512 + tid; v[j] = s < L ? sr[s] : NINF; }
    LAS float* redf = (LAS float*)red;
    float mx = v[0], mn = v[0];
#pragma unroll
    for (int j = 1; j < 33; ++j) { mx = fmaxf(mx, v[j]); mn = fminf(mn, v[j] == NINF ? __builtin_inff() : v[j]); }
#pragma unroll
    for (int o = 1; o < 64; o <<= 1) { mx = fmaxf(mx, __shfl_xor(mx, o)); mn = fminf(mn, __shfl_xor(mn, o)); }
    if (lane == 0) { redf[32 + wave] = mx; redf[40 + wave] = mn; }
    __syncthreads();
#pragma unroll
    for (int w = 0; w < 8; ++w) { mx = fmaxf(mx, redf[32 + w]); mn = fminf(mn, redf[40 + w]); }
    mx = __builtin_bit_cast(float, __builtin_amdgcn_readfirstlane(__builtin_bit_cast(int, mx))); mn = __builtin_bit_cast(float, __builtin_amdgcn_readfirstlane(__builtin_bit_cast(int, mn)));
    int par = 0;
#define BCNT_GE(c, dst) do { int c_ = 0; _Pragma("unroll") for (int j = 0; j < 33; ++j) c_ += (v[j] >= (c)) ? 1 : 0; _Pragma("unroll") for (int o = 1; o < 64; o <<= 1) c_ += __shfl_xor(c_, o); \
        LAS unsigned* buf_ = red + par * 8; par ^= 1; if (lane == 0) buf_[wave] = (unsigned)c_; __syncthreads(); int tot_ = 0; _Pragma("unroll") for (int w = 0; w < 8; ++w) tot_ += (int)buf_[w]; dst = __builtin_amdgcn_readfirstlane(tot_); } while (0)
    int chi; BCNT_GE(mx, chi);
    Bracket B; br_init(B, mn, mx, L, chi);
#pragma unroll 1
    while (!B.done) { const float c = br_next(B); if (B.done) break; int cnt; BCNT_GE(c, cnt); br_update(B, c, cnt); }
#undef BCNT_GE
    const float thr = B.thr;
    int c = 0;
#pragma unroll
    for (int j = 0; j < 33; ++j) c += (v[j] >= thr) ? 1 : 0;
    int incl = c;
#pragma unroll
    for (int o = 1; o < 64; o <<= 1) { const int x = __shfl_up(incl, o); if (lane >= o) incl += x; }
    __syncthreads();
    if (lane == 63) red[16 + wave] = (unsigned)incl;
    __syncthreads();
    int base = incl - c;
#pragma unroll
    for (int w = 0; w < 8; ++w) if (w < wave) base += (int)red[16 + w];
    int* so = sidx + r * 256;
#pragma unroll
    for (int j = 0; j < 33; ++j) if (v[j] >= thr) { if (base < 256) so[base] = j * 512 + tid; ++base; }
    __syncthreads();
}
struct SsmConst { const float* abar; const float* a32; const bf16_t* bbt; const bf16_t* cmt; };
template <int MODE>
__device__ __forceinline__ void ssm_task(int set, int g, int chunk, int lane, const SsmConst sc, const bf16_t* __restrict__ proj, const float* __restrict__ dvec,
                                         f32x2* __restrict__ SE, const f32x2* __restrict__ SIN, const float* __restrict__ s0re, const float* __restrict__ s0im,
                                         bf16_t* __restrict__ zb, float* __restrict__ ore, float* __restrict__ oim) {
    const int bq = lane & 15, q = lane >> 4; const int b = set * 16 + bq;
    bf16x4 bbt[8];
#pragma unroll
    for (int j = 0; j < 8; ++j) bbt[j] = *(const bf16x4*)(sc.bbt + ((size_t)(g * 128 + 16 * j + bq)) * 16 + 4 * q);
    float ar[16], ai[16], sr[16], si[16];
#pragma unroll
    for (int m = 0; m < 16; ++m) { const f32x2 a = *(const f32x2*)(sc.abar + ((size_t)(g * 64 + 16 * q + m)) * 2); ar[m] = a.x; ai[m] = a.y; sr[m] = 0.f; si[m] = 0.f; }
    bf16x8 cmt[4]; f32x4 dv = {0.f, 0.f, 0.f, 0.f};
    if (MODE != 0) {
#pragma unroll
        for (int j = 0; j < 4; ++j) cmt[j] = *(const bf16x8*)(sc.cmt + ((size_t)(g * 16 + bq)) * 128 + 32 * j + 8 * q);
        dv = *(const f32x4*)(dvec + 16 * g + 4 * q);
    }
    size_t row0; int nstep;
    if (MODE == 2) { row0 = (size_t)TP + 4 * b; nstep = DT;
#pragma unroll
        for (int m = 0; m < 16; ++m) { sr[m] = s0re[((size_t)b * SG + g) * SN + 16 * q + m]; si[m] = s0im[((size_t)b * SG + g) * SN + 16 * q + m]; } }
    else { row0 = (size_t)b * SEQ + (size_t)chunk * SSM_L; nstep = SSM_L;
        if (MODE == 1) {
#pragma unroll
            for (int m = 0; m < 16; ++m) { const f32x2 s = SIN[(((size_t)b * SSM_NCH + chunk) * SG + g) * SN + 16 * q + m]; sr[m] = s.x; si[m] = s.y; } } }
    const bf16_t* up = proj + row0 * INWP + C_U + 16 * g + 4 * q;
    constexpr int UB = 4;
    bf16x4 ub[UB], un[UB];
#pragma unroll
    for (int i = 0; i < UB; ++i) ub[i] = *(const bf16x4*)(up + (size_t)i * INWP);
#pragma unroll 1
    for (int t0 = 0; t0 < nstep; t0 += UB) {
        if (t0 + UB < nstep) {
#pragma unroll
            for (int i = 0; i < UB; ++i) un[i] = *(const bf16x4*)(up + (size_t)(t0 + UB + i) * INWP); }
#pragma unroll
        for (int i = 0; i < UB; ++i) {
            const bf16x4 ucur = ub[i]; const int t = t0 + i;
            f32x4 y = {0.f, 0.f, 0.f, 0.f};
#pragma unroll
            for (int jh = 0; jh < 4; ++jh) {
                const f32x4 bur = __builtin_amdgcn_mfma_f32_16x16x16bf16_1k(bbt[2 * jh], ucur, (f32x4){0.f, 0.f, 0.f, 0.f}, 0, 0, 0);
                const f32x4 bui = __builtin_amdgcn_mfma_f32_16x16x16bf16_1k(bbt[2 * jh + 1], ucur, (f32x4){0.f, 0.f, 0.f, 0.f}, 0, 0, 0);
#pragma unroll
                for (int ii = 0; ii < 4; ++ii) { const int m = 4 * jh + ii; const float nr = ar[m] * sr[m] - ai[m] * si[m] + bur[ii], ni = ar[m] * si[m] + ai[m] * sr[m] + bui[ii]; sr[m] = nr; si[m] = ni; }
                if (MODE != 0) { u32x4 w; w.x = cvt_pk_bf16(sr[4 * jh], sr[4 * jh + 1]); w.y = cvt_pk_bf16(sr[4 * jh + 2], sr[4 * jh + 3]); w.z = cvt_pk_bf16(si[4 * jh], si[4 * jh + 1]); w.w = cvt_pk_bf16(si[4 * jh + 2], si[4 * jh + 3]);
                    y = __builtin_amdgcn_mfma_f32_16x16x32_bf16(cmt[jh], as_bf16x8(w), y, 0, 0, 0); }
            }
            if (MODE != 0) {
                const u32x2 uw = __builtin_bit_cast(u32x2, ucur);
                const f32x4 uf = (f32x4){bf_lo(uw.x), bf_hi(uw.x), bf_lo(uw.y), bf_hi(uw.y)};
                y += dv * uf;
                u32x2 zo; zo.x = cvt_pk_bf16(gelu_tanh(y[0]), gelu_tanh(y[1])); zo.y = cvt_pk_bf16(gelu_tanh(y[2]), gelu_tanh(y[3]));
                *(u32x2*)(zb + (row0 + t) * SSMW + 16 * g + 4 * q) = zo;
            }
            __builtin_amdgcn_sched_barrier(0);
        }
#pragma unroll
        for (int i = 0; i < UB; ++i) ub[i] = un[i];
    }
    if (MODE == 0) {
        f32x2* e = SE + (((size_t)b * SSM_NCH + chunk) * SG + g) * SN + 16 * q;
#pragma unroll
        for (int m = 0; m < 16; ++m) e[m] = (f32x2){sr[m], si[m]};
    }
    if (MODE == 2) {
#pragma unroll
        for (int m = 0; m < 16; ++m) { ore[((size_t)b * SG + g) * SN + 16 * q + m] = sr[m]; oim[((size_t)b * SG + g) * SN + 16 * q + m] = si[m]; }
    }
}
__device__ __forceinline__ void ssm_carry(int idx  , const float* __restrict__ a32, const f32x2* __restrict__ SE, f32x2* __restrict__ SIN, float* __restrict__ ore, float* __restrict__ oim) {
    const int b = idx >> 11, gn = idx & 2047;
    const f32x2 a = *(const f32x2*)(a32 + (size_t)gn * 2);
    float sr = 0.f, si = 0.f;
#pragma unroll 1
    for (int jb = 0; jb < SSM_NCH; jb += 16) {
        f32x2 e[16];
#pragma unroll
        for (int i = 0; i < 16; ++i) e[i] = SE[((size_t)b * SSM_NCH + jb + i) * (SG * SN) + gn];
#pragma unroll
        for (int i = 0; i < 16; ++i) { SIN[((size_t)b * SSM_NCH + jb + i) * (SG * SN) + gn] = (f32x2){sr, si}; const float nr = a.x * sr - a.y * si + e[i].x, ni = a.x * si + a.y * sr + e[i].y; sr = nr; si = ni; }
    }
    ore[(size_t)b * (SG * SN) + gn] = sr; oim[(size_t)b * (SG * SN) + gn] = si;
}
__device__ __forceinline__ void ssm_constants(int e, const float* __restrict__ a_re, const float* __restrict__ a_im, const float* __restrict__ log_dt, const float* __restrict__ b_re, const float* __restrict__ b_im,
                                              const float* __restrict__ c_re, const float* __restrict__ c_im, unsigned char* __restrict__ ssc) {
    const int gn = e >> 5, ri = (e >> 4) & 1, c = e & 15;
    const int g = gn >> 6, n = gn & 63;
    double dt, dum; cexp_d((double)log_dt[g], 0.0, 10, dt, dum);
    const double lr = (double)a_re[gn], li = (double)a_im[gn];
    double abr, abi; cexp_d(lr * dt, li * dt, 10, abr, abi);
    const double den = lr * lr + li * li;
    const double fr = ((abr - 1.0) * lr + abi * li) / den, fi = (abi * lr - (abr - 1.0) * li) / den;
    if ((e & 31) == 0) {
        double p32r = abr, p32i = abi;
#pragma unroll 1
        for (int i = 0; i < 5; ++i) { const double nr = p32r * p32r - p32i * p32i, ni = 2.0 * p32r * p32i; p32r = nr; p32i = ni; }
        float* ab = (float*)(ssc + SSC_ABAR) + (size_t)gn * 2; ab[0] = (float)abr; ab[1] = (float)abi;
        float* a3 = (float*)(ssc + SSC_A32) + (size_t)gn * 2; a3[0] = (float)p32r; a3[1] = (float)p32i;
    }
    bf16_t* bbt = (bf16_t*)(ssc + SSC_BBT); bf16_t* cmt = (bf16_t*)(ssc + SSC_CMT);
    const int qq = n >> 4, jh = (n >> 2) & 3, i = n & 3;
    const int rowl = 16 * (2 * jh + ri) + 4 * qq + i;
    const int kap = 32 * jh + 8 * qq + 4 * ri + i;
    const double br = (double)b_re[(size_t)gn * 16 + c], bi = (double)b_im[(size_t)gn * 16 + c];
    const double v = ri == 0 ? (fr * br - fi * bi) : (fr * bi + fi * br);
    bbt[((size_t)g * 128 + rowl) * 16 + c] = (bf16_t)(cvt_pk_bf16((float)v, 0.f) & 0xffffu);
    const float cv = ri == 0 ? c_re[((size_t)g * 16 + c) * 64 + n] : -c_im[((size_t)g * 16 + c) * 64 + n];
    cmt[((size_t)g * 16 + c) * 128 + kap] = (bf16_t)(cvt_pk_bf16(cv, 0.f) & 0xffffu);
}
namespace att {
constexpr int D = 128, NW = 8, QBLK = 32, KVBLK = 64, QB = NW * QBLK;
constexpr int SHM_V = KVBLK * D * 2, SHM_K = KVBLK * D * 2;
constexpr int LDS_BYTES_ATT = 2 * SHM_V + 2 * SHM_K + NW * 64 * 4;
constexpr int QS = 1024, KS = 256;
constexpr float SCALE = 0.08838834764831845f, THR = 8.f;
#define KSWZ(row, colB) ((row) * 256 + ((colB) ^ (((row) & 7) << 4)))
#define SBAR() __builtin_amdgcn_sched_barrier(0)
__device__ __forceinline__ int v_st(int k, int c) { const int kk = (k & ~0xC) | ((k & 4) << 1) | ((k & 8) >> 1); return ((kk >> 3) * 4 + (c >> 5)) * 512 + ((kk & 7) * 32 + (c & 31)) * 2; }
__device__ __forceinline__ int v_rd_base(int lane) { return ((lane & 3) << 3) | (((lane >> 2) & 3) << 6) | (((lane >> 4) & 1) << 5) | (((lane >> 5) & 1) << 8); }
constexpr int v_rd_off(int d0, int ks, int half) { return d0 * 512 + ks * 4096 + half * 2048; }
__device__ __forceinline__ int crow(int r, int hi) { return (r & 3) + 8 * (r >> 2) + 4 * hi; }
__device__ __forceinline__ bf16x8 load8(const bf16_t* p) { return *reinterpret_cast<const bf16x8*>(p); }
__device__ __forceinline__ void mask_bits(f32x16& p0, f32x16& p1, u64 w, int hi) {
    const float NEG = -__builtin_inff();
    const unsigned lo = (unsigned)w >> (4 * hi), hh = (unsigned)(w >> 32) >> (4 * hi);
#pragma unroll
    for (int r = 0; r < 16; ++r) {
        const int c = (r & 3) + 8 * (r >> 2);
        if (!((lo >> c) & 1u)) p0[r] = NEG;
        if (!((hh >> c) & 1u)) p1[r] = NEG;
    }
}
__device__ __forceinline__ void partialSM(f32x16& p0, f32x16& p1, float& m_reg, float& mn, float& alpha) {
    float pmax = p0[0]; for (int r = 1; r < 16; ++r) pmax = fmaxf(pmax, p0[r]); for (int r = 0; r < 16; ++r) pmax = fmaxf(pmax, p1[r]);
    { auto rr = __builtin_amdgcn_permlane32_swap(__float_as_uint(pmax), __float_as_uint(pmax), false, false);
      pmax = fmaxf(__uint_as_float(rr[0]), __uint_as_float(rr[1])); }
    constexpr float C2 = 1.4426950408889634f * SCALE;
    if (__builtin_expect(__all((pmax - m_reg) * SCALE <= THR), 1)) { mn = m_reg; alpha = 1.f; }
    else { mn = fmaxf(m_reg, pmax); alpha = __builtin_amdgcn_exp2f((m_reg - mn) * C2); m_reg = mn; }
    const float mnL = -mn * C2;
    for (int r = 0; r < 16; ++r) p0[r] = fmaf(p0[r], C2, mnL); for (int r = 0; r < 16; ++r) p1[r] = fmaf(p1[r], C2, mnL);
    for (int r = 0; r < 16; ++r) p0[r] = __builtin_amdgcn_exp2f(p0[r]);
}
__device__ __forceinline__ void finishSM(f32x16& p0, f32x16& p1, float alpha, float& l_reg, bf16x8& pa0, bf16x8& pa1, bf16x8& pa2, bf16x8& pa3) {
    for (int r = 0; r < 16; ++r) p1[r] = __builtin_amdgcn_exp2f(p1[r]);
    float ps = 0; for (int r = 0; r < 16; ++r) ps += p0[r]; for (int r = 0; r < 16; ++r) ps += p1[r];
    { auto rr = __builtin_amdgcn_permlane32_swap(__float_as_uint(ps), __float_as_uint(ps), false, false);
      ps = __uint_as_float(rr[0]) + __uint_as_float(rr[1]); }
    l_reg = l_reg * alpha + ps;
#define PK4(P, B_, OUT) do { unsigned a0 = cvt_pk_bf16(P[B_+0], P[B_+1]), a1 = cvt_pk_bf16(P[B_+2], P[B_+3]);                          \
        unsigned b0 = cvt_pk_bf16(P[B_+4], P[B_+5]), b1 = cvt_pk_bf16(P[B_+6], P[B_+7]);                                             \
        auto r0 = __builtin_amdgcn_permlane32_swap(a0, b0, false, false); auto r1 = __builtin_amdgcn_permlane32_swap(a1, b1, false, false); \
        u32x4 w = {r0[0], r1[0], r0[1], r1[1]}; OUT = *reinterpret_cast<bf16x8*>(&w); } while (0)
    PK4(p0, 0, pa0); PK4(p0, 8, pa1); PK4(p1, 0, pa2); PK4(p1, 8, pa3);
#undef PK4
}
template <int KB>
__device__ __forceinline__ void qkt(f32x16& p0, f32x16& p1, const char* K_lds, int r32, int hi, const bf16x8* qr) {
    p0 = f32x16{}; p1 = f32x16{};
    const char* kb[4];
#pragma unroll
    for (int dd = 0; dd < 4; ++dd) kb[dd] = K_lds + KB * SHM_K + KSWZ(r32, (dd * 16 + hi * 8) * 2);
#pragma unroll
    for (int d0 = 0; d0 < 8; ++d0) { const char* a = kb[d0 & 3] + (d0 >> 2) * 128;
        bf16x8 b0 = *reinterpret_cast<const bf16x8*>(a);
        bf16x8 b1 = *reinterpret_cast<const bf16x8*>(a + 32 * 256);
        p0 = __builtin_amdgcn_mfma_f32_32x32x16_bf16(b0, qr[d0], p0, 0, 0, 0);
        p1 = __builtin_amdgcn_mfma_f32_32x32x16_bf16(b1, qr[d0], p1, 0, 0, 0); }
}
typedef short s16x4 __attribute__((ext_vector_type(4)));
template <int VB>
__device__ __forceinline__ void pv_tile(f32x16* o, int vb0, bf16x8 pa0, bf16x8 pa1, bf16x8 pa2, bf16x8 pa3) {
#define TRRD(dst, off) asm volatile("ds_read_b64_tr_b16 %0, %1 offset:%2" : "=&v"(dst) : "v"(vb0), "i"(off) : "memory")
#define PV_D0(d0) do { s16x4 l0, l1, l2, l3, h0, h1, h2, h3; constexpr int b_ = VB * SHM_V + v_rd_off(d0, 0, 0); \
        TRRD(l0, b_); TRRD(h0, b_ + 2048); TRRD(l1, b_ + 4096); TRRD(h1, b_ + 6144); TRRD(l2, b_ + 8192); TRRD(h2, b_ + 10240); TRRD(l3, b_ + 12288); TRRD(h3, b_ + 14336); \
        asm volatile("s_waitcnt lgkmcnt(0)" ::: "memory"); SBAR();   \
        o[d0] = __builtin_amdgcn_mfma_f32_32x32x16_bf16(pa0, (bf16x8){l0[0], l0[1], l0[2], l0[3], h0[0], h0[1], h0[2], h0[3]}, o[d0], 0, 0, 0);   \
        o[d0] = __builtin_amdgcn_mfma_f32_32x32x16_bf16(pa1, (bf16x8){l1[0], l1[1], l1[2], l1[3], h1[0], h1[1], h1[2], h1[3]}, o[d0], 0, 0, 0);   \
        o[d0] = __builtin_amdgcn_mfma_f32_32x32x16_bf16(pa2, (bf16x8){l2[0], l2[1], l2[2], l2[3], h2[0], h2[1], h2[2], h2[3]}, o[d0], 0, 0, 0);   \
        o[d0] = __builtin_amdgcn_mfma_f32_32x32x16_bf16(pa3, (bf16x8){l3[0], l3[1], l3[2], l3[3], h3[0], h3[1], h3[2], h3[3]}, o[d0], 0, 0, 0); } while (0)
    PV_D0(0); PV_D0(1); PV_D0(2); PV_D0(3);
#undef PV_D0
#undef TRRD
}
struct BlockRef { const bf16_t* Q; const bf16_t* K; const bf16_t* V; bf16_t* O; const u64* MB; int P0; };
struct Seam { bf16x8 qr[8]; bf16x8 st_v0, st_v1, st_k0, st_k1; };
#define ROWK(p, k0, rr) ((p) + (size_t)((k0) + (rr)) * KS + sc)
#define VMW() asm volatile("s_waitcnt vmcnt(0)" ::: "memory")
#define VMWN(n) asm volatile("s_waitcnt vmcnt(%0)" :: "i"(n) : "memory")
#define SLOAD_H(Kp, Vp, k0) do { S.st_v0 = load8(ROWK(Vp, k0, sr)); S.st_v1 = load8(ROWK(Vp, k0, 32 + sr));              \
                         S.st_k0 = load8(ROWK(Kp, k0, sr)); S.st_k1 = load8(ROWK(Kp, k0, 32 + sr)); } while (0)
#define SWRITE_HK(bf) do { *(bf16x8*)(K_lds + (bf) * SHM_K + kws) = S.st_k0; *(bf16x8*)(K_lds + (bf) * SHM_K + kws + 32 * 256) = S.st_k1; } while (0)
#define SWRITE_HV(bf) do { *(bf16x8*)(V_lds + (bf) * SHM_V + vst0) = S.st_v0; *(bf16x8*)(V_lds + (bf) * SHM_V + vst1) = S.st_v1; } while (0)
#define SWRITE_H(bf) do { SWRITE_HV(bf); SWRITE_HK(bf); } while (0)
__device__ __forceinline__ void attn_prime(const BlockRef& cur, char* lds, Seam& S, int wid) {
    const int lane = lane_id_(), tid = wid * 64 + lane, r32 = lane & 31, hi = lane >> 5;
    const int sr = tid >> 4, sc = (tid & 15) * 8, kws = KSWZ(sr, sc * 2); char* K_lds = lds + 2 * SHM_V;
    for (int d0 = 0; d0 < 8; ++d0) S.qr[d0] = load8(cur.Q + (size_t)(wid * QBLK + r32) * QS + d0 * 16 + hi * 8);
    SLOAD_H(cur.K, cur.V, 0); VMW(); SWRITE_HK(0);
    __syncthreads();
}
__device__ __forceinline__ void attn_block(const BlockRef& cur, const BlockRef& nxt, char* lds, Seam& S, int wid) {
    const int lane = lane_id_(), tid = wid * 64 + lane, r32 = lane & 31, hi = lane >> 5;
    const int NT = cur.P0 / KVBLK + QB / KVBLK;
    char* V_lds = lds; char* K_lds = lds + 2 * SHM_V;
    float* ws = (float*)(lds + 2 * SHM_V + 2 * SHM_K) + wid * 64; float* li_l = ws, * al_l = ws + 32;
    float m_reg = -1e30f, l_reg = 0; f32x16 o[4] = {};
    const int sr = tid >> 4, sc = (tid & 15) * 8, vst0 = v_st(sr, sc), vst1 = v_st(32 + sr, sc), kws = KSWZ(sr, sc * 2);
    const int vb0 = (int)(uintptr_t)V_lds + v_rd_base(lane);
    const bf16_t* Kh = cur.K; const bf16_t* Vh = cur.V;
    const u64* mrow = cur.MB + (size_t)(wid * QBLK + r32) * 32;
    u64 mw;
#define RESC(a) do { if (__any((a) < 1.f)) { if (hi == 0) al_l[r32] = (a); asm volatile("s_waitcnt lgkmcnt(0)" ::: "memory");              \
                     for (int d_ = 0; d_ < 4; ++d_) for (int r = 0; r < 16; ++r) o[d_][r] *= al_l[crow(r, hi)]; } } while (0)
#define KBASE(t) ((t) * KVBLK)
    constexpr int NQL = 8;
#define SEAM_K0() do { VMWN(NQL); SWRITE_HK(0); SBAR(); } while (0)
    f32x16 pA0, pA1, pB0, pB1; float mnA, mnB, alA, alB; bf16x8 pa0, pa1, pa2, pa3;
    SWRITE_HV(0); SBAR();
    if (NT > 1) { SLOAD_H(Kh, Vh, KBASE(1)); }
    mw = mrow[0];
    SBAR(); qkt<0>(pA0, pA1, K_lds, r32, hi, S.qr);
    mask_bits(pA0, pA1, mw, hi); partialSM(pA0, pA1, m_reg, mnA, alA);
    if (NT > 1) { VMW(); SWRITE_H(1); }
    __syncthreads();
#define HALF_STEP(PX0, PX1, mnX, alX, PY0, PY1, alY, t, KB, VB, SB) do {                                                      \
        SBAR(); mw = mrow[(t)]; qkt<KB>(PX0, PX1, K_lds, r32, hi, S.qr);                                             \
        finishSM(PY0, PY1, alY, l_reg, pa0, pa1, pa2, pa3); SBAR();                                                           \
        if ((t) + 1 < NT) { SLOAD_H(Kh, Vh, KBASE((t) + 1)); SBAR(); }                                               \
        pv_tile<VB>(o, vb0, pa0, pa1, pa2, pa3); mask_bits(PX0, PX1, mw, hi); partialSM(PX0, PX1, m_reg, mnX, alX);                                        \
        __syncthreads();                                                                                                      \
        if ((t) + 1 < NT) { VMW(); SWRITE_H(SB); }                                                                          \
        RESC(alX); __syncthreads(); } while (0)
    for (int t = 1; t + 1 < NT; t += 2) {
        HALF_STEP(pB0, pB1, mnB, alB, pA0, pA1, alA, t, 1, 0, 0);
        HALF_STEP(pA0, pA1, mnA, alA, pB0, pB1, alB, t + 1, 0, 1, 1);
    }
    SBAR(); mw = mrow[NT - 1]; qkt<1>(pB0, pB1, K_lds, r32, hi, S.qr); SBAR();
    SLOAD_H(nxt.K, nxt.V, 0); SBAR();
#pragma unroll
    for (int d0 = 0; d0 < 8; ++d0) S.qr[d0] = load8(nxt.Q + (size_t)(wid * QBLK + r32) * QS + d0 * 16 + hi * 8);
    SBAR();
    finishSM(pA0, pA1, alA, l_reg, pa0, pa1, pa2, pa3); SBAR();
    pv_tile<0>(o, vb0, pa0, pa1, pa2, pa3);
    mask_bits(pB0, pB1, mw, hi); partialSM(pB0, pB1, m_reg, mnB, alB); __syncthreads(); RESC(alB);
    finishSM(pB0, pB1, alB, l_reg, pa0, pa1, pa2, pa3); SBAR(); pv_tile<1>(o, vb0, pa0, pa1, pa2, pa3);
    SBAR(); SEAM_K0();
    if (hi == 0) li_l[r32] = l_reg; asm volatile("s_waitcnt lgkmcnt(0)" ::: "memory");
    float rli[16];
#pragma unroll
    for (int r = 0; r < 16; ++r) rli[r] = __builtin_amdgcn_rcpf(li_l[crow(r, hi)]);
    bf16_t* Ow = cur.O + (size_t)(wid * QBLK) * QS;
#pragma unroll
    for (int r = 0; r < 16; ++r) { const int orow = crow(r, hi);
#pragma unroll
        for (int d0 = 0; d0 < 4; ++d0) { const float v = o[d0][r] * rli[r];
            const float vn = __shfl_xor(v, 1);
            if ((r32 & 1) == 0) *(unsigned*)(Ow + (size_t)orow * QS + d0 * 32 + r32) = cvt_pk_bf16(v, vn); } }
    __syncthreads();
#undef RESC
#undef KBASE
#undef SEAM_K0
#undef HALF_STEP
}
#undef ROWK
#undef VMW
#undef VMWN
#undef SLOAD_H
#undef SWRITE_HK
#undef SWRITE_HV
#undef SWRITE_H
#undef KSWZ
}
__device__ __forceinline__ void sample_attn_unit(int u, int tid, int lane, int wave, LAS unsigned char* lds, const bf16_t* __restrict__ qn, const int* __restrict__ sidx, const int* __restrict__ pt,
                                                 const float* __restrict__ ck, const float* __restrict__ cv, const float* __restrict__ out, bf16_t* __restrict__ oatt) {
    const int b = u >> 3, t = (u >> 1) & 3, kvh = u & 1; const size_t row = (size_t)TP + 4 * b + t;
    LAS unsigned char* kv = lds; LAS int* lidx = (LAS int*)(lds + 69632); LAS float* lq = (LAS float*)(lds + 70656); LAS float* lp = (LAS float*)(lds + 72704);
    LAS float* lred = (LAS float*)(lds + 76800); LAS float* lo2 = (LAS float*)(lds + 77056);
    if (tid < 256) { const int idx = sidx[(b * 4 + t) * 256 + tid]; lidx[tid] = idx < PAST ? pt[b * NPG + (idx >> 7)] * PAGE + (idx & 127) : -(1 + idx - PAST); }
    lq[tid] = bf2f(qn[row * 1024 + kvh * 512 + tid]);
    __syncthreads();
    { f32x2 kvv[32];
#pragma unroll
      for (int kk = 0; kk < 32; ++kk) { const int pr = lidx[wave * 32 + kk];
          const float* src = pr >= 0 ? ck + ((size_t)pr * 2 + kvh) * 128 : out + O_KS + ((size_t)(b * 4 - 1 - pr) * 2 + kvh) * 128;
          kvv[kk] = *(const f32x2*)(src + 2 * lane); }
#pragma unroll
      for (int kk = 0; kk < 32; ++kk) *(LAS unsigned*)(kv + (wave * 32 + kk) * 272 + 4 * lane) = cvt_pk_bf16(kvv[kk].x, kvv[kk].y); }
    __syncthreads();
    const int key = tid & 255, hp = tid >> 8;
    float s0 = 0.f, s1 = 0.f;
    { const LAS unsigned char* kr = kv + key * 272; const LAS float* q0 = lq + (2 * hp) * 128; const LAS float* q1 = q0 + 128;
#pragma unroll
      for (int c = 0; c < 16; ++c) { const u32x4 w = *(const LAS u32x4*)(kr + 16 * c); f32x4 a, bb; unpack8(w, a, bb);
          const f32x4 qa = *(const LAS f32x4*)(q0 + 8 * c), qb = *(const LAS f32x4*)(q0 + 8 * c + 4), ra = *(const LAS f32x4*)(q1 + 8 * c), rb = *(const LAS f32x4*)(q1 + 8 * c + 4);
          s0 += (a[0] * qa[0] + a[1] * qa[1]) + (a[2] * qa[2] + a[3] * qa[3]) + (bb[0] * qb[0] + bb[1] * qb[1]) + (bb[2] * qb[2] + bb[3] * qb[3]);
          s1 += (a[0] * ra[0] + a[1] * ra[1]) + (a[2] * ra[2] + a[3] * ra[3]) + (bb[0] * rb[0] + bb[1] * rb[1]) + (bb[2] * rb[2] + bb[3] * rb[3]); } }
    s0 *= 0.08838834764831845f; s1 *= 0.08838834764831845f;
    float m0 = s0, m1 = s1;
#pragma unroll
    for (int o = 1; o < 64; o <<= 1) { m0 = fmaxf(m0, __shfl_xor(m0, o)); m1 = fmaxf(m1, __shfl_xor(m1, o)); }
    if (lane == 0) { lred[wave * 2] = m0; lred[wave * 2 + 1] = m1; }
    __syncthreads();
    { const int w0 = hp * 4; m0 = fmaxf(fmaxf(lred[w0 * 2], lred[w0 * 2 + 2]), fmaxf(lred[w0 * 2 + 4], lred[w0 * 2 + 6])); m1 = fmaxf(fmaxf(lred[w0 * 2 + 1], lred[w0 * 2 + 3]), fmaxf(lred[w0 * 2 + 5], lred[w0 * 2 + 7])); }
    const float p0 = __expf(s0 - m0), p1 = __expf(s1 - m1);
    lp[(2 * hp) * 256 + key] = p0; lp[(2 * hp + 1) * 256 + key] = p1;
    const float t0 = wave_sum(p0), t1 = wave_sum(p1);
    if (lane == 0) { lred[16 + wave * 2] = t0; lred[16 + wave * 2 + 1] = t1; }
    __syncthreads();
    { f32x2 kvv[32];
#pragma unroll
      for (int kk = 0; kk < 32; ++kk) { const int pr = lidx[wave * 32 + kk];
          const float* src = pr >= 0 ? cv + ((size_t)pr * 2 + kvh) * 128 : out + O_VS + ((size_t)(b * 4 - 1 - pr) * 2 + kvh) * 128;
          kvv[kk] = *(const f32x2*)(src + 2 * lane); }
#pragma unroll
      for (int kk = 0; kk < 32; ++kk) *(LAS unsigned*)(kv + (wave * 32 + kk) * 256 + 4 * lane) = cvt_pk_bf16(kvv[kk].x, kvv[kk].y); }
    __syncthreads();
    const int dp = lane, head = wave & 3, kh = wave >> 2;
    float o0 = 0.f, o1 = 0.f;
#pragma unroll 8
    for (int k = kh * 128; k < kh * 128 + 128; ++k) { const unsigned w = *(const LAS unsigned*)(kv + k * 256 + 4 * dp); const float p = lp[head * 256 + k]; o0 += p * bf_lo(w); o1 += p * bf_hi(w); }
    if (kh == 1) { lo2[head * 128 + 2 * dp] = o0; lo2[head * 128 + 2 * dp + 1] = o1; }
    __syncthreads();
    if (kh == 0) { const int hq = head >> 1, hb = head & 1; const int w0 = hq * 4;
        const float sum = (lred[16 + w0 * 2 + hb] + lred[16 + w0 * 2 + 2 + hb]) + (lred[16 + w0 * 2 + 4 + hb] + lred[16 + w0 * 2 + 6 + hb]);
        const float inv = 1.0f / sum; o0 = (o0 + lo2[head * 128 + 2 * dp]) * inv; o1 = (o1 + lo2[head * 128 + 2 * dp + 1]) * inv;
        *(unsigned*)(oatt + row * 1024 + (kvh * 4 + head) * 128 + 2 * dp) = cvt_pk_bf16(o0, o1); }
    __syncthreads();
}
__device__ __forceinline__ void ld8bf(const bf16_t* p, float (&v)[8]) { const u32x4 a = __builtin_nontemporal_load((const u32x4*)p); v[0] = bf_lo(a.x); v[1] = bf_hi(a.x); v[2] = bf_lo(a.y); v[3] = bf_hi(a.y); v[4] = bf_lo(a.z); v[5] = bf_hi(a.z); v[6] = bf_lo(a.w); v[7] = bf_hi(a.w); }
__device__ __forceinline__ void ld8f(const float* p, float (&v)[8]) { const f32x4 a = *(const f32x4*)p, b = *(const f32x4*)(p + 4); v[0] = a.x; v[1] = a.y; v[2] = a.z; v[3] = a.w; v[4] = b.x; v[5] = b.y; v[6] = b.z; v[7] = b.w; }
__device__ __forceinline__ void st8f(float* p, const float (&v)[8]) { *(f32x4*)p = (f32x4){v[0], v[1], v[2], v[3]}; *(f32x4*)(p + 4) = (f32x4){v[4], v[5], v[6], v[7]}; }
__device__ __forceinline__ void conv_item(int rblk, int cg, int lane, const bf16_t* __restrict__ up, bf16_t* __restrict__ act, const float* __restrict__ cw, const float* __restrict__ cb,
                                          const float* __restrict__ sconv, float* __restrict__ out) {
    const int col = 512 * cg + 8 * lane; if (col >= DFF) return;
    float wg[3][8], wv[3][8], bg[8], bv[8], g2[8], g1[8], v2[8], v1[8];
#pragma unroll
    for (int j = 0; j < 3; ++j) { ld8f(cw + (size_t)j * DFF2 + col, wg[j]); ld8f(cw + (size_t)j * DFF2 + DFF + col, wv[j]); }
    ld8f(cb + col, bg); ld8f(cb + DFF + col, bv);
    size_t row0; int nrows; int tbase; int b; const bool samp = rblk >= 512;
    if (!samp) { b = rblk >> 5; tbase = (rblk & 31) * 64; row0 = (size_t)b * SEQ + tbase; nrows = 64;
        if (tbase == 0) {
#pragma unroll
            for (int e = 0; e < 8; ++e) { g2[e] = 0.f; g1[e] = 0.f; v2[e] = 0.f; v1[e] = 0.f; } }
        else { ld8bf(up + (row0 - 2) * DFF2 + col, g2); ld8bf(up + (row0 - 1) * DFF2 + col, g1); ld8bf(up + (row0 - 2) * DFF2 + DFF + col, v2); ld8bf(up + (row0 - 1) * DFF2 + DFF + col, v1); } }
    else { b = rblk - 512; tbase = 0; row0 = (size_t)TP + 4 * b; nrows = 4;
        ld8f(sconv + ((size_t)b * 2 + 0) * DFF2 + col, g2); ld8f(sconv + ((size_t)b * 2 + 1) * DFF2 + col, g1); ld8f(sconv + ((size_t)b * 2 + 0) * DFF2 + DFF + col, v2); ld8f(sconv + ((size_t)b * 2 + 1) * DFF2 + DFF + col, v1); }
#pragma unroll 2
    for (int r = 0; r < nrows; ++r) {
        float gc[8], vc[8], a[8];
        ld8bf(up + (row0 + r) * DFF2 + col, gc); ld8bf(up + (row0 + r) * DFF2 + DFF + col, vc);
#pragma unroll
        for (int e = 0; e < 8; ++e) { const float cgt = wg[0][e] * g2[e] + wg[1][e] * g1[e] + wg[2][e] * gc[e] + bg[e]; const float cvl = wv[0][e] * v2[e] + wv[1][e] * v1[e] + wv[2][e] * vc[e] + bv[e]; a[e] = gelu_tanh(cgt) * cvl; }
        u32x4 w; w.x = cvt_pk_bf16(a[0], a[1]); w.y = cvt_pk_bf16(a[2], a[3]); w.z = cvt_pk_bf16(a[4], a[5]); w.w = cvt_pk_bf16(a[6], a[7]);
        __builtin_nontemporal_store(w, (u32x4*)(act + (row0 + r) * DFF + col));
        const int t = tbase + r;
        if (!samp && t >= SEQ - 2) { float* o = out + O_CVP + ((size_t)b * 2 + (t - (SEQ - 2))) * DFF2; st8f(o + col, gc); st8f(o + DFF + col, vc); }
        if (samp && t >= DT - 2) { float* o = out + O_CVS + ((size_t)b * 2 + (t - (DT - 2))) * DFF2; st8f(o + col, gc); st8f(o + DFF + col, vc); }
#pragma unroll
        for (int e = 0; e < 8; ++e) { g2[e] = g1[e]; g1[e] = gc[e]; v2[e] = v1[e]; v1[e] = vc[e]; }
    }
}
constexpr int NPH = 13;
#ifndef MK_REP
#define MK_REP {1,1,1,1,1,1,1,1,1,1,1,1,1}
#endif
__device__ constexpr int kRep[NPH] = MK_REP;
#ifndef MK_N_LAUNCHES
#define MK_N_LAUNCHES 1
#endif
#ifndef MUL_TA
#define MUL_TA 1
#endif
#ifndef MUL_SSMA
#define MUL_SSMA 1
#endif
#ifndef MUL_SEL
#define MUL_SEL 1
#endif
#ifndef MUL_SSMC
#define MUL_SSMC 1
#endif
#ifndef MUL_ATT
#define MUL_ATT 1
#endif
#ifndef MUL_SATT
#define MUL_SATT 1
#endif
#ifndef MUL_CONV
#define MUL_CONV 1
#endif
#ifndef MUL_IDXP
#define MUL_IDXP 1
#endif
#ifndef MUL_IDXS
#define MUL_IDXS 1
#endif
#ifndef MUL_CARRY
#define MUL_CARRY 1
#endif
#define WS_PTRS const int lane = lane_id_(); const int tid = wave * 64 + lane; (void)tid; GAS unsigned char* wsg_ = (GAS unsigned char*)ws; asm volatile("" : "+s"(wsg_)); unsigned char* wsl_ = (unsigned char*)wsg_;     float* RT = (float*)(wsl_ + WS_RT); unsigned char* SSC = ws + WS_SSC; bf16_t* WIN = (bf16_t*)(wsl_ + WS_WIN); bf16_t* WGLU = (bf16_t*)(wsl_ + WS_WGLU); bf16_t* WATT = (bf16_t*)(wsl_ + WS_WATT); bf16_t* WSSM = (bf16_t*)(wsl_ + WS_WSSM); bf16_t* WO = (bf16_t*)(wsl_ + WS_WO); bf16_t* WUP = (bf16_t*)(wsl_ + WS_WUP); bf16_t* WDN = (bf16_t*)(wsl_ + WS_WDN); bf16_t* WPLE = (bf16_t*)(wsl_ + WS_WPLE); bf16_t* WPG = (bf16_t*)(wsl_ + WS_WPG); bf16_t* H = (bf16_t*)(wsl_ + WS_H); bf16_t* PBF = (bf16_t*)(wsl_ + WS_PBF); bf16_t* PLER = (bf16_t*)(wsl_ + WS_PLER); float* RS0 = (float*)(wsl_ + WS_RSP); float* SSQ1 = (float*)(wsl_ + WS_RSP + 262144); float* SSQ2 = (float*)(wsl_ + WS_RSP + 524288); float* SSQP = (float*)(wsl_ + WS_RSP + 786432); bf16_t* PROJ = (bf16_t*)(wsl_ + WS_PROJ); bf16_t* QN = (bf16_t*)(wsl_ + WS_QN); bf16_t* KN = (bf16_t*)(wsl_ + WS_KN); bf16_t* VB = (bf16_t*)(wsl_ + WS_VB); bf16_t* IQ = (bf16_t*)(wsl_ + WS_IQ); bf16_t* IKR = (bf16_t*)(wsl_ + WS_IKR); float* IW = (float*)(wsl_ + WS_IW); float* SC = (float*)(wsl_ + WS_SC); float* SSC2 = (float*)(wsl_ + WS_SSC2); u64* BMK = (u64*)(wsl_ + WS_BM); int* SIDX = (int*)(wsl_ + WS_SIDX); bf16_t* OATT = (bf16_t*)(wsl_ + WS_OATT); bf16_t* Z = (bf16_t*)(wsl_ + WS_Z); bf16_t* Z2 = (bf16_t*)(wsl_ + WS_Z2); f32x2* SE = (f32x2*)(wsl_ + WS_SE); f32x2* SIN = (f32x2*)(wsl_ + WS_SIN); bf16_t* MRG = (bf16_t*)(wsl_ + WS_MRG); bf16_t* UP = (bf16_t*)(wsl_ + WS_UP); bf16_t* ACT = (bf16_t*)(wsl_ + WS_ACT); const SsmConst sscn{(const float*)(SSC + SSC_ABAR), (const float*)(SSC + SSC_A32), (const bf16_t*)(SSC + SSC_BBT), (const bf16_t*)(SSC + SSC_CMT)};
#ifndef WGM_IN
#define WGM_IN 3
#endif
#ifndef WGM_UP
#define WGM_UP 3
#endif
#ifndef WGM_DN
#define WGM_DN 3
#endif
#ifndef WGM_PG
#define WGM_PG 3
#endif
struct Args { const void* in[36]; float* out; unsigned char* ws; int ph_lo, ph_hi, bar_region, pad; };

__global__ void __launch_bounds__(NWAVES * 64, 2) fwd(Args args) {
    extern __shared__ __attribute__((aligned(16))) unsigned char lds_raw[];
    LAS unsigned char* lds = (LAS unsigned char*)lds_raw;
    const int wave = __builtin_amdgcn_readfirstlane((int)threadIdx.x >> 6);
    const int G = gridDim.x; const int bx = blockIdx.x; const int vcu = (G % 8 == 0) ? (bx % 8) * (G / 8) + bx / 8 : bx;
    const int gw = vcu * NWAVES + wave, NGW = G * NWAVES;
    unsigned char* ws = args.ws; float* out = args.out;
    const float* x_p = (const float*)args.in[0]; const float* x_s = (const float*)args.in[1];
    const float* cache_k = (const float*)args.in[2]; const float* cache_v = (const float*)args.in[3]; const float* cache_ik = (const float*)args.in[4];
    const float* st_re = (const float*)args.in[5]; const float* st_im = (const float*)args.in[6]; const float* st_conv = (const float*)args.in[7];
    const int* ptab = (const int*)args.in[8]; const float* p_p = (const float*)args.in[9]; const float* p_s = (const float*)args.in[10];
    const float* g_mix = (const float*)args.in[11]; const float* w_in = (const float*)args.in[12]; const float* g_q = (const float*)args.in[13]; const float* g_k = (const float*)args.in[14];
    const float* a_re = (const float*)args.in[15]; const float* a_im = (const float*)args.in[16]; const float* log_dt = (const float*)args.in[17];
    const float* sb_re = (const float*)args.in[18]; const float* sb_im = (const float*)args.in[19]; const float* sc_re = (const float*)args.in[20]; const float* sc_im = (const float*)args.in[21];
    const float* ssm_d = (const float*)args.in[22]; const float* w_glu = (const float*)args.in[23]; const float* w_att = (const float*)args.in[24]; const float* w_ssm = (const float*)args.in[25];
    const float* w_o = (const float*)args.in[26]; const float* g_ffn = (const float*)args.in[27]; const float* w_up = (const float*)args.in[28]; const float* conv_w = (const float*)args.in[29];
    const float* conv_b = (const float*)args.in[30]; const float* w_down = (const float*)args.in[31]; const float* w_ple = (const float*)args.in[32]; const float* g_ple = (const float*)args.in[33];
    const float* g_pg = (const float*)args.in[34]; const float* w_pg = (const float*)args.in[35];
    for (int u = wave * 64 + lane_id_(); u < (LDS_BYTES - LDSCTL_OFF) / 4; u += NWAVES * 64) ((LAS unsigned*)(lds + LDSCTL_OFF))[u] = 0u;
    __syncthreads();
    const int lo = args.ph_lo, hi = args.ph_hi;
    XcdBarrier bar; bar.bar = (unsigned*)(ws + WS_CTL) + CW_BAR + args.bar_region * XCD_BAR_WORDS; bar.x = 0; bar.st = nullptr; bar.w0 = 0;
    if (hi - lo > 1) bar = xcd_barrier_post((unsigned*)(ws + WS_CTL) + CW_BAR + args.bar_region * XCD_BAR_WORDS, (volatile LAS unsigned*)(lds + MISC_OFF) + 8);
#define IN(k) (lo <= (k) && (k) < hi)
#ifdef PROBE_PHASE
    unsigned long long pp_t0 = 0, pp_dur = 0;
#define PP_BEGIN(k) do { if ((k) == PROBE_PHASE) pp_t0 = __builtin_amdgcn_s_memrealtime(); } while (0)
#define PP_END(k) do { if ((k) == PROBE_PHASE) pp_dur = __builtin_amdgcn_s_memrealtime() - pp_t0; } while (0)
#else
#define PP_BEGIN(k)
#define PP_END(k)
#endif
#ifdef PROBE_PHASE
#define PS_BEGIN(k) do { if ((k) == PROBE_PHASE) pp_t0 = __builtin_amdgcn_s_memrealtime(); } while (0)
#define PS_END(k) do { if ((k) == PROBE_PHASE) pp_dur += __builtin_amdgcn_s_memrealtime() - pp_t0; } while (0)
#else
#define PS_BEGIN(k)
#define PS_END(k)
#endif
#define SEAM(k) do { if (IN(k) && IN((k) + 1)) xcd_barrier(bar); } while (0)
#define XROW(m) ((m) < TP ? x_p + (size_t)(m) * DM : x_s + (size_t)((m) - TP) * DM)

    PP_BEGIN(0);
    if (IN(0)) for (int rep_ = 0; rep_ < kRep[0]; ++rep_) { WS_PTRS (void)RT; (void)SSC; (void)WIN; (void)WGLU; (void)WATT; (void)WSSM; (void)WO; (void)WUP; (void)WDN; (void)WPLE; (void)WPG; (void)H; (void)PBF; (void)PLER; (void)RS0; (void)SSQ1; (void)SSQ2; (void)SSQP; (void)PROJ; (void)QN; (void)KN; (void)VB; (void)IQ; (void)IKR; (void)IW; (void)SC; (void)SSC2; (void)BMK; (void)SIDX; (void)OATT; (void)Z; (void)Z2; (void)SE; (void)SIN; (void)MRG; (void)UP; (void)ACT; (void)sscn;
        LAS float* scr = (LAS float*)(lds + wave * 16384);
        constexpr int I0 = (DM / 64) * (INWP / 32), I1 = (512 / 64) * (512 / 32), I2 = (1024 / 64) * (DM / 32), I3 = (512 / 64) * (DM / 32), I4 = (DM / 64) * (DM / 32),
                      I5 = (DM / 64) * (DFF2 / 32), I6 = (DFF / 64) * (DM / 32), I7 = (PLE / 64) * (DM / 32), I8 = (DM / 64) * (DM / 32);
        auto mkitem0 = [&](int it) { TrItem T; int r = it;
            if (r < I0) { T = TrItem{w_in, WIN, g_mix, DM, INW, INWP / 32, r}; return T; } r -= I0;
            T = TrItem{w_ple, WPLE, nullptr, PLE, DM, DM / 32, r}; return T; };
        constexpr int NITEMS0 = I0 + I7;
        PS_BEGIN(110);
        { float wa[32], wb[32]; TrItem Ta, Tb; int it = gw;
          if (it < NITEMS0) { Ta = mkitem0(it); transpose_load(Ta, lane, wa); }
          for (; it < NITEMS0; it += NGW) { const int nx = it + NGW; if (nx < NITEMS0) { Tb = mkitem0(nx); transpose_load(Tb, lane, wb); }
              transpose_store(Ta, lane, wa, scr); Ta = Tb;
#pragma unroll
              for (int i = 0; i < 32; ++i) wa[i] = wb[i]; } }
        PS_END(110);
        PS_BEGIN(111);
        for (int m = gw; m < MR; m += NGW) {
            row_to_bf16_rstd(XROW(m), H + (size_t)m * DM, RS0 + m, lane);
            const float* pr = m < TP ? p_p + (size_t)m * PLE : p_s + (size_t)(m - TP) * PLE;
            const f32x4 v = *((const f32x4*)pr + lane); u32x2 w; w.x = cvt_pk_bf16(v.x, v.y); w.y = cvt_pk_bf16(v.z, v.w); *((u32x2*)(PBF + (size_t)m * PLE) + lane) = w;
        }
        PS_END(111);
        PS_BEGIN(112);
        for (int e = gw * 64 + lane; e < (SEQ + DT) * 24; e += NGW * 64) {
            const int pi = e / 24, i = e % 24; const double pos = pi < SEQ ? (double)pi : (double)(PAST + pi - SEQ);
            const double ex = i < 16 ? (double)i / 16.0 : (double)(i - 16) / 8.0; double inv, dum; cexp_d(-ex * 13.122363377404328, 0.0, 10, inv, dum);
            double c, s; cexp_d(0.0, pos * inv, 20, c, s);
            if (i < 16) { RT[pi * 48 + i] = (float)c; RT[pi * 48 + 16 + i] = (float)s; } else { RT[pi * 48 + 32 + (i - 16)] = (float)c; RT[pi * 48 + 40 + (i - 16)] = (float)s; }
        }
        for (int m = gw * 64 + lane; m < MP; m += NGW * 64) { SSQ1[m] = 0.f; SSQ2[m] = 0.f; SSQP[m] = 0.f; }
        for (int gn = gw * 64 + lane; gn < SG * SN * 32; gn += NGW * 64) ssm_constants(gn, a_re, a_im, log_dt, sb_re, sb_im, sc_re, sc_im, SSC);
        PS_END(112);
    }
    SEAM(0);
    PP_END(0);
    PP_BEGIN(1);
    if (IN(1)) for (int rep_ = 0; rep_ < kRep[1]; ++rep_) { WS_PTRS (void)RT; (void)SSC; (void)WIN; (void)WGLU; (void)WATT; (void)WSSM; (void)WO; (void)WUP; (void)WDN; (void)WPLE; (void)WPG; (void)H; (void)PBF; (void)PLER; (void)RS0; (void)SSQ1; (void)SSQ2; (void)SSQP; (void)PROJ; (void)QN; (void)KN; (void)VB; (void)IQ; (void)IKR; (void)IW; (void)SC; (void)SSC2; (void)BMK; (void)SIDX; (void)OATT; (void)Z; (void)Z2; (void)SE; (void)SIN; (void)MRG; (void)UP; (void)ACT; (void)sscn;
        { pg8::Gemm g{H, WIN, MP, INWP, DM, DM, 1}; pg8::StaticOrder S; S.init(MP, INWP, G, bx, WGM_IN); EpiStoreBf16<1, false, false> E{PROJ, INWP, RS0, nullptr};
          pg8::gemm_phase<EpiStoreBf16<1, false, false>, pg8::StaticOrder, true, true>(lds, g, S, E, wave); }
        { { SkStore Es{PLER, SSQP}; skinny_gemm(lds, PBF, PLE, WPLE, PLE, DM, Es, vcu, G, wave, lane); }
          pg8::Gemm g{PBF, WPLE, TP, DM, PLE, PLE, 2}; pg8::StaticOrder S; S.init(TP, DM, G, bx); EpiStoreBf16<0, true> E{PLER, DM, nullptr, SSQP};
          pg8::gemm_phase<EpiStoreBf16<0, true>, pg8::StaticOrder, true, true>(lds, g, S, E, wave); }
    }
    SEAM(1);
    PP_END(1);
    PP_BEGIN(2);
    if (IN(2)) for (int rep_ = 0; rep_ < kRep[2]; ++rep_) { WS_PTRS (void)RT; (void)SSC; (void)WIN; (void)WGLU; (void)WATT; (void)WSSM; (void)WO; (void)WUP; (void)WDN; (void)WPLE; (void)WPG; (void)H; (void)PBF; (void)PLER; (void)RS0; (void)SSQ1; (void)SSQ2; (void)SSQP; (void)PROJ; (void)QN; (void)KN; (void)VB; (void)IQ; (void)IKR; (void)IW; (void)SC; (void)SSC2; (void)BMK; (void)SIDX; (void)OATT; (void)Z; (void)Z2; (void)SE; (void)SIN; (void)MRG; (void)UP; (void)ACT; (void)sscn;
        for (int task_ = gw; task_ < MUL_SSMA * SSM_NCH * SG; task_ += NGW) { const int task = task_ % (SSM_NCH * SG); ssm_task<0>(0, task & 31, task >> 5, lane, sscn, PROJ, ssm_d, SE, SIN, nullptr, nullptr, Z, nullptr, nullptr); }
        { TaRaw Ra, Rb; if (gw < MR) ta_load(gw, lane, PROJ, Ra);
          for (int row_ = gw; row_ < MUL_TA * MR; row_ += NGW) { const int row = row_ % MR; const int nx = row_ + NGW; if (nx < MUL_TA * MR) ta_load(nx % MR, lane, PROJ, Rb); ta_compute(row, lane, Ra, RT, g_q, g_k, QN, KN, VB, IQ, IKR, IW, out); Ra = Rb; } }
    }
    SEAM(2);
    PP_END(2);
    PP_BEGIN(3);
    if (IN(3)) for (int rep_ = 0; rep_ < kRep[3]; ++rep_) { WS_PTRS (void)RT; (void)SSC; (void)WIN; (void)WGLU; (void)WATT; (void)WSSM; (void)WO; (void)WUP; (void)WDN; (void)WPLE; (void)WPG; (void)H; (void)PBF; (void)PLER; (void)RS0; (void)SSQ1; (void)SSQ2; (void)SSQP; (void)PROJ; (void)QN; (void)KN; (void)VB; (void)IQ; (void)IKR; (void)IW; (void)SC; (void)SSC2; (void)BMK; (void)SIDX; (void)OATT; (void)Z; (void)Z2; (void)SE; (void)SIN; (void)MRG; (void)UP; (void)ACT; (void)sscn;
        for (int u_ = vcu; u_ < MUL_IDXP * 256; u_ += G) { const int u = u_ & 255; const int b = u >> 4, y = u & 15; idx_prompt_block(b, y, wave, lane, IQ, IKR, IW, SC); idx_prompt_block(b, 31 - y, wave, lane, IQ, IKR, IW, SC); }
        for (int u_ = vcu; u_ < MUL_IDXS * 512; u_ += G) { const int u = u_ & 511; idx_sample_unit(u >> 4, u & 15, wave, lane, IQ, IKR, IW, cache_ik, ptab, SSC2); }
        if (lane < 16) for (int idx_ = gw * 16 + lane; idx_ < MUL_CARRY * NB * SG * SN; idx_ += NGW * 16) { const int idx = idx_ % (NB * SG * SN); ssm_carry(idx, sscn.a32, SE, SIN, out + O_SRP, out + O_SIP); }
    }
    SEAM(3);
    PP_END(3);
    PP_BEGIN(4);
    if (IN(4)) for (int rep_ = 0; rep_ < kRep[4]; ++rep_) { WS_PTRS (void)RT; (void)SSC; (void)WIN; (void)WGLU; (void)WATT; (void)WSSM; (void)WO; (void)WUP; (void)WDN; (void)WPLE; (void)WPG; (void)H; (void)PBF; (void)PLER; (void)RS0; (void)SSQ1; (void)SSQ2; (void)SSQP; (void)PROJ; (void)QN; (void)KN; (void)VB; (void)IQ; (void)IKR; (void)IW; (void)SC; (void)SSC2; (void)BMK; (void)SIDX; (void)OATT; (void)Z; (void)Z2; (void)SE; (void)SIN; (void)MRG; (void)UP; (void)ACT; (void)sscn;
        for (int r = vcu; r < TS; r += G) select_sample_row(r, tid, lane, wave, SSC2, SIDX, (LAS unsigned*)lds);
        {
            constexpr int J1 = (512 / 64) * (512 / 32), J2 = (1024 / 64) * (DM / 32), J3 = (512 / 64) * (DM / 32), J4 = (DM / 64) * (DM / 32), J5 = (DM / 64) * (DFF2 / 32), J6 = (DFF / 64) * (DM / 32), J8 = (DM / 64) * (DM / 32);
            constexpr int NLATE = J1 + J2 + J3 + J4 + J5 + J6 + J8;
            auto mkitem1 = [&](int it) { TrItem T; int r = it;
                if (r < J1) { T = TrItem{w_glu, WGLU, nullptr, 512, 512, 512 / 32, r}; return T; } r -= J1;
                if (r < J2) { T = TrItem{w_att, WATT, nullptr, 1024, DM, DM / 32, r}; return T; } r -= J2;
                if (r < J3) { T = TrItem{w_ssm, WSSM, nullptr, 512, DM, DM / 32, r}; return T; } r -= J3;
                if (r < J4) { T = TrItem{w_o, WO, nullptr, DM, DM, DM / 32, r}; return T; } r -= J4;
                if (r < J5) { T = TrItem{w_up, WUP, g_ffn, DM, DFF2, DFF2 / 32, r}; return T; } r -= J5;
                if (r < J6) { T = TrItem{w_down, WDN, nullptr, DFF, DM, DM / 32, r}; return T; } r -= J6;
                T = TrItem{w_pg, WPG, g_pg, DM, DM, DM / 32, r}; return T; };
            LAS float* scr = (LAS float*)(lds + 36864 + wave * 8448);
            int it = gw;
            for (int k_ = gw; k_ < MUL_SEL * TP || it < NLATE; k_ += NGW) {
                const bool hrow = k_ < MUL_SEL * TP, hit = it < NLATE;
                float v[32], wt[32]; TrItem Tt; int row = 0;
                if (hrow) { const int k = k_ % TP; const int b = k >> 11, t0 = k & (SEQ - 1); const int t = (b & 1) ? (SEQ - 1 - t0) : t0; row = __builtin_amdgcn_readfirstlane(b * SEQ + t); select_prompt_load(row, lane, SC, v); }
                if (hit) { Tt = mkitem1(it); transpose_load(Tt, lane, wt); }
                if (hrow) select_prompt_compute(row, lane, v, BMK, (LAS unsigned*)(lds + wave * 4608));
                if (hit) { transpose_store(Tt, lane, wt, scr); it += NGW; }
            }
        }
        for (int task_ = gw; task_ < MUL_SSMC * (SSM_NCH * SG + 2 * SG); task_ += NGW) { const int task = task_ % (SSM_NCH * SG + 2 * SG);
            if (task < SSM_NCH * SG) ssm_task<1>(0, task & 31, task >> 5, lane, sscn, PROJ, ssm_d, SE, SIN, nullptr, nullptr, Z, nullptr, nullptr);
            else { const int k = task - SSM_NCH * SG; ssm_task<2>(k >> 5, k & 31, 0, lane, sscn, PROJ, ssm_d, SE, SIN, st_re, st_im, Z, out + O_SRS, out + O_SIS); }
        }
    }
    SEAM(4);
    PP_END(4);
    PP_BEGIN(5);
    if (IN(5)) for (int rep_ = 0; rep_ < kRep[5]; ++rep_) { WS_PTRS (void)RT; (void)SSC; (void)WIN; (void)WGLU; (void)WATT; (void)WSSM; (void)WO; (void)WUP; (void)WDN; (void)WPLE; (void)WPG; (void)H; (void)PBF; (void)PLER; (void)RS0; (void)SSQ1; (void)SSQ2; (void)SSQP; (void)PROJ; (void)QN; (void)KN; (void)VB; (void)IQ; (void)IKR; (void)IW; (void)SC; (void)SSC2; (void)BMK; (void)SIDX; (void)OATT; (void)Z; (void)Z2; (void)SE; (void)SIN; (void)MRG; (void)UP; (void)ACT; (void)sscn;
        {
            const int total = MUL_ATT * NB * NH * 4;
            auto mkref = [&](int L_, int pass) { const int L = L_ % (NB * NH * 4); const int gq = L & 3, y = (L >> 2) & 3, kvh = (L >> 4) & 1, b = L >> 5; const int h = kvh * 4 + gq, qb = pass ? 7 - y : y;
                att::BlockRef r; const size_t q0 = ((size_t)b * SEQ + (size_t)qb * 256) * 1024 + h * 128;
                r.Q = QN + q0; r.O = OATT + q0; r.K = KN + (size_t)b * SEQ * 256 + kvh * 128; r.V = VB + (size_t)b * SEQ * 256 + kvh * 128; r.MB = BMK + ((size_t)b * SEQ + (size_t)qb * 256) * 32; r.P0 = qb * 256; return r; };
            int L = vcu;
            if (L < total) {
                int pass = 0; att::BlockRef cur = mkref(L, 0); att::Seam S;
                att::attn_prime(cur, (char*)lds_raw, S, wave);
                for (;;) {
                    const bool more_pass = pass == 0, more_item = L + G < total, last = !more_pass && !more_item;
                    int passn = pass + 1, Ln = L; if (!more_pass) { passn = 0; Ln = more_item ? L + G : L; }
                    const att::BlockRef nxt = last ? cur : mkref(Ln, passn);
                    att::attn_block(cur, nxt, (char*)lds_raw, S, wave);
                    if (last) break;
                    cur = nxt; pass = passn; L = Ln;
                }
            }
            VM_WAIT(); __syncthreads();
        }
        for (int u_ = vcu; u_ < MUL_SATT * 256; u_ += G) { const int u = u_ & 255; sample_attn_unit(u, tid, lane, wave, lds, QN, SIDX, ptab, cache_k, cache_v, out, OATT); }
        { SkGlu Es{Z, Z2}; skinny_gemm(lds, Z, 512, WGLU, 512, 512, Es, vcu, G, wave, lane); }
        { pg8::Gemm g{Z, WGLU, TP, 512, 512, 512, 3}; pg8::StaticOrder S; S.init(TP, 512, G, bx); EpiGlu E{Z, Z2, 512};
          pg8::gemm_phase<EpiGlu, pg8::StaticOrder, true, true>(lds, g, S, E, wave); }
    }
    SEAM(5);
    PP_END(5);
    PP_BEGIN(6);
    if (IN(6)) for (int rep_ = 0; rep_ < kRep[6]; ++rep_) { WS_PTRS (void)RT; (void)SSC; (void)WIN; (void)WGLU; (void)WATT; (void)WSSM; (void)WO; (void)WUP; (void)WDN; (void)WPLE; (void)WPG; (void)H; (void)PBF; (void)PLER; (void)RS0; (void)SSQ1; (void)SSQ2; (void)SSQP; (void)PROJ; (void)QN; (void)KN; (void)VB; (void)IQ; (void)IKR; (void)IW; (void)SC; (void)SSC2; (void)BMK; (void)SIDX; (void)OATT; (void)Z; (void)Z2; (void)SE; (void)SIN; (void)MRG; (void)UP; (void)ACT; (void)sscn; { SkGate<false> Es{PROJ + C_GA, INWP, MRG}; skinny_gemm(lds, OATT, 1024, WATT, 1024, DM, Es, vcu, G, wave, lane); }
        pg8::Gemm g{OATT, WATT, TP, DM, 1024, 1024, 4}; pg8::StaticOrder S; S.init(TP, DM, G, bx); EpiGate<false> E{PROJ + C_GA, INWP, MRG, DM};
        pg8::gemm_phase<EpiGate<false>, pg8::StaticOrder, true, true>(lds, g, S, E, wave); }
    if (IN(6) && IN(7)) { VM_WAIT(); __syncthreads(); }
    PP_END(6);
    PP_BEGIN(7);
    if (IN(7)) { WS_PTRS (void)RT; (void)SSC; (void)WIN; (void)WGLU; (void)WATT; (void)WSSM; (void)WO; (void)WUP; (void)WDN; (void)WPLE; (void)WPG; (void)H; (void)PBF; (void)PLER; (void)RS0; (void)SSQ1; (void)SSQ2; (void)SSQP; (void)PROJ; (void)QN; (void)KN; (void)VB; (void)IQ; (void)IKR; (void)IW; (void)SC; (void)SSC2; (void)BMK; (void)SIDX; (void)OATT; (void)Z; (void)Z2; (void)SE; (void)SIN; (void)MRG; (void)UP; (void)ACT; (void)sscn; { SkGate<true> Es{PROJ + C_GS, INWP, MRG}; skinny_gemm(lds, Z2, 512, WSSM, 512, DM, Es, vcu, G, wave, lane); }
        pg8::Gemm g{Z2, WSSM, TP, DM, 512, 512, 5}; pg8::StaticOrder S; S.init(TP, DM, G, bx); EpiGate<true> E{PROJ + C_GS, INWP, MRG, DM};
        pg8::gemm_phase<EpiGate<true>, pg8::StaticOrder, true, true>(lds, g, S, E, wave); }
    SEAM(7);
    PP_END(7);
    PP_BEGIN(8);
    if (IN(8)) for (int rep_ = 0; rep_ < kRep[8]; ++rep_) { WS_PTRS (void)RT; (void)SSC; (void)WIN; (void)WGLU; (void)WATT; (void)WSSM; (void)WO; (void)WUP; (void)WDN; (void)WPLE; (void)WPG; (void)H; (void)PBF; (void)PLER; (void)RS0; (void)SSQ1; (void)SSQ2; (void)SSQP; (void)PROJ; (void)QN; (void)KN; (void)VB; (void)IQ; (void)IKR; (void)IW; (void)SC; (void)SSC2; (void)BMK; (void)SIDX; (void)OATT; (void)Z; (void)Z2; (void)SE; (void)SIN; (void)MRG; (void)UP; (void)ACT; (void)sscn; { SkResid Es{H, SSQ1}; skinny_gemm(lds, MRG, DM, WO, DM, DM, Es, vcu, G, wave, lane); }
        pg8::Gemm g{MRG, WO, TP, DM, DM, DM, 6}; pg8::StaticOrder S; S.init(TP, DM, G, bx); EpiResidBf E{H, SSQ1};
        pg8::gemm_phase<EpiResidBf, pg8::StaticOrder, true, true>(lds, g, S, E, wave); }
    SEAM(8);
    PP_END(8);
    PP_BEGIN(9);
    if (IN(9)) for (int rep_ = 0; rep_ < kRep[9]; ++rep_) { WS_PTRS (void)RT; (void)SSC; (void)WIN; (void)WGLU; (void)WATT; (void)WSSM; (void)WO; (void)WUP; (void)WDN; (void)WPLE; (void)WPG; (void)H; (void)PBF; (void)PLER; (void)RS0; (void)SSQ1; (void)SSQ2; (void)SSQP; (void)PROJ; (void)QN; (void)KN; (void)VB; (void)IQ; (void)IKR; (void)IW; (void)SC; (void)SSC2; (void)BMK; (void)SIDX; (void)OATT; (void)Z; (void)Z2; (void)SE; (void)SIN; (void)MRG; (void)UP; (void)ACT; (void)sscn;
        pg8::Gemm g{H, WUP, MP, DFF2, DM, DM, 7}; pg8::StaticOrder S; S.init(MP, DFF2, G, bx, WGM_UP); EpiStoreBf16<2, false> E{UP, DFF2, SSQ1, nullptr};
        pg8::gemm_phase<EpiStoreBf16<2, false>, pg8::StaticOrder, true, true>(lds, g, S, E, wave); }
    SEAM(9);
    PP_END(9);
    PP_BEGIN(10);
    if (IN(10)) for (int rep_ = 0; rep_ < kRep[10]; ++rep_) { WS_PTRS (void)RT; (void)SSC; (void)WIN; (void)WGLU; (void)WATT; (void)WSSM; (void)WO; (void)WUP; (void)WDN; (void)WPLE; (void)WPG; (void)H; (void)PBF; (void)PLER; (void)RS0; (void)SSQ1; (void)SSQ2; (void)SSQP; (void)PROJ; (void)QN; (void)KN; (void)VB; (void)IQ; (void)IKR; (void)IW; (void)SC; (void)SSC2; (void)BMK; (void)SIDX; (void)OATT; (void)Z; (void)Z2; (void)SE; (void)SIN; (void)MRG; (void)UP; (void)ACT; (void)sscn; for (int it_ = gw; it_ < MUL_CONV * (512 + DB) * 11; it_ += NGW) { const int it = it_ % ((512 + DB) * 11); conv_item(it / 11, it % 11, lane, UP, ACT, conv_w, conv_b, st_conv, out); } }
    SEAM(10);
    PP_END(10);
    PP_BEGIN(11);
    if (IN(11)) { WS_PTRS (void)RT; (void)SSC; (void)WIN; (void)WGLU; (void)WATT; (void)WSSM; (void)WO; (void)WUP; (void)WDN; (void)WPLE; (void)WPG; (void)H; (void)PBF; (void)PLER; (void)RS0; (void)SSQ1; (void)SSQ2; (void)SSQP; (void)PROJ; (void)QN; (void)KN; (void)VB; (void)IQ; (void)IKR; (void)IW; (void)SC; (void)SSC2; (void)BMK; (void)SIDX; (void)OATT; (void)Z; (void)Z2; (void)SE; (void)SIN; (void)MRG; (void)UP; (void)ACT; (void)sscn; { PS_BEGIN(101); SkResid Es{H, SSQ2}; skinny_gemm(lds, ACT, DFF, WDN, DFF, DM, Es, vcu, G, wave, lane); PS_END(101); }
        pg8::Gemm g{ACT, WDN, TP, DM, DFF, DFF, 8}; pg8::StaticOrder S; S.init(TP, DM, G, bx, WGM_DN); EpiResidBf E{H, SSQ2};
        pg8::gemm_phase<EpiResidBf, pg8::StaticOrder, true, true>(lds, g, S, E, wave); }
    SEAM(11);
    PP_END(11);
    PP_BEGIN(12);
    if (IN(12)) { WS_PTRS (void)RT; (void)SSC; (void)WIN; (void)WGLU; (void)WATT; (void)WSSM; (void)WO; (void)WUP; (void)WDN; (void)WPLE; (void)WPG; (void)H; (void)PBF; (void)PLER; (void)RS0; (void)SSQ1; (void)SSQ2; (void)SSQP; (void)PROJ; (void)QN; (void)KN; (void)VB; (void)IQ; (void)IKR; (void)IW; (void)SC; (void)SSC2; (void)BMK; (void)SIDX; (void)OATT; (void)Z; (void)Z2; (void)SE; (void)SIN; (void)MRG; (void)UP; (void)ACT; (void)sscn; { PS_BEGIN(102); SkPg Es{out + O_Y, H, PLER, SSQ2, SSQP, g_ple}; skinny_gemm(lds, H, DM, WPG, DM, DM, Es, vcu, G, wave, lane); PS_END(102); }
#ifdef STAG12
        { if (tid == 0) { const unsigned long long t0_ = __builtin_amdgcn_s_memrealtime(); const unsigned long long d_ = (unsigned long long)((bx >> 3) & 7) * STAG12; while (__builtin_amdgcn_s_memrealtime() - t0_ < d_) __builtin_amdgcn_s_sleep(16); } __syncthreads(); }
#endif
        pg8::Gemm g{H, WPG, TP, DM, DM, DM, 9}; pg8::StaticOrder S; S.init(TP, DM, G, bx, WGM_PG); EpiPg E{out + O_Y, H, PLER, SSQ2, SSQP, g_ple};
        PS_BEGIN(103); pg8::gemm_phase<EpiPg, pg8::StaticOrder, true, true>(lds, g, S, E, wave); PS_END(103); }
    PP_END(12);
#ifdef PROBE_PHASE
    if (blockIdx.x == 0 && wave == 0 && lane_id_() == 0) { const unsigned long long t0 = __builtin_amdgcn_s_memrealtime(); while (__builtin_amdgcn_s_memrealtime() - t0 < pp_dur) __builtin_amdgcn_s_sleep(8); }
#endif
#if defined(PROBE_KLOOP) || defined(PROBE_EPI)
    if (blockIdx.x == 0 && wave == 0 && lane_id_() == 0) { const unsigned dur = *(LAS unsigned*)(lds + MISC_OFF + 64); const unsigned long long t0 = __builtin_amdgcn_s_memrealtime(); while (__builtin_amdgcn_s_memrealtime() - t0 < (unsigned long long)dur) __builtin_amdgcn_s_sleep(8); }
#endif
#undef IN
#undef SEAM
#undef XROW
}

extern "C" void kernel_launch(void* const* d_in, const int* in_sizes, int n_in, void* d_out, int out_size, void* d_ws, size_t ws_size, hipStream_t stream) {
    static int grid = 0;
    if (grid == 0) {
        if (n_in != 36 || out_size != (int)O_END || ws_size < WS_END) { fprintf(stderr, "kernel_launch: unexpected shapes (n_in %d, out %d, ws %zu; want 36, %zu, >= %zu)\n", n_in, out_size, ws_size, (size_t)O_END, (size_t)WS_END); grid = -1; return; }
        int dev = 0, cus = 0, per_cu = 0;
        if (hipGetDevice(&dev) != hipSuccess || hipDeviceGetAttribute(&cus, hipDeviceAttributeMultiprocessorCount, dev) != hipSuccess) { grid = -1; return; }
        if (hipFuncSetAttribute((const void*)fwd, hipFuncAttributeMaxDynamicSharedMemorySize, LDS_BYTES) != hipSuccess) { fprintf(stderr, "kernel_launch: hipFuncSetAttribute failed\n"); grid = -1; return; }
        if (hipOccupancyMaxActiveBlocksPerMultiprocessor(&per_cu, (const void*)fwd, NWAVES * 64, LDS_BYTES) != hipSuccess || per_cu < 1) fprintf(stderr, "kernel_launch: occupancy query reports %d\n", per_cu);
        (void)hipGetLastError();
        grid = cus;
    }
    if (grid < 0) return;
    if (hipMemsetAsync((char*)d_ws + WS_CTL, 0, CTL_ZERO_BYTES, stream) != hipSuccess) return;
    Args a{};
    for (int i = 0; i < 36; ++i) a.in[i] = d_in[i];
    a.out = (float*)d_out; a.ws = (unsigned char*)d_ws;
    const int nl = MK_N_LAUNCHES;
    for (int li = 0; li < nl; ++li) {
        a.ph_lo = (NPH * li) / nl; a.ph_hi = (NPH * (li + 1)) / nl; a.bar_region = li; a.pad = 0;
        hipLaunchKernelGGL(fwd, dim3(grid), dim3(NWAVES * 64), LDS_BYTES, stream, a);
    }
}
```

```cpp
#include <hip/hip_runtime.h>
#include <cstdio>
#include <cstdint>

#define LAS __attribute__((address_space(3)))
#define GAS __attribute__((address_space(1)))
typedef unsigned short bf16_t;
typedef short bf16x8 __attribute__((ext_vector_type(8)));
typedef short bf16x4 __attribute__((ext_vector_type(4)));
typedef float f32x4 __attribute__((ext_vector_type(4)));
typedef float f32x2 __attribute__((ext_vector_type(2)));
typedef float f32x16 __attribute__((ext_vector_type(16)));
typedef unsigned u32x4 __attribute__((ext_vector_type(4)));
typedef unsigned u32x2 __attribute__((ext_vector_type(2)));
typedef unsigned long long u64;

constexpr int DM = 2048, NB = 16, SEQ = 2048, DB = 32, DT = 4, PAST = 16384, PAGE = 128, NPG = 128;
constexpr int TP = NB * SEQ, TS = DB * DT, MR = TP + TS, MP = 33024;
constexpr int NH = 8, NKV = 2, HD = 128, IH = 16, IDD = 64;
constexpr int SSMW = 512, SG = 32, SN = 64;
constexpr int DFF = 5504, DFF2 = 11008, PLE = 256;
constexpr int INW = 7248, INWP = 7424;
constexpr int C_Q = 0, C_K = 1024, C_V = 1280, C_IQ = 1536, C_IK = 2560, C_IW = 2624, C_U = 2640, C_GA = 3152, C_GS = 5200;
constexpr float EPS = 1e-6f, IDX_SCALE = 0.03125f;
constexpr int SSM_L = 32, SSM_NCH = SEQ / SSM_L;
constexpr int SLEN = PAST + DT, SSTR = 16400;

constexpr size_t O_Y = 0;
constexpr size_t O_KP = (size_t)MR * DM;
constexpr size_t O_VP = O_KP + (size_t)TP * 256;
constexpr size_t O_IKP = O_VP + (size_t)TP * 256;
constexpr size_t O_SRP = O_IKP + (size_t)TP * 64;
constexpr size_t O_SIP = O_SRP + (size_t)NB * SG * SN;
constexpr size_t O_CVP = O_SIP + (size_t)NB * SG * SN;
constexpr size_t O_KS = O_CVP + (size_t)NB * 2 * DFF2;
constexpr size_t O_VS = O_KS + (size_t)TS * 256;
constexpr size_t O_IKS = O_VS + (size_t)TS * 256;
constexpr size_t O_SRS = O_IKS + (size_t)TS * 64;
constexpr size_t O_SIS = O_SRS + (size_t)DB * SG * SN;
constexpr size_t O_CVS = O_SIS + (size_t)DB * SG * SN;
constexpr size_t O_END = O_CVS + (size_t)DB * 2 * DFF2;
static_assert(O_END == 87572480, "output size");

constexpr size_t MiB = 1u << 20;
constexpr size_t al(size_t x) { return (x + MiB - 1) & ~(MiB - 1); }
constexpr size_t WS_CTL = 0, CTL_ZERO_BYTES = 65536;
constexpr size_t WS_RT = WS_CTL + MiB;
constexpr size_t WS_SSC = WS_RT + MiB;
constexpr size_t WS_WIN = WS_SSC + MiB;
constexpr size_t WS_WGLU = WS_WIN + al((size_t)INWP * DM * 2);
constexpr size_t WS_WATT = WS_WGLU + al((size_t)512 * 512 * 2);
constexpr size_t WS_WSSM = WS_WATT + al((size_t)DM * 1024 * 2);
constexpr size_t WS_WO = WS_WSSM + al((size_t)DM * 512 * 2);
constexpr size_t WS_WUP = WS_WO + al((size_t)DM * DM * 2);
constexpr size_t WS_WDN = WS_WUP + al((size_t)DFF2 * DM * 2);
constexpr size_t WS_WPLE = WS_WDN + al((size_t)DM * DFF * 2);
constexpr size_t WS_WPG = WS_WPLE + al((size_t)DM * PLE * 2);
constexpr size_t WS_H = WS_WPG + al((size_t)DM * DM * 2);
constexpr size_t WS_PBF = WS_H + al((size_t)MP * DM * 2);
constexpr size_t WS_PLER = WS_PBF + al((size_t)MP * PLE * 2);
constexpr size_t WS_RSP = WS_PLER + al((size_t)MP * DM * 2);
constexpr size_t WS_A0 = WS_RSP + MiB;
constexpr size_t WS_PROJ = WS_A0;
constexpr size_t WS_QN = WS_PROJ + al((size_t)MP * INWP * 2);
constexpr size_t WS_KN = WS_QN + al((size_t)MP * 1024 * 2);
constexpr size_t WS_VB = WS_KN + al((size_t)MP * 256 * 2);
constexpr size_t WS_IQ = WS_VB + al((size_t)MP * 256 * 2);
constexpr size_t WS_IKR = WS_IQ + al((size_t)MP * 1024 * 2);
constexpr size_t WS_IW = WS_IKR + al((size_t)MP * 64 * 2);
constexpr size_t WS_SC = WS_IW + al((size_t)MP * 16 * 4);
constexpr size_t WS_SSC2 = WS_SC + al((size_t)NB * SEQ * SEQ * 4);
constexpr size_t WS_BM = WS_SSC2 + al((size_t)TS * SSTR * 4);
constexpr size_t WS_SIDX = WS_BM + al((size_t)TP * 32 * 8);
constexpr size_t WS_OATT = WS_SIDX + MiB;
constexpr size_t WS_Z = WS_OATT + al((size_t)MP * 1024 * 2);
constexpr size_t WS_Z2 = WS_Z + al((size_t)MP * 512 * 2);
constexpr size_t WS_SE = WS_Z2 + al((size_t)MP * 512 * 2);
constexpr size_t WS_SIN = WS_SE + al((size_t)NB * SSM_NCH * SG * SN * 8);
constexpr size_t WS_MRG = WS_SIN + al((size_t)NB * SSM_NCH * SG * SN * 8);
constexpr size_t WS_G8 = WS_MRG + al((size_t)MP * DM * 2);
constexpr size_t WS_T8 = WS_G8 + al((size_t)MP * 4096);
constexpr size_t WS_A_END = WS_T8 + al((size_t)MP * DM);
constexpr size_t WS_UP = WS_A0;
constexpr size_t WS_ACT = WS_UP + al((size_t)MP * DFF2 * 2);
constexpr size_t WS_B_END = WS_ACT + al((size_t)MP * DFF * 2);
constexpr size_t WS_END = WS_A_END > WS_B_END ? WS_A_END : WS_B_END;
static_assert(WS_END < (size_t)2600 * MiB, "d_ws map too large");
constexpr size_t SSC_ABAR = 0, SSC_A32 = 16384, SSC_BBT = 32768, SSC_CMT = 32768 + 131072, SSC_END = SSC_CMT + 131072;
static_assert(SSC_END <= MiB, "ssc");
constexpr int CW_BAR = 4096;

constexpr int RING_BYTES = 131072;
constexpr int LDSCTL_OFF = RING_BYTES, MISC_OFF = LDSCTL_OFF + 320;
constexpr int LDS_BYTES = 147456;
constexpr int NWAVES = 8;

__device__ __forceinline__ unsigned cvt_pk_bf16(float lo, float hi) { unsigned r; asm volatile("v_cvt_pk_bf16_f32 %0, %1, %2" : "=v"(r) : "v"(lo), "v"(hi)); return r; }
__device__ __forceinline__ float bf_lo(unsigned w) { return __uint_as_float(w << 16); }
__device__ __forceinline__ float bf_hi(unsigned w) { return __uint_as_float(w & 0xffff0000u); }
__device__ __forceinline__ float bf2f(bf16_t x) { return __uint_as_float(((unsigned)x) << 16); }
__device__ __forceinline__ float sigmoidf_(float x) { return __builtin_amdgcn_rcpf(1.0f + __expf(-x)); }
__device__ __forceinline__ float gelu_tanh(float y) { const float t = 1.5957691216057308f * (y + 0.044715f * y * y * y); return y * __builtin_amdgcn_rcpf(1.0f + __expf(-t)); }
__device__ __forceinline__ float wave_sum(float v) {
#pragma unroll
    for (int o = 1; o < 64; o <<= 1) v += __shfl_xor(v, o);
    return v;
}
__device__ __forceinline__ int lane_id_() { int l; asm volatile("v_mbcnt_lo_u32_b32 %0, -1, 0\n\tv_mbcnt_hi_u32_b32 %0, -1, %0" : "=v"(l)); return l; }
#define LDS_WAIT() asm volatile("s_waitcnt lgkmcnt(0)" ::: "memory")
#define VM_WAIT() asm volatile("s_waitcnt vmcnt(0)" ::: "memory")
namespace pg8 {
#define PG8_LAS __attribute__((address_space(3)))
constexpr int BM = 256, BK = 64, HALF = 128, HTB = HALF * BK * 2  , STAGE_BYTES = 8 * HTB, NXCD = 8;

__host__ __device__ __forceinline__ int lds_byte(int r, int c) { const int st = (r >> 4) * 2 + (c >> 5), rr = r & 15, cc = c & 31, ob = rr * 64 + cc * 2; return st * 1024 + (ob ^ (((ob >> 9) & 1) << 5)); }
__host__ __device__ __forceinline__ void stage_rc(int b, int& R, int& C) { const int st = b / 1024, sb = b % 1024, swz = sb ^ (((sb >> 9) & 1) << 5); R = (st >> 1) * 16 + swz / 64; C = (st & 1) * 32 + (swz % 64) / 2; }
__host__ __device__ __forceinline__ int perm32(int rho) { const int n = rho >> 4, i = rho & 15; return 8 * (i >> 2) + 4 * n + (i & 3); }

struct Unit { int pm, pn; };
struct Gemm { const bf16_t* A; const bf16_t* Bt; int M, N, K, lda, tag; };

struct StaticOrder {
    int nM, nN, nwg, G, c, WGM;
    __host__ __device__ void init(int M, int N, int G_, int c_, int wgm = 2) { nM = M / BM; nN = N / BM; nwg = nM * nN; G = G_; c = c_; WGM = wgm; }
    __host__ __device__ bool next(int i, Unit& u) const {
        const long L = (long)i * G + c; if (L >= nwg) return false;
        int wgid = (int)L; { const int q = nwg / NXCD, r = nwg % NXCD, xcd = wgid % NXCD, off = wgid / NXCD; wgid = (xcd < r ? xcd * (q + 1) : r * (q + 1) + (xcd - r) * q) + off; }
        const int nig = WGM * nN, gid = wgid / nig, fm = gid * WGM, gsz = (nM - fm) < WGM ? (nM - fm) : WGM;
        u.pm = fm + ((wgid % nig) % gsz); u.pn = (wgid % nig) / gsz; return true;
    }
    __device__ __forceinline__ void a_ready(const Unit&) const {}
    __device__ __forceinline__ void done(const Unit&) const {}
};
template <class Epi, class Sched, bool ALIGN_EPI = false, bool SP2 = false>
__device__ __forceinline__ void gemm_phase(PG8_LAS unsigned char* lds, const Gemm g, const Sched& S, const Epi& E, int wid) {
    const int lane = lane_id_(), tid = wid * 64 + lane, wr = wid >> 2, wc = wid & 3, fr = lane & 15, fq = lane >> 4;
    const int K = g.K, nt = K / BK;
    unsigned voffA[2], voffB[2];
#pragma unroll
    for (int i = 0; i < 2; ++i) { int R, C; stage_rc(tid * 16 + i * 8192, R, C); const int Rb = Epi::PERM ? ((R >> 5) * 64 + perm32(R & 31)) : R;
        voffA[i] = (unsigned)(R * g.lda + C) * 2u; voffB[i] = (unsigned)(Rb * K + C) * 2u; }
    const size_t kstep = (size_t)(BK * 2);
    const size_t hstepB = (size_t)(Epi::PERM ? 32 : HALF) * K * 2, hstepA = (size_t)HALF * g.lda * 2;
    const size_t tstepB = (size_t)BM * K * 2, tstepA = 2 * hstepA;
    const unsigned ldsw = (unsigned)wid * 1024u;
    const int aoff = lds_byte(wr * 64 + fr, fq * 8), boff = lds_byte(wc * 32 + fr, fq * 8);
#define PG8_SA(b, h) (((b) * 2 + (h)) * HTB)
#define PG8_SB(b, h) ((4 + (b) * 2 + (h)) * HTB)
#define PG8_STAGE(bufoff, gbase, voff) do { _Pragma("unroll") for (int _i = 0; _i < 2; ++_i) \
        __builtin_amdgcn_global_load_lds((const unsigned*)((const char*)(gbase) + (voff)[_i]), (PG8_LAS unsigned*)(lds + (bufoff) + ldsw + _i * 8192), 16, 0, 0); } while (0)
#define PG8_LDA(dst, b, h) do { _Pragma("unroll") for (int m = 0; m < 4; ++m) _Pragma("unroll") for (int k = 0; k < 2; ++k) dst[m][k] = *(const PG8_LAS bf16x8*)(lds + PG8_SA(b, h) + aoff + m * 2048 + k * 1024); } while (0)
#define PG8_LDB(dst, b, h) do { _Pragma("unroll") for (int n = 0; n < 2; ++n) _Pragma("unroll") for (int k = 0; k < 2; ++k) dst[n][k] = *(const PG8_LAS bf16x8*)(lds + PG8_SB(b, h) + boff + n * 2048 + k * 1024); } while (0)
#define PG8_MMA(ai, bj, At, Bt) do { __builtin_amdgcn_s_setprio(1); _Pragma("unroll") for (int m = 0; m < 4; ++m) _Pragma("unroll") for (int n = 0; n < 2; ++n) _Pragma("unroll") for (int k = 0; k < 2; ++k) \
        acc[ai][bj][m][n] = __builtin_amdgcn_mfma_f32_16x16x32_bf16(Bt[n][k], At[m][k], acc[ai][bj][m][n], 0, 0, 0); __builtin_amdgcn_s_setprio(0); } while (0)
#define PG8_WAIT_V(n) asm volatile("s_waitcnt vmcnt(" #n ")" ::: "memory")
#define PG8_WAIT_L(n) asm volatile("s_waitcnt lgkmcnt(" #n ")" ::: "memory")
#define PG8_BAR __builtin_amdgcn_s_barrier()
#define PG8_SCHED __builtin_amdgcn_sched_barrier(0)
    Unit cur, nxt; int ui = 0;
    if (!S.next(0, cur)) return;
    f32x4 acc[2][2][4][2];
#pragma unroll
    for (int a = 0; a < 2; ++a)
#pragma unroll
        for (int b = 0; b < 2; ++b)
#pragma unroll
            for (int m = 0; m < 4; ++m)
#pragma unroll
                for (int n = 0; n < 2; ++n) acc[a][b][m][n] = (f32x4){0.f, 0.f, 0.f, 0.f};
    bf16x8 At[4][2], B0[2][2], B1[2][2];
    const char* cA = (const char*)g.A + (size_t)cur.pm * tstepA; const char* cB = (const char*)g.Bt + (size_t)cur.pn * tstepB;
    S.a_ready(cur);
    if constexpr (SP2) {
        PG8_STAGE(PG8_SB(0, 0), cB, voffB); PG8_STAGE(PG8_SB(0, 1), cB + hstepB, voffB); PG8_STAGE(PG8_SA(0, 0), cA, voffA); PG8_STAGE(PG8_SA(0, 1), cA + hstepA, voffA);
        if (wr == 1) PG8_BAR;
        PG8_WAIT_V(2); PG8_BAR;
        PG8_STAGE(PG8_SB(1, 0), cB + kstep, voffB); PG8_STAGE(PG8_SA(1, 0), cA + kstep, voffA); PG8_STAGE(PG8_SB(1, 1), cB + hstepB + kstep, voffB);
        PG8_WAIT_V(6); PG8_BAR;
    } else {
        PG8_STAGE(PG8_SB(0, 0), cB, voffB); PG8_STAGE(PG8_SA(0, 0), cA, voffA); PG8_STAGE(PG8_SB(0, 1), cB + hstepB, voffB); PG8_STAGE(PG8_SA(0, 1), cA + hstepA, voffA);
        if (wr == 1) PG8_BAR;
        PG8_WAIT_V(4); PG8_BAR;
        PG8_STAGE(PG8_SB(1, 0), cB + kstep, voffB); PG8_STAGE(PG8_SA(1, 0), cA + kstep, voffA); PG8_STAGE(PG8_SB(1, 1), cB + hstepB + kstep, voffB);
        PG8_WAIT_V(6); PG8_BAR;
    }
    for (;;) {
        const bool has_next = S.next(ui + 1, nxt);
        const char* nA = has_next ? (const char*)g.A + (size_t)nxt.pm * tstepA : cA; const char* nB = has_next ? (const char*)g.Bt + (size_t)nxt.pn * tstepB : cB;
#ifdef PROBE_KLOOP
        const unsigned long long pk_t0 = __builtin_amdgcn_s_memrealtime();
#endif
        for (int t = 0; t < nt; t += 2) {
            const bool last = (t == nt - 2);
            const char* a1 = cA + (size_t)(t + 1) * kstep;
            const char* a2 = last ? nA : cA + (size_t)(t + 2) * kstep; const char* b2 = last ? nB : cB + (size_t)(t + 2) * kstep;
            const char* a3 = a2 + kstep; const char* b3 = b2 + kstep;
            if (last && has_next) S.a_ready(nxt);
            if constexpr (SP2) {
            PG8_LDB(B0, 0, 0); PG8_LDB(B1, 0, 1); PG8_SCHED; PG8_LDA(At, 0, 0); PG8_STAGE(PG8_SA(1, 1), a1 + hstepA, voffA);
            PG8_WAIT_V(8); PG8_WAIT_L(0); PG8_BAR; PG8_MMA(0, 0, At, B0); PG8_MMA(0, 1, At, B1); PG8_BAR; PG8_SCHED;
            PG8_LDA(At, 0, 1); PG8_STAGE(PG8_SB(0, 0), b2, voffB); PG8_STAGE(PG8_SB(0, 1), b2 + hstepB, voffB); PG8_STAGE(PG8_SA(0, 0), a2, voffA);
            PG8_WAIT_V(8); PG8_WAIT_L(0); PG8_BAR; PG8_MMA(1, 0, At, B0); PG8_MMA(1, 1, At, B1); PG8_BAR; PG8_SCHED;
            PG8_LDB(B0, 1, 0); PG8_LDB(B1, 1, 1); PG8_SCHED; PG8_LDA(At, 1, 0); PG8_STAGE(PG8_SA(0, 1), a2 + hstepA, voffA);
            PG8_WAIT_V(8); PG8_WAIT_L(0); PG8_BAR; PG8_MMA(0, 0, At, B0); PG8_MMA(0, 1, At, B1); PG8_BAR; PG8_SCHED;
            PG8_LDA(At, 1, 1); PG8_STAGE(PG8_SB(1, 0), b3, voffB); PG8_STAGE(PG8_SB(1, 1), b3 + hstepB, voffB); PG8_STAGE(PG8_SA(1, 0), a3, voffA);
            PG8_WAIT_V(8); PG8_WAIT_L(0); PG8_BAR; PG8_MMA(1, 0, At, B0); PG8_MMA(1, 1, At, B1); PG8_BAR; PG8_SCHED;
            } else {
            PG8_LDB(B0, 0, 0); PG8_SCHED; PG8_LDA(At, 0, 0); PG8_STAGE(PG8_SA(1, 1), a1 + hstepA, voffA);
            PG8_WAIT_L(8); PG8_BAR; PG8_WAIT_L(0); PG8_MMA(0, 0, At, B0); PG8_BAR; PG8_SCHED;
            PG8_LDB(B1, 0, 1); PG8_STAGE(PG8_SB(0, 0), b2, voffB);
            PG8_BAR; PG8_WAIT_L(0); PG8_MMA(0, 1, At, B1); PG8_BAR;
            PG8_LDA(At, 0, 1); PG8_STAGE(PG8_SA(0, 0), a2, voffA);
            PG8_BAR; PG8_WAIT_L(0); PG8_MMA(1, 0, At, B0); PG8_BAR; PG8_SCHED;
            PG8_STAGE(PG8_SB(0, 1), b2 + hstepB, voffB);
            PG8_WAIT_V(6); PG8_BAR; PG8_MMA(1, 1, At, B1); PG8_BAR;
            PG8_LDB(B0, 1, 0); PG8_SCHED; PG8_LDA(At, 1, 0); PG8_STAGE(PG8_SA(0, 1), a2 + hstepA, voffA);
            PG8_WAIT_L(8); PG8_BAR; PG8_WAIT_L(0); PG8_MMA(0, 0, At, B0); PG8_BAR; PG8_SCHED;
            PG8_LDB(B1, 1, 1); PG8_STAGE(PG8_SB(1, 0), b3, voffB);
            PG8_BAR; PG8_WAIT_L(0); PG8_MMA(0, 1, At, B1); PG8_BAR;
            PG8_LDA(At, 1, 1); PG8_STAGE(PG8_SA(1, 0), a3, voffA);
            PG8_BAR; PG8_WAIT_L(0); PG8_MMA(1, 0, At, B0); PG8_BAR; PG8_SCHED;
            PG8_STAGE(PG8_SB(1, 1), b3 + hstepB, voffB);
            PG8_WAIT_V(6); PG8_BAR; PG8_MMA(1, 1, At, B1); PG8_BAR;
            }
        }
#ifdef PROBE_KLOOP
        if (PROBE_KLOOP == g.tag && tid == 0) *(PG8_LAS unsigned*)(lds + 131072 + 320 + 64) += (unsigned)(__builtin_amdgcn_s_memrealtime() - pk_t0);
#endif
        if constexpr (ALIGN_EPI) { if (wr == 0) PG8_BAR; }
#ifdef PROBE_EPI
        const unsigned long long pe_t0 = __builtin_amdgcn_s_memrealtime();
#endif
        if constexpr (!Epi::AFTER_DRAIN) { E(acc, cur, wr, wc, fr, fq); S.done(cur); }
#ifdef PROBE_EPI
        if (PROBE_EPI == g.tag && tid == 0) *(PG8_LAS unsigned*)(lds + 131072 + 320 + 64) += (unsigned)(__builtin_amdgcn_s_memrealtime() - pe_t0);
#endif
        if (!has_next) break;
#pragma unroll
        for (int a = 0; a < 2; ++a)
#pragma unroll
            for (int b = 0; b < 2; ++b)
#pragma unroll
                for (int m = 0; m < 4; ++m)
#pragma unroll
                    for (int n = 0; n < 2; ++n) acc[a][b][m][n] = (f32x4){0.f, 0.f, 0.f, 0.f};
        cur = nxt; cA = nA; cB = nB; ++ui;
        if constexpr (ALIGN_EPI) { if (wr == 1) PG8_BAR; }
    }
    PG8_WAIT_V(0);
    if constexpr (!ALIGN_EPI) { if (wr == 0) PG8_BAR; }
    PG8_BAR;
    if constexpr (Epi::AFTER_DRAIN) { E.fused(acc, cur, wr, wc, fr, fq, lds, wid, lane); S.done(cur); }
#undef PG8_SA
#undef PG8_SB
#undef PG8_STAGE
#undef PG8_LDA
#undef PG8_LDB
#undef PG8_MMA
#undef PG8_WAIT_V
#undef PG8_WAIT_L
#undef PG8_BAR
#undef PG8_SCHED
}
}
#define EPI_ROWS_BEGIN  _Pragma("unroll") for (int ai = 0; ai < 2; ++ai) _Pragma("unroll") for (int m = 0; m < 4; ++m) { const int row = u.pm * 256 + ai * 128 + wr * 64 + m * 16 + fr;
#define EPI_ROWS_END    }
__device__ __forceinline__ u32x4 pack8(const f32x4 a, const f32x4 b) { u32x4 w; w.x = cvt_pk_bf16(a[0], a[1]); w.y = cvt_pk_bf16(a[2], a[3]); w.z = cvt_pk_bf16(b[0], b[1]); w.w = cvt_pk_bf16(b[2], b[3]); return w; }
__device__ __forceinline__ void unpack8(const u32x4 w, f32x4& a, f32x4& b) { a = (f32x4){bf_lo(w.x), bf_hi(w.x), bf_lo(w.y), bf_hi(w.y)}; b = (f32x4){bf_lo(w.z), bf_hi(w.z), bf_lo(w.w), bf_hi(w.w)}; }
__device__ __forceinline__ f32x4 sig4(const f32x4 x) { return (f32x4){sigmoidf_(x[0]), sigmoidf_(x[1]), sigmoidf_(x[2]), sigmoidf_(x[3])}; }

__device__ __forceinline__ void ssq_add(float* ssq, int row, float part, int fq) { part += __shfl_xor(part, 16); part += __shfl_xor(part, 32); if (fq == 0) atomicAdd(ssq + row, part); }
__device__ __forceinline__ float sq4(const f32x4 a) { return (a[0] * a[0] + a[1] * a[1]) + (a[2] * a[2] + a[3] * a[3]); }
#define EPI_BJ 32
#define EPI_ROW(ai, m) (u.pm * 256 + (ai) * 128 + wr * 64 + (m) * 16 + fr)
template <int RS, bool SSQ, bool NT = true> struct EpiStoreBf16 {
    static constexpr bool PERM = true, AFTER_DRAIN = false;
    bf16_t* O; int ldc; const float* rs; float* ssq;
    __device__ __forceinline__ void operator()(const f32x4 (&acc)[2][2][4][2], const pg8::Unit& u, int wr, int wc, int, int) const { const int l_ = lane_id_(); const int fr = l_ & 15, fq = l_ >> 4;

        const int col0 = u.pn * 256 + wc * 64 + 8 * fq;
        float scv[2][4];
#pragma unroll
        for (int ai = 0; ai < 2; ++ai)
#pragma unroll
            for (int m = 0; m < 4; ++m) scv[ai][m] = RS ? rs[EPI_ROW(ai, m)] : 1.f;
#pragma unroll
        for (int ai = 0; ai < 2; ++ai)
#pragma unroll
            for (int m = 0; m < 4; ++m) { const int row = EPI_ROW(ai, m);
                bf16_t* rowp = O + (size_t)row * ldc + col0;
                float sc = scv[ai][m]; if (RS == 2) sc = 1.0f / sqrtf(sc * (1.f / DM) + EPS);
                float part = 0.f;
#pragma unroll
                for (int bj = 0; bj < 2; ++bj) { const f32x4 v0 = acc[ai][bj][m][0] * sc, v1 = acc[ai][bj][m][1] * sc; if (SSQ) part += sq4(v0) + sq4(v1); if (NT) __builtin_nontemporal_store(pack8(v0, v1), (u32x4*)(rowp + bj * EPI_BJ)); else *(u32x4*)(rowp + bj * EPI_BJ) = pack8(v0, v1); }
                if (SSQ) ssq_add(ssq, row, part, fq); }
    }
};
#define EPI_BARRIER() asm volatile("" ::: "memory")
#define EPI_PIN(ai, m) asm volatile("" :: "v"(acc[ai][0][m][0]), "v"(acc[ai][0][m][1]), "v"(acc[ai][1][m][0]), "v"(acc[ai][1][m][1]) : "memory")
__device__ __forceinline__ u32x2 pack8_fp8(const f32x4 a, const f32x4 b) { int w0 = __builtin_amdgcn_cvt_pk_fp8_f32(a[0], a[1], 0, false); w0 = __builtin_amdgcn_cvt_pk_fp8_f32(a[2], a[3], w0, true);
    int w1 = __builtin_amdgcn_cvt_pk_fp8_f32(b[0], b[1], 0, false); w1 = __builtin_amdgcn_cvt_pk_fp8_f32(b[2], b[3], w1, true); return (u32x2){(unsigned)w0, (unsigned)w1}; }
__device__ __forceinline__ void unpack8_fp8(const u32x2 w, f32x4& a, f32x4& b) { const auto a0 = __builtin_amdgcn_cvt_pk_f32_fp8((int)w.x, false), a1 = __builtin_amdgcn_cvt_pk_f32_fp8((int)w.x, true),
    b0 = __builtin_amdgcn_cvt_pk_f32_fp8((int)w.y, false), b1 = __builtin_amdgcn_cvt_pk_f32_fp8((int)w.y, true); a = (f32x4){a0[0], a0[1], a1[0], a1[1]}; b = (f32x4){b0[0], b0[1], b1[0], b1[1]}; }
struct EpiProj {
    static constexpr bool PERM = true, AFTER_DRAIN = false;
    bf16_t* O; const float* rs; unsigned char* G8;
    __device__ __forceinline__ void operator()(const f32x4 (&acc)[2][2][4][2], const pg8::Unit& u, int wr, int wc, int, int) const { const int l_ = lane_id_(); const int fr = l_ & 15, fq = l_ >> 4;
        const int col0 = u.pn * 256 + wc * 64 + 8 * fq;
        float scv[2][4];
#pragma unroll
        for (int ai = 0; ai < 2; ++ai)
#pragma unroll
            for (int m = 0; m < 4; ++m) scv[ai][m] = rs[EPI_ROW(ai, m)];
#pragma unroll
        for (int ai = 0; ai < 2; ++ai)
#pragma unroll
            for (int m = 0; m < 4; ++m) { const int row = EPI_ROW(ai, m); const float sc = scv[ai][m];
#pragma unroll
                for (int bj = 0; bj < 2; ++bj) { const int col = col0 + bj * EPI_BJ; const f32x4 v0 = acc[ai][bj][m][0] * sc, v1 = acc[ai][bj][m][1] * sc;
                    if (col < C_GA) *(u32x4*)(O + (size_t)row * INWP + col) = pack8(v0, v1);
                    else if (col < INW) *(u32x2*)(G8 + (size_t)row * 4096 + (col - C_GA)) = pack8_fp8(v0, v1); } }
    }
};
struct EpiGlu {
    static constexpr bool PERM = true, AFTER_DRAIN = false;
    const bf16_t* Z; bf16_t* O; int ldc;
    __device__ __forceinline__ void operator()(f32x4 (&acc)[2][2][4][2], const pg8::Unit& u, int wr, int wc, int, int) const { const int l_ = lane_id_(); const int fr = l_ & 15, fq = l_ >> 4;

        const int col0 = u.pn * 256 + wc * 64 + 8 * fq;
#pragma unroll
        for (int g = 0; g < 8; ++g) { const int ai = g >> 2, m = g & 3; const unsigned off = (unsigned)EPI_ROW(ai, m) * (unsigned)ldc + col0;
            const u32x4 za = *(const u32x4*)(Z + off), zb = *(const u32x4*)(Z + off + EPI_BJ);
            { f32x4 z0, z1; unpack8(za, z0, z1); acc[ai][0][m][0] = z0 * sig4(acc[ai][0][m][0]); acc[ai][0][m][1] = z1 * sig4(acc[ai][0][m][1]); }
            { f32x4 z0, z1; unpack8(zb, z0, z1); acc[ai][1][m][0] = z0 * sig4(acc[ai][1][m][0]); acc[ai][1][m][1] = z1 * sig4(acc[ai][1][m][1]); }
            EPI_PIN(ai, m); }
#pragma unroll
        for (int g = 0; g < 8; ++g) { const int ai = g >> 2, m = g & 3; const unsigned off = (unsigned)EPI_ROW(ai, m) * (unsigned)ldc + col0;
            *(u32x4*)(O + off) = pack8(acc[ai][0][m][0], acc[ai][0][m][1]); *(u32x4*)(O + off + EPI_BJ) = pack8(acc[ai][1][m][0], acc[ai][1][m][1]); }
    }
};
template <bool ADD> struct EpiGate {
    static constexpr bool PERM = true, AFTER_DRAIN = false;
    const unsigned char* Gt; int ldg; unsigned char* T8; bf16_t* O; int ldc;
    __device__ __forceinline__ void operator()(f32x4 (&acc)[2][2][4][2], const pg8::Unit& u, int wr, int wc, int, int) const { const int l_ = lane_id_(); const int fr = l_ & 15, fq = l_ >> 4;
        const int col0 = u.pn * 256 + wc * 64 + 8 * fq;
        u32x2 Ga[8][2], Ta[8][2];
#pragma unroll
        for (int g = 0; g < 8; ++g) { const unsigned row = (unsigned)EPI_ROW(g >> 2, g & 3); const unsigned og = row * (unsigned)ldg + col0, ot = row * (unsigned)DM + col0;
            Ga[g][0] = *(const u32x2*)(Gt + og); Ga[g][1] = *(const u32x2*)(Gt + og + EPI_BJ);
            if (ADD) { Ta[g][0] = *(const u32x2*)(T8 + ot); Ta[g][1] = *(const u32x2*)(T8 + ot + EPI_BJ); } }
#pragma unroll
        for (int g = 0; g < 8; ++g) { const int ai = g >> 2, m = g & 3;
#pragma unroll
            for (int bj = 0; bj < 2; ++bj) { f32x4 g0, g1; unpack8_fp8(Ga[g][bj], g0, g1); f32x4 r0 = sig4(g0) * acc[ai][bj][m][0], r1 = sig4(g1) * acc[ai][bj][m][1];
                if (ADD) { f32x4 o0, o1; unpack8_fp8(Ta[g][bj], o0, o1); r0 += o0; r1 += o1; }
                acc[ai][bj][m][0] = r0; acc[ai][bj][m][1] = r1; }
            EPI_PIN(ai, m); }
#pragma unroll
        for (int g = 0; g < 8; ++g) { const int ai = g >> 2, m = g & 3; const unsigned row = (unsigned)EPI_ROW(ai, m);
            if (ADD) { const unsigned oo = row * (unsigned)ldc + col0; *(u32x4*)(O + oo) = pack8(acc[ai][0][m][0], acc[ai][0][m][1]); *(u32x4*)(O + oo + EPI_BJ) = pack8(acc[ai][1][m][0], acc[ai][1][m][1]); }
            else { const unsigned ot = row * (unsigned)DM + col0; *(u32x2*)(T8 + ot) = pack8_fp8(acc[ai][0][m][0], acc[ai][0][m][1]); *(u32x2*)(T8 + ot + EPI_BJ) = pack8_fp8(acc[ai][1][m][0], acc[ai][1][m][1]); } }
    }
};
#define EPD 1
struct EpiResidBf {
    static constexpr bool PERM = true, AFTER_DRAIN = false;
    bf16_t* X; float* ssq;
    __device__ __forceinline__ void operator()(f32x4 (&acc)[2][2][4][2], const pg8::Unit& u, int wr, int wc, int, int) const { const int l_ = lane_id_(); const int fr = l_ & 15, fq = l_ >> 4;
        const int col0 = u.pn * 256 + wc * 64 + 8 * fq;
        float part[8]; u32x4 La[EPD + 1], Lb[EPD + 1];
#pragma unroll
        for (int g = 0; g < EPD; ++g) { const unsigned off = (unsigned)EPI_ROW(g >> 2, g & 3) * DM + col0; La[g] = *(const u32x4*)(X + off); Lb[g] = *(const u32x4*)(X + off + EPI_BJ); }
#pragma unroll
        for (int g = 0; g < 8; ++g) { const int ai = g >> 2, m = g & 3; const int nb = (g + EPD) % (EPD + 1), cb = g % (EPD + 1);
            if (g + EPD < 8) { const unsigned off = (unsigned)EPI_ROW((g + EPD) >> 2, (g + EPD) & 3) * DM + col0; La[nb] = *(const u32x4*)(X + off); Lb[nb] = *(const u32x4*)(X + off + EPI_BJ); }
            asm volatile("" :: "v"(La[nb]), "v"(Lb[nb]) : "memory");
            f32x4 x0, x1, x2, x3; unpack8(La[cb], x0, x1); unpack8(Lb[cb], x2, x3);
            x0 += acc[ai][0][m][0]; x1 += acc[ai][0][m][1]; x2 += acc[ai][1][m][0]; x3 += acc[ai][1][m][1];
            part[g] = (sq4(x0) + sq4(x1)) + (sq4(x2) + sq4(x3));
            acc[ai][0][m][0] = x0; acc[ai][0][m][1] = x1; acc[ai][1][m][0] = x2; acc[ai][1][m][1] = x3;
            EPI_PIN(ai, m); }
#pragma unroll
        for (int g = 0; g < 8; ++g) { const int ai = g >> 2, m = g & 3; const unsigned off = (unsigned)EPI_ROW(ai, m) * DM + col0;
            *(u32x4*)(X + off) = pack8(acc[ai][0][m][0], acc[ai][0][m][1]); *(u32x4*)(X + off + EPI_BJ) = pack8(acc[ai][1][m][0], acc[ai][1][m][1]); }
#pragma unroll
        for (int g = 0; g < 8; ++g) ssq_add(ssq, EPI_ROW(g >> 2, g & 3), part[g], fq);
    }
};
#define EPDP 1
struct EpiPg {
    static constexpr bool PERM = true, AFTER_DRAIN = false;
    float* out; const bf16_t* x2; const bf16_t* pr; const float* ssq2; const float* ssqp; const float* gp;
    __device__ __forceinline__ void operator()(f32x4 (&acc)[2][2][4][2], const pg8::Unit& u, int wr, int wc, int, int) const { const int l_ = lane_id_(); const int fr = l_ & 15, fq = l_ >> 4;
        const int col0 = u.pn * 256 + wc * 64 + 8 * fq;
        f32x4 gv[2][2]; u32x4 Lx[EPDP + 1][2], Lp[EPDP + 1][2]; float Ls[EPDP + 1][2];
#pragma unroll
        for (int bj = 0; bj < 2; ++bj)
#pragma unroll
            for (int n = 0; n < 2; ++n) gv[bj][n] = *(const f32x4*)(gp + col0 + bj * EPI_BJ + n * 4);
#pragma unroll
        for (int g = 0; g < EPDP; ++g) { const int row0_ = EPI_ROW(g >> 2, g & 3); Ls[g][0] = ssq2[row0_]; Ls[g][1] = ssqp[row0_]; const unsigned off = (unsigned)row0_ * DM + col0; Lx[g][0] = *(const u32x4*)(x2 + off); Lx[g][1] = *(const u32x4*)(x2 + off + EPI_BJ); Lp[g][0] = *(const u32x4*)(pr + off); Lp[g][1] = *(const u32x4*)(pr + off + EPI_BJ); }
#pragma unroll
        for (int g = 0; g < 8; ++g) { const int ai = g >> 2, m = g & 3; const int nb = (g + EPDP) % (EPDP + 1), cb = g % (EPDP + 1);
            if (g + EPDP < 8) { const int row1_ = EPI_ROW((g + EPDP) >> 2, (g + EPDP) & 3); Ls[nb][0] = ssq2[row1_]; Ls[nb][1] = ssqp[row1_]; const unsigned off = (unsigned)row1_ * DM + col0;
                Lx[nb][0] = *(const u32x4*)(x2 + off); Lx[nb][1] = *(const u32x4*)(x2 + off + EPI_BJ); Lp[nb][0] = *(const u32x4*)(pr + off); Lp[nb][1] = *(const u32x4*)(pr + off + EPI_BJ); }
            asm volatile("" :: "v"(Lx[nb][0]), "v"(Lx[nb][1]), "v"(Lp[nb][0]), "v"(Lp[nb][1]) : "memory");
            const float r2 = 1.0f / sqrtf(Ls[cb][0] * (1.f / DM) + EPS), rp = 1.0f / sqrtf(Ls[cb][1] * (1.f / DM) + EPS);
#pragma unroll
            for (int bj = 0; bj < 2; ++bj) { f32x4 x0, x1, p0, p1; unpack8(Lx[cb][bj], x0, x1); unpack8(Lp[cb][bj], p0, p1);
                acc[ai][bj][m][0] = x0 + sig4(acc[ai][bj][m][0] * r2) * p0 * gv[bj][0] * rp; acc[ai][bj][m][1] = x1 + sig4(acc[ai][bj][m][1] * r2) * p1 * gv[bj][1] * rp; }
            EPI_PIN(ai, m); }
#pragma unroll
        for (int ai = 0; ai < 2; ++ai)
#pragma unroll
            for (int m = 0; m < 4; ++m) { const int row = EPI_ROW(ai, m);
                if (row < MR) { const unsigned off = (unsigned)row * DM + col0;
#pragma unroll
                    for (int bj = 0; bj < 2; ++bj) { float* o = out + off + bj * EPI_BJ; *(f32x4*)o = acc[ai][bj][m][0]; *(f32x4*)(o + 4) = acc[ai][bj][m][1]; } } }
    }
};
template <class Epi>
__device__ __forceinline__ void skinny_gemm(LAS unsigned char* lds, const bf16_t* __restrict__ A, int lda, const bf16_t* __restrict__ Bt, int K, int N, const Epi& E, int vcu, int G, int wave, int lane) {
    const int kq = wave & 3, rgp = wave >> 2, cq = lane >> 4, Kq = K >> 2;
    LAS f32x4* red = (LAS f32x4*)lds;
    for (int u = vcu; u < N / 8; u += G) {
        const int cs = u >> 1, rh = u & 1; const int row0 = TP + 64 * rh + 32 * rgp + (lane & 15);
        const bf16_t* ap0 = A + (size_t)row0 * lda + kq * Kq + 8 * cq; const bf16_t* ap1 = ap0 + (size_t)16 * lda;
        const bf16_t* bp = Bt + (size_t)(16 * cs + (lane & 15)) * K + kq * Kq + 8 * cq;
        f32x4 acc0 = {0.f, 0.f, 0.f, 0.f}, acc1 = {0.f, 0.f, 0.f, 0.f};
#pragma unroll 8
        for (int k0 = 0; k0 < Kq; k0 += 32) { const bf16x8 bw = *(const bf16x8*)(bp + k0);
            acc0 = __builtin_amdgcn_mfma_f32_16x16x32_bf16(bw, *(const bf16x8*)(ap0 + k0), acc0, 0, 0, 0);
            acc1 = __builtin_amdgcn_mfma_f32_16x16x32_bf16(bw, *(const bf16x8*)(ap1 + k0), acc1, 0, 0, 0); }
        if (kq != 0) { red[((kq - 1) * 2 + rgp) * 128 + lane] = acc0; red[((kq - 1) * 2 + rgp) * 128 + 64 + lane] = acc1; }
        __syncthreads();
        if (kq == 0) {
#pragma unroll
            for (int q3 = 0; q3 < 3; ++q3) { acc0 += red[(q3 * 2 + rgp) * 128 + lane]; acc1 += red[(q3 * 2 + rgp) * 128 + 64 + lane]; }
            E(row0, 16 * cs + 4 * cq, acc0, lane); E(row0 + 16, 16 * cs + 4 * cq, acc1, lane); }
        __syncthreads();
    }
}
__device__ __forceinline__ f32x4 ld4bf(const bf16_t* p) { const u32x2 w = *(const u32x2*)p; return (f32x4){bf_lo(w.x), bf_hi(w.x), bf_lo(w.y), bf_hi(w.y)}; }
__device__ __forceinline__ void st4bf(bf16_t* p, const f32x4 v) { u32x2 w; w.x = cvt_pk_bf16(v[0], v[1]); w.y = cvt_pk_bf16(v[2], v[3]); *(u32x2*)p = w; }
struct SkGlu { const bf16_t* Z; bf16_t* O; __device__ __forceinline__ void operator()(int row, int col, f32x4 acc, int) const { const size_t o = (size_t)row * 512 + col; st4bf(O + o, ld4bf(Z + o) * sig4(acc)); } };
template <bool ADD> struct SkGate { const unsigned char* Gt; int ldg; unsigned char* T8; bf16_t* O;
    __device__ __forceinline__ void operator()(int row, int col, f32x4 acc, int) const { const int gw_ = *(const int*)(Gt + (size_t)row * ldg + col); const auto g0_ = __builtin_amdgcn_cvt_pk_f32_fp8(gw_, false), g1_ = __builtin_amdgcn_cvt_pk_f32_fp8(gw_, true);
        f32x4 r = sig4((f32x4){g0_[0], g0_[1], g1_[0], g1_[1]}) * acc; unsigned char* tp = T8 + (size_t)row * DM + col;
        if (ADD) { const int tw = *(const int*)tp; const auto t0 = __builtin_amdgcn_cvt_pk_f32_fp8(tw, false), t1 = __builtin_amdgcn_cvt_pk_f32_fp8(tw, true); r += (f32x4){t0[0], t0[1], t1[0], t1[1]}; st4bf(O + (size_t)row * DM + col, r); }
        else { int w = __builtin_amdgcn_cvt_pk_fp8_f32(r[0], r[1], 0, false); w = __builtin_amdgcn_cvt_pk_fp8_f32(r[2], r[3], w, true); *(int*)tp = w; } } };
struct SkResid { bf16_t* X; float* ssq;
    __device__ __forceinline__ void operator()(int row, int col, f32x4 acc, int lane) const { bf16_t* p = X + (size_t)row * DM + col; const f32x4 x = ld4bf(p) + acc; st4bf(p, x);
        float part = sq4(x); part += __shfl_xor(part, 16); part += __shfl_xor(part, 32); if (lane < 16) atomicAdd(ssq + row, part); } };
struct SkPg { float* out; const bf16_t* x2; const bf16_t* pr; const float* ssq2; const float* ssqp; const float* gp;
    __device__ __forceinline__ void operator()(int row, int col, f32x4 acc, int) const { const float r2 = 1.0f / sqrtf(ssq2[row] * (1.f / DM) + EPS), rp = 1.0f / sqrtf(ssqp[row] * (1.f / DM) + EPS);
        const size_t o = (size_t)row * DM + col; *(f32x4*)(out + o) = ld4bf(x2 + o) + sig4(acc * r2) * ld4bf(pr + o) * *(const f32x4*)(gp + col) * rp; } };
struct SkStore { bf16_t* O; float* ssq;
    __device__ __forceinline__ void operator()(int row, int col, f32x4 acc, int lane) const { st4bf(O + (size_t)row * DM + col, acc);
        float part = sq4(acc); part += __shfl_xor(part, 16); part += __shfl_xor(part, 32); if (lane < 16) atomicAdd(ssq + row, part); } };
#define XB_TMO      128
#define XB_XCNT(j)  (256  + 64 * (j))
#define XB_XSUB(j)  (1280 + 64 * (j))
#define XB_XGEN(j)  (2304 + 64 * (j))
#define XB_TOP      3328
#define XB_TOPGEN   3392
#define XCD_BAR_WORDS 3456
#define XB_SPIN_CAP (1u << 18)

__device__ __forceinline__ unsigned xb_ld(unsigned* p)              { return __hip_atomic_load(p, __ATOMIC_RELAXED, __HIP_MEMORY_SCOPE_AGENT); }
__device__ __forceinline__ unsigned xb_add(unsigned* p, unsigned v) { return __hip_atomic_fetch_add(p, v, __ATOMIC_RELAXED, __HIP_MEMORY_SCOPE_AGENT); }
__device__ __forceinline__ unsigned xb_xcc_id() { return (unsigned)__builtin_amdgcn_s_getreg((3 << 11) | 20) & 0xFu; }
#define XB_SPIN(cond, bar) do { unsigned _sp = 0; while (cond) { __builtin_amdgcn_s_sleep(1); \
    if ((++_sp & 255u) == 0u) { if (xb_ld(&(bar)[XB_TMO])) break; if (_sp > XB_SPIN_CAP) { atomicAdd(&(bar)[XB_TMO], 1u); break; } } } } while (0)

struct XcdBarrier {
    unsigned* bar; unsigned x; int w0;
    volatile LAS unsigned* st;
};

__device__ __forceinline__ XcdBarrier xcd_barrier_post(unsigned* bar, volatile LAS unsigned* st) {
    XcdBarrier b; b.bar = bar; b.x = xb_xcc_id(); b.st = st; b.w0 = (__builtin_amdgcn_readfirstlane((int)threadIdx.x >> 6) == 0);
    if (b.w0 && lane_id_() == 0) (void)xb_add(&bar[XB_XCNT(b.x)], 1u);
    return b;
}
__device__ __forceinline__ void xcd_barrier_complete(unsigned* bar, unsigned x, unsigned& nloc, unsigned& nx) {
    const unsigned G = gridDim.x * gridDim.y * gridDim.z;
    unsigned sum, cnt, mine, sp = 0u;
    for (;;) {
        sum = 0u; cnt = 0u; mine = 0u;
#pragma unroll
        for (unsigned j = 0; j < 16; ++j) { const unsigned c = xb_ld(&bar[XB_XCNT(j)]); sum += c; cnt += (c > 0u) ? 1u : 0u; mine = (j == x) ? c : mine; }
        if (sum == G) break;
        __builtin_amdgcn_s_sleep(1);
        if ((++sp & 255u) == 0u) { if (xb_ld(&bar[XB_TMO])) break; if (sp > XB_SPIN_CAP) { atomicAdd(&bar[XB_TMO], 1u); break; } }
    }
    nloc = mine > 0u ? mine : 1u; nx = cnt > 0u ? cnt : 1u;
}

__device__ __forceinline__ void xcd_barrier(const XcdBarrier& b) {
    asm volatile("s_waitcnt vmcnt(0)" ::: "memory");
    __syncthreads();
    if (b.w0 && lane_id_() == 0) {
        unsigned* bar = b.bar;
        __builtin_amdgcn_s_waitcnt(0);
        unsigned nloc = b.st[0], nx = b.st[1];
        if (nloc == 0u) { xcd_barrier_complete(bar, b.x, nloc, nx); b.st[0] = nloc; b.st[1] = nx; }
        const unsigned old = xb_add(&bar[XB_XSUB(b.x)], 1u);
        const unsigned gen = old / nloc;
        if (old + 1u == (gen + 1u) * nloc) {
            __builtin_amdgcn_fence(__ATOMIC_RELEASE, "agent");
            asm volatile("s_waitcnt vmcnt(0)" ::: "memory");
            const unsigned og = xb_add(&bar[XB_TOP], 1u);
            const unsigned tg = og / nx;
            if (og + 1u == (tg + 1u) * nx) xb_add(&bar[XB_TOPGEN], 1u);
            else XB_SPIN(xb_ld(&bar[XB_TOPGEN]) == tg, bar);
            __builtin_amdgcn_fence(__ATOMIC_ACQUIRE, "agent");
            xb_add(&bar[XB_XGEN(b.x)], 1u);
            asm volatile("s_waitcnt vmcnt(0)" ::: "memory");
        } else {
            XB_SPIN(xb_ld(&bar[XB_XGEN(b.x)]) == gen, bar);
            __builtin_amdgcn_fence(__ATOMIC_ACQUIRE, "agent");
            asm volatile("s_waitcnt vmcnt(0)" ::: "memory");
        }
    }
    __syncthreads();
}
__device__ __forceinline__ void cexp_d(double re, double im, int k, double& ore, double& oim) {
    const double sc = 1.0 / (double)(1ull << k); const double zr = re * sc, zi = im * sc;
    double tr = 1.0, ti = 0.0, sr = 1.0, si = 0.0;
#pragma unroll 1
    for (int n = 1; n <= 12; ++n) { const double inv = 1.0 / (double)n; const double nr = (tr * zr - ti * zi) * inv, ni = (tr * zi + ti * zr) * inv; tr = nr; ti = ni; sr += tr; si += ti; }
#pragma unroll 1
    for (int i = 0; i < k; ++i) { const double nr = sr * sr - si * si, ni = 2.0 * sr * si; sr = nr; si = ni; }
    ore = sr; oim = si;
}

struct TrItem { const float* W; bf16_t* WT; const float* gk; int K, N, nblk, item; };
__device__ __forceinline__ void transpose_load(const TrItem& T, int lane, float (&w)[32]) {
    const int kb = T.item / T.nblk, nb = T.item % T.nblk, k0 = 64 * kb, n0 = 32 * nb;
    const int nn = n0 + (lane & 31); const int nc = nn < T.N ? nn : T.N - 1;
    const float* wp = T.W + (size_t)(k0 + (lane >> 5)) * T.N + nc;
    const size_t rs2 = (size_t)2 * T.N;
#pragma unroll
    for (int i = 0; i < 32; ++i) w[i] = wp[i * rs2];
    if (T.gk) {
        float gkv[32]; const float* gp = T.gk + k0 + (lane >> 5);
#pragma unroll
        for (int i = 0; i < 32; ++i) gkv[i] = gp[2 * i];
#pragma unroll
        for (int i = 0; i < 32; ++i) w[i] *= gkv[i];
    }
    if (nn >= T.N) {
#pragma unroll
        for (int i = 0; i < 32; ++i) w[i] = 0.f; }
}
__device__ __forceinline__ void transpose_store(const TrItem& T, int lane, const float (&w)[32], LAS float* scr) {
    const int kb = T.item / T.nblk, nb = T.item % T.nblk, k0 = 64 * kb, n0 = 32 * nb;
#pragma unroll
    for (int i = 0; i < 32; ++i) { const int kk = 2 * i + (lane >> 5); scr[kk * 33 + (lane & 31)] = w[i]; }
    LDS_WAIT(); asm volatile("" ::: "memory");
    const int c = lane & 7;
#pragma unroll
    for (int j = 0; j < 4; ++j) { const int n = (lane >> 3) + 8 * j; const LAS float* s = scr + (8 * c) * 33 + n;
        u32x4 o; o.x = cvt_pk_bf16(s[0 * 33], s[1 * 33]); o.y = cvt_pk_bf16(s[2 * 33], s[3 * 33]); o.z = cvt_pk_bf16(s[4 * 33], s[5 * 33]); o.w = cvt_pk_bf16(s[6 * 33], s[7 * 33]);
        *(u32x4*)(T.WT + (size_t)(n0 + n) * T.K + k0 + 8 * c) = o; }
    LDS_WAIT(); asm volatile("" ::: "memory");
}
__device__ __forceinline__ void row_to_bf16_rstd(const float* __restrict__ xrow, bf16_t* __restrict__ orow, float* __restrict__ rs, int lane) {
    const f32x4* xr = (const f32x4*)xrow + lane;
    f32x4 v[8]; float s = 0.f;
#pragma unroll
    for (int j = 0; j < 8; ++j) { v[j] = xr[64 * j]; s += (v[j].x * v[j].x + v[j].y * v[j].y) + (v[j].z * v[j].z + v[j].w * v[j].w); }
    s = wave_sum(s);
    u32x2* o8 = (u32x2*)orow + lane;
#pragma unroll
    for (int j = 0; j < 8; ++j) { u32x2 w; w.x = cvt_pk_bf16(v[j].x, v[j].y); w.y = cvt_pk_bf16(v[j].z, v[j].w); o8[64 * j] = w; }
    if (lane == 0) *rs = 1.0f / sqrtf(s * (1.f / DM) + EPS);
}
__device__ __forceinline__ void ld16bf(const bf16_t* p, float (&v)[16]) {
    const u32x4 a = *(const u32x4*)p, b = *(const u32x4*)(p + 8);
    v[0] = bf_lo(a.x); v[1] = bf_hi(a.x); v[2] = bf_lo(a.y); v[3] = bf_hi(a.y); v[4] = bf_lo(a.z); v[5] = bf_hi(a.z); v[6] = bf_lo(a.w); v[7] = bf_hi(a.w);
    v[8] = bf_lo(b.x); v[9] = bf_hi(b.x); v[10] = bf_lo(b.y); v[11] = bf_hi(b.y); v[12] = bf_lo(b.z); v[13] = bf_hi(b.z); v[14] = bf_lo(b.w); v[15] = bf_hi(b.w);
}
__device__ __forceinline__ void st16bf(bf16_t* p, const float (&v)[16]) {
    u32x4 a, b; a.x = cvt_pk_bf16(v[0], v[1]); a.y = cvt_pk_bf16(v[2], v[3]); a.z = cvt_pk_bf16(v[4], v[5]); a.w = cvt_pk_bf16(v[6], v[7]);
    b.x = cvt_pk_bf16(v[8], v[9]); b.y = cvt_pk_bf16(v[10], v[11]); b.z = cvt_pk_bf16(v[12], v[13]); b.w = cvt_pk_bf16(v[14], v[15]);
    *(u32x4*)p = a; *(u32x4*)(p + 8) = b;
}
__device__ __forceinline__ void st16f(float* p, const float (&v)[16]) {
#pragma unroll
    for (int j = 0; j < 4; ++j) __builtin_nontemporal_store((f32x4){v[4 * j], v[4 * j + 1], v[4 * j + 2], v[4 * j + 3]}, (f32x4*)(p + 4 * j));
}
__device__ __forceinline__ void norm_rope128(float (&v)[16], int sub, const float (&g)[16], const float (&cs)[16], const float (&sn)[16]) {
    float ss = 0.f;
#pragma unroll
    for (int e = 0; e < 16; ++e) ss += v[e] * v[e];
    ss += __shfl_xor(ss, 1); ss += __shfl_xor(ss, 2); ss += __shfl_xor(ss, 4);
    const float rstd = 1.0f / sqrtf(ss * (1.f / 128.f) + EPS);
    const float sg = sub == 0 ? -1.f : 1.f; const bool act = sub < 2;
#pragma unroll
    for (int e = 0; e < 16; ++e) v[e] = v[e] * rstd * g[e];
#pragma unroll
    for (int e = 0; e < 16; ++e) { const float o = __shfl_xor(v[e], 1); const float r = v[e] * cs[e] + sg * o * sn[e]; v[e] = act ? r : v[e]; }
}
__device__ __forceinline__ void ld16f(const float* p, float (&v)[16]) {
#pragma unroll
    for (int j = 0; j < 4; ++j) { const f32x4 a = *(const f32x4*)(p + 4 * j); v[4 * j] = a.x; v[4 * j + 1] = a.y; v[4 * j + 2] = a.z; v[4 * j + 3] = a.w; }
}
__device__ __forceinline__ void rope64(float (&v)[16], const float (&ci)[8], const float (&si)[8]) {
#pragma unroll
    for (int i = 0; i < 8; ++i) { const float x1 = v[i], x2 = v[8 + i]; v[i] = x1 * ci[i] - x2 * si[i]; v[8 + i] = x2 * ci[i] + x1 * si[i]; }
}
__device__ __forceinline__ void up16(const u32x4 a, const u32x4 b, float (&v)[16]) {
    v[0] = bf_lo(a.x); v[1] = bf_hi(a.x); v[2] = bf_lo(a.y); v[3] = bf_hi(a.y); v[4] = bf_lo(a.z); v[5] = bf_hi(a.z); v[6] = bf_lo(a.w); v[7] = bf_hi(a.w);
    v[8] = bf_lo(b.x); v[9] = bf_hi(b.x); v[10] = bf_lo(b.y); v[11] = bf_hi(b.y); v[12] = bf_lo(b.z); v[13] = bf_hi(b.z); v[14] = bf_lo(b.w); v[15] = bf_hi(b.w);
}
struct TaRaw { u32x4 q0, q1, k0, k1, v0, v1, j0, j1; unsigned w; };
__device__ __forceinline__ void ta_load(int row, int lane, const bf16_t* __restrict__ proj, TaRaw& R) {
    const bf16_t* pr = proj + (size_t)row * INWP; const int l15 = lane & 15, l3 = lane & 3;
    R.q0 = *(const u32x4*)(pr + C_Q + 16 * lane); R.q1 = *(const u32x4*)(pr + C_Q + 16 * lane + 8);
    R.k0 = *(const u32x4*)(pr + C_K + 16 * l15); R.k1 = *(const u32x4*)(pr + C_K + 16 * l15 + 8);
    R.v0 = *(const u32x4*)(pr + C_V + 16 * l15); R.v1 = *(const u32x4*)(pr + C_V + 16 * l15 + 8);
    R.j0 = *(const u32x4*)(pr + C_IK + 16 * l3); R.j1 = *(const u32x4*)(pr + C_IK + 16 * l3 + 8);
    R.w = pr[C_IW + l15];
}
__device__ __forceinline__ void ta_compute(int row, int lane, const TaRaw& R, const float* __restrict__ RT, const float* __restrict__ gq, const float* __restrict__ gk,
                                           bf16_t* __restrict__ qn, bf16_t* __restrict__ kn, bf16_t* __restrict__ vb, bf16_t* __restrict__ iqr, bf16_t* __restrict__ ikr, float* __restrict__ iws, float* __restrict__ out) {
    const int pi = row < TP ? (row & (SEQ - 1)) : SEQ + ((row - TP) & 3);
    const float* rt = RT + pi * 48;
    const bool isp = row < TP; const int rs = isp ? row : row - TP;
    float cs[16], sn[16], ci[8], si[8], gqv[16], gkv[16];
    ld16f(rt, cs); ld16f(rt + 16, sn);
    { const f32x4 a = *(const f32x4*)(rt + 32), b = *(const f32x4*)(rt + 36), c = *(const f32x4*)(rt + 40), d = *(const f32x4*)(rt + 44);
      ci[0] = a.x; ci[1] = a.y; ci[2] = a.z; ci[3] = a.w; ci[4] = b.x; ci[5] = b.y; ci[6] = b.z; ci[7] = b.w; si[0] = c.x; si[1] = c.y; si[2] = c.z; si[3] = c.w; si[4] = d.x; si[5] = d.y; si[6] = d.z; si[7] = d.w; }
    ld16f(gq + (lane & 7) * 16, gqv); ld16f(gk + (lane & 7) * 16, gkv);
    float v[16];
    up16(R.q0, R.q1, v); norm_rope128(v, lane & 7, gqv, cs, sn); st16bf(qn + (size_t)row * 1024 + 16 * lane, v);
    { const int l = lane & 15; up16(R.k0, R.k1, v); norm_rope128(v, l & 7, gkv, cs, sn);
      if (lane < 16) { st16bf(kn + (size_t)row * 256 + 16 * l, v); st16f(out + (isp ? O_KP : O_KS) + (size_t)rs * 256 + 16 * l, v); } }
    if (lane < 16) { up16(R.v0, R.v1, v); (void)vb; st16f(out + (isp ? O_VP : O_VS) + (size_t)rs * 256 + 16 * lane, v); }
    (void)iqr;
    if (lane < 4) { up16(R.j0, R.j1, v); if (lane == 0) rope64(v, ci, si); st16bf(ikr + (size_t)row * 64 + 16 * lane, v); st16f(out + (isp ? O_IKP : O_IKS) + (size_t)rs * 64 + 16 * lane, v); }
    if (lane < 16) iws[(size_t)row * 16 + lane] = bf2f((bf16_t)R.w) * IDX_SCALE;
}
__device__ __forceinline__ bf16x8 as_bf16x8(const u32x4 w) { return __builtin_bit_cast(bf16x8, w); }
__device__ __forceinline__ void idx_load_a(const bf16_t* __restrict__ proj, const float* __restrict__ RT, size_t row0, int lane, bf16x8 (&a)[4]) {
    const int rho = lane & 31, h = lane >> 5; const int tok = (rho >> 2) & 1, head = (rho & 3) + 4 * (rho >> 3);
    const size_t row = row0 + tok;
    const bf16_t* p = proj + row * INWP + C_IQ + head * 64 + 8 * h;
#pragma unroll
    for (int kk = 0; kk < 4; ++kk) a[kk] = *(const bf16x8*)(p + 16 * kk);
    const int pi = row < (size_t)TP ? (int)(row & (SEQ - 1)) : SEQ + (int)((row - TP) & 3);
    const float* rt = RT + pi * 48;
    const f32x4 c0 = *(const f32x4*)(rt + 32), c1 = *(const f32x4*)(rt + 36), s0 = *(const f32x4*)(rt + 40), s1 = *(const f32x4*)(rt + 44);
    const float cc[8] = {c0.x, c0.y, c0.z, c0.w, c1.x, c1.y, c1.z, c1.w}, ss[8] = {s0.x, s0.y, s0.z, s0.w, s1.x, s1.y, s1.z, s1.w};
    const u32x4 w = __builtin_bit_cast(u32x4, a[0]);
    float x[8] = {bf_lo(w.x), bf_hi(w.x), bf_lo(w.y), bf_hi(w.y), bf_lo(w.z), bf_hi(w.z), bf_lo(w.w), bf_hi(w.w)};
    const float sg = h == 0 ? -1.f : 1.f;
#pragma unroll
    for (int i = 0; i < 8; ++i) { const float o = __shfl_xor(x[i], 32); x[i] = x[i] * cc[i] + sg * o * ss[i]; }
    u32x4 r; r.x = cvt_pk_bf16(x[0], x[1]); r.y = cvt_pk_bf16(x[2], x[3]); r.z = cvt_pk_bf16(x[4], x[5]); r.w = cvt_pk_bf16(x[6], x[7]);
    a[0] = as_bf16x8(r);
}
__device__ __forceinline__ float idx_reduce(const f32x16& acc, const f32x4 (&wv)[4]) {
    float s = 0.f;
#pragma unroll
    for (int r = 0; r < 16; ++r) s += wv[r >> 2][r & 3] * fmaxf(acc[r], 0.f);
    return s;
}
__device__ __forceinline__ void idx_prompt_block(int b, int qb, int wave, int lane, const bf16_t* __restrict__ proj, const float* __restrict__ RT, const bf16_t* __restrict__ ikr, const float* __restrict__ iws, float* __restrict__ sc) {
    const int h = lane >> 5, kl = lane & 31;
    bf16x8 a[4][4]; f32x4 wv[4][4]; size_t rowi[4];
#pragma unroll
    for (int i = 0; i < 4; ++i) { const size_t row0 = (size_t)b * SEQ + 64 * qb + 2 * (4 * wave + i); rowi[i] = row0 + h; idx_load_a(proj, RT, row0, lane, a[i]);
#pragma unroll
        for (int j = 0; j < 4; ++j) wv[i][j] = *(const f32x4*)(iws + (row0 + h) * 16 + 4 * j); }
    const int ntile = 2 * qb + 2;
    const bf16_t* kp = ikr + ((size_t)b * SEQ + kl) * 64 + 8 * h;
    bf16x8 bc[4], bn[4];
#pragma unroll
    for (int kk = 0; kk < 4; ++kk) bc[kk] = *(const bf16x8*)(kp + 16 * kk);
    for (int kt = 0; kt < ntile; ++kt) {
        if (kt + 1 < ntile) {
#pragma unroll
            for (int kk = 0; kk < 4; ++kk) bn[kk] = *(const bf16x8*)(kp + (size_t)(kt + 1) * 32 * 64 + 16 * kk); }
#pragma unroll
        for (int i = 0; i < 4; ++i) { f32x16 acc = {};
#pragma unroll
            for (int kk = 0; kk < 4; ++kk) acc = __builtin_amdgcn_mfma_f32_32x32x16_bf16(a[i][kk], bc[kk], acc, 0, 0, 0);
            sc[rowi[i] * SEQ + 32 * kt + kl] = idx_reduce(acc, wv[i]); }
#pragma unroll
        for (int kk = 0; kk < 4; ++kk) bc[kk] = bn[kk];
    }
}
__device__ __forceinline__ void idx_sample_unit(int b, int c, int wave, int lane, const bf16_t* __restrict__ proj, const float* __restrict__ RT, const bf16_t* __restrict__ ikr, const float* __restrict__ iws,
                                                const float* __restrict__ cik, const int* __restrict__ pt, float* __restrict__ ssc) {
    const int h = lane >> 5, kl = lane & 31;
    bf16x8 a[2][4]; f32x4 wv[2][4];
#pragma unroll
    for (int i = 0; i < 2; ++i) { const size_t row0 = (size_t)TP + 4 * b + 2 * i; idx_load_a(proj, RT, row0, lane, a[i]);
#pragma unroll
        for (int j = 0; j < 4; ++j) wv[i][j] = *(const f32x4*)(iws + (row0 + h) * 16 + 4 * j); }
    const int pgl = 8 * c + wave; const int page = pt[b * NPG + pgl];
#pragma unroll 1
    for (int kt = 0; kt < 4; ++kt) {
        const float* p = cik + ((size_t)page * PAGE + 32 * kt + kl) * 64 + 8 * h; bf16x8 bc[4];
#pragma unroll
        for (int kk = 0; kk < 4; ++kk) { const f32x4 x0 = *(const f32x4*)(p + 16 * kk), x1 = *(const f32x4*)(p + 16 * kk + 4); bc[kk] = as_bf16x8(pack8(x0, x1)); }
#pragma unroll
        for (int i = 0; i < 2; ++i) { f32x16 acc = {};
#pragma unroll
            for (int kk = 0; kk < 4; ++kk) acc = __builtin_amdgcn_mfma_f32_32x32x16_bf16(a[i][kk], bc[kk], acc, 0, 0, 0);
            ssc[(size_t)(b * 4 + 2 * i + h) * SSTR + pgl * PAGE + 32 * kt + kl] = idx_reduce(acc, wv[i]); }
    }
    if (c == 15 && wave == 0) {
        const bf16_t* p = ikr + ((size_t)TP + 4 * b + (kl & 3)) * 64 + 8 * h; bf16x8 bc[4];
#pragma unroll
        for (int kk = 0; kk < 4; ++kk) bc[kk] = *(const bf16x8*)(p + 16 * kk);
#pragma unroll
        for (int i = 0; i < 2; ++i) { f32x16 acc = {};
#pragma unroll
            for (int kk = 0; kk < 4; ++kk) acc = __builtin_amdgcn_mfma_f32_32x32x16_bf16(a[i][kk], bc[kk], acc, 0, 0, 0);
            const float s = idx_reduce(acc, wv[i]); if (kl < 4) ssc[(size_t)(b * 4 + 2 * i + h) * SSTR + PAST + kl] = s; }
    }
}
__device__ __forceinline__ unsigned fkey(float v) { const unsigned u = __float_as_uint(v); return (u >> 31) ? ~u : (u | 0x80000000u); }
__device__ __forceinline__ float fkey_inv(unsigned k) { return __uint_as_float((k >> 31) ? (k ^ 0x80000000u) : ~k); }
struct Bracket { float a, b, fa, fb, thr; int side, it; bool done; };
__device__ __forceinline__ void br_init(Bracket& B, float lo, float hi, int n, int cnt_hi) {
    B.a = lo; B.b = hi; B.fa = (float)(n - 256); B.fb = (float)(cnt_hi - 256); B.thr = lo; B.side = 0; B.it = 0; B.done = false;
    if (cnt_hi >= 256) { B.thr = hi; B.done = true; }
    if (n <= 256) { B.thr = lo; B.done = true; }
}
__device__ __forceinline__ float br_next(Bracket& B) {
    float c;
    if (B.it % 3 == 2) { const unsigned ka = fkey(B.a), kb = fkey(B.b); if (kb - ka <= 1u) { B.done = true; return B.a; } c = fkey_inv(ka + ((kb - ka) >> 1)); }
    else { c = B.a + (B.b - B.a) * (B.fa / (B.fa - B.fb)); if (!(c > B.a) || !(c < B.b)) c = 0.5f * (B.a + B.b);
           if (!(c > B.a) || !(c < B.b)) { const unsigned ka = fkey(B.a), kb = fkey(B.b); if (kb - ka <= 1u) { B.done = true; return B.a; } c = fkey_inv(ka + ((kb - ka) >> 1)); } }
    ++B.it; if (B.it > 120) B.done = true;
    return c;
}
__device__ __forceinline__ void br_update(Bracket& B, float c, int cnt) {
    const float f = (float)(cnt - 256);
    if (cnt == 256) { B.thr = c; B.done = true; return; }
    if (cnt > 256) { B.a = c; B.fa = f; B.thr = c; if (B.side == 1) B.fb *= 0.5f; B.side = 1; }
    else { B.b = c; B.fb = f; if (B.side == -1) B.fa *= 0.5f; B.side = -1; }
}
__device__ __forceinline__ void select_prompt_load(int row, int lane, const float* __restrict__ sc, float (&v)[32]) {
    const int t = row & (SEQ - 1); const float NINF = -__builtin_inff();
    const int nreg = t < 256 ? 0 : (t >> 6) + 1; const float* sr = sc + (size_t)row * SEQ;
#pragma unroll
    for (int j = 0; j < 32; ++j) { v[j] = NINF; if (j < nreg) { const int s = 64 * j + lane; if (s <= t) v[j] = sr[s]; } }
}
__device__ __forceinline__ void select_prompt_compute(int row, int lane, float (&v)[32], u64* __restrict__ bm, LAS unsigned* hist  ) {
    const int t = row & (SEQ - 1);
    u64 myword = 0ull;
    if (t < 256) {
        const int n = t + 1 - 64 * lane; myword = n >= 64 ? ~0ull : (n > 0 ? ((1ull << n) - 1ull) : 0ull);
    } else {
        const int nreg = (t >> 6) + 1; const float NINF = -__builtin_inff();
        float mx = v[0], mn = v[0];
#pragma unroll
        for (int j = 1; j < 32; ++j) { mx = fmaxf(mx, v[j]); mn = fminf(mn, v[j] == NINF ? __builtin_inff() : v[j]); }
#pragma unroll
        for (int o = 1; o < 64; o <<= 1) { mx = fmaxf(mx, __shfl_xor(mx, o)); mn = fminf(mn, __shfl_xor(mn, o)); }
        mx = __builtin_bit_cast(float, __builtin_amdgcn_readfirstlane(__builtin_bit_cast(int, mx))); mn = __builtin_bit_cast(float, __builtin_amdgcn_readfirstlane(__builtin_bit_cast(int, mn)));
#define CNT_GE(c, dst) do { int cnt_ = 0; _Pragma("unroll") for (int gq = 0; gq < 4; ++gq) if (8 * gq < nreg) { _Pragma("unroll") for (int j = 8 * gq; j < 8 * gq + 8; ++j) cnt_ += __popcll(__ballot(v[j] >= (c))); __builtin_amdgcn_sched_barrier(0); } dst = cnt_; } while (0)
        float thr = mn; bool found = false;
        const float range = mx - mn;
        if (range > 0.f) {
            const float scale = 1023.0f / range;
            LAS u32x4* h4 = (LAS u32x4*)hist;
#pragma unroll
            for (int i = 0; i < 4; ++i) h4[lane * 4 + i] = (u32x4){0u, 0u, 0u, 0u};
            if (lane == 0) hist[1024] = 0u;
            LDS_WAIT();
#pragma unroll
            for (int gq = 0; gq < 4; ++gq) if (8 * gq < nreg) {
#pragma unroll
                for (int j = 8 * gq; j < 8 * gq + 8; ++j) if (v[j] != NINF) { const int bin = (int)((v[j] - mn) * scale); __hip_atomic_fetch_add(hist + bin, 1u, __ATOMIC_RELAXED, __HIP_MEMORY_SCOPE_WORKGROUP); } }
            LDS_WAIT();
            unsigned hb[16];
#pragma unroll
            for (int i = 0; i < 4; ++i) { const u32x4 w = h4[lane * 4 + i]; hb[4 * i] = w.x; hb[4 * i + 1] = w.y; hb[4 * i + 2] = w.z; hb[4 * i + 3] = w.w; }
            unsigned S = 0u;
#pragma unroll
            for (int i = 0; i < 16; ++i) S += hb[i];
            unsigned incl = S;
#pragma unroll
            for (int o = 1; o < 64; o <<= 1) { const unsigned x = __shfl_down(incl, o); if (lane + o < 64) incl += x; }
            const unsigned above = incl - S;
            const bool mine = above < 256u && incl >= 256u;
            int bstar = 0; unsigned cab = 0u, mcount = 0u;
            if (mine) { unsigned run = above; bool got = false;
#pragma unroll
                for (int i = 15; i >= 0; --i) { if (!got) { if (run + hb[i] >= 256u) { got = true; bstar = 16 * lane + i; cab = run; mcount = hb[i]; } else run += hb[i]; } } }
            const u64 mm = __ballot(mine); const int src = (int)__builtin_ctzll(mm | (1ull << 63));
            bstar = __shfl(bstar, src); cab = (unsigned)__shfl((int)cab, src); mcount = (unsigned)__shfl((int)mcount, src);
            const unsigned r = 256u - cab;
            if (mm != 0ull && mcount <= 64u) {
                LAS float* cand = (LAS float*)(hist + 1032);
#pragma unroll
                for (int gq = 0; gq < 4; ++gq) if (8 * gq < nreg) {
#pragma unroll
                    for (int j = 8 * gq; j < 8 * gq + 8; ++j) if (v[j] != NINF && (int)((v[j] - mn) * scale) == bstar) { const unsigned slot = __hip_atomic_fetch_add(hist + 1024, 1u, __ATOMIC_RELAXED, __HIP_MEMORY_SCOPE_WORKGROUP); if (slot < 64u) cand[slot] = v[j]; } }
                LDS_WAIT();
                const float x = (unsigned)lane < mcount ? cand[lane] : NINF; unsigned rank = 0u;
                for (unsigned i = 0; i < mcount; ++i) rank += (cand[i] >= x) ? 1u : 0u;
                float best = ((unsigned)lane < mcount && rank >= r) ? x : NINF;
#pragma unroll
                for (int o = 1; o < 64; o <<= 1) best = fmaxf(best, __shfl_xor(best, o));
                thr = best; found = true;
            }
        }
        if (!found) {
            int chi; CNT_GE(mx, chi);
            Bracket B; br_init(B, mn, mx, t + 1, chi);
#pragma unroll 1
            while (!B.done) { const float c = br_next(B); if (B.done) break; int cnt; CNT_GE(c, cnt); br_update(B, c, cnt); }
            thr = B.thr;
        }
#pragma unroll
        for (int j = 0; j < 32; ++j) { const u64 w = __ballot(v[j] >= thr); if (lane == j) myword = w; if ((j & 7) == 7) __builtin_amdgcn_sched_barrier(0); }
#undef CNT_GE
    }
    if (lane < 32) bm[(size_t)row * 32 + lane] = myword;
}
__device__ __forceinline__ void select_sample_row(int r, int tid, int lane, int wave, const float* __restrict__ ssc, int* __restrict__ sidx, LAS unsigned* red) {
    const int L = PAST + 1 + (r & 3); const float NINF = -__builtin_inff();
    float v[33]; const float* sr = ssc + (size_t)r * SSTR;
#pragma unroll
    for (int j = 0; j < 33; ++j) { const int s = j * 512 + tid; v[j] = s < L ? sr[s] : NINF; }
    LAS float* redf = (LAS float*)red;
    float mx = v[0], mn = v[0];
#pragma unroll
    for (int j = 1; j < 33; ++j) { mx = fmaxf(mx, v[j]); mn = fminf(mn, v[j] == NINF ? __builtin_inff() : v[j]); }
#pragma unroll
    for (int o = 1; o < 64; o <<= 1) { mx = fmaxf(mx, __shfl_xor(mx, o)); mn = fminf(mn, __shfl_xor(mn, o)); }
    if (lane == 0) { redf[32 + wave] = mx; redf[40 + wave] = mn; }
    __syncthreads();
#pragma unroll
    for (int w = 0; w < 8; ++w) { mx = fmaxf(mx, redf[32 + w]); mn = fminf(mn, redf[40 + w]); }
    mx = __builtin_bit_cast(float, __builtin_amdgcn_readfirstlane(__builtin_bit_cast(int, mx))); mn = __builtin_bit_cast(float, __builtin_amdgcn_readfirstlane(__builtin_bit_cast(int, mn)));
    int par = 0;
#define BCNT_GE(c, dst) do { int c_ = 0; _Pragma("unroll") for (int j = 0; j < 33; ++j) c_ += (v[j] >= (c)) ? 1 : 0; _Pragma("unroll") for (int o = 1; o < 64; o <<= 1) c_ += __shfl_xor(c_, o); \
        LAS unsigned* buf_ = red + par * 8; par ^= 1; if (lane == 0) buf_[wave] = (unsigned)c_; __syncthreads(); int tot_ = 0; _Pragma("unroll") for (int w = 0; w < 8; ++w) tot_ += (int)buf_[w]; dst = __builtin_amdgcn_readfirstlane(tot_); } while (0)
    int chi; BCNT_GE(mx, chi);
    Bracket B; br_init(B, mn, mx, L, chi);
#pragma unroll 1
    while (!B.done) { const float c = br_next(B); if (B.done) break; int cnt; BCNT_GE(c, cnt); br_update(B, c, cnt); }
#undef BCNT_GE
    const float thr = B.thr;
    int c = 0;
#pragma unroll
    for (int j = 0; j < 33; ++j) c += (v[j] >= thr) ? 1 : 0;
    int incl = c;
#pragma unroll
    for (int o = 1; o < 64; o <<= 1) { const int x = __shfl_up(incl, o); if (lane >= o) incl += x; }
    __syncthreads();
    if (lane == 63) red[16 + wave] = (unsigned)incl;
    __syncthreads();
    int base = incl - c;
#pragma unroll
    for (int w = 0; w < 8; ++w) if (w < wave) base += (int)red[16 + w];
    int* so = sidx + r * 256;
#pragma unroll
    for (int j = 0; j < 33; ++j) if (v[j] >= thr) { if (base < 256) so[base] = j * 512 + tid; ++base; }
    __syncthreads();
}
struct SsmConst { const float* abar; const float* a32; const bf16_t* bbt; const bf16_t* cmt; };
template <int MODE>
__device__ __forceinline__ void ssm_task(int set, int g, int chunk, int lane, const SsmConst sc, const bf16_t* __restrict__ proj, const float* __restrict__ dvec,
                                         f32x2* __restrict__ SE, const f32x2* __restrict__ SIN, const float* __restrict__ s0re, const float* __restrict__ s0im,
                                         bf16_t* __restrict__ zb, float* __restrict__ ore, float* __restrict__ oim) {
    const int bq = lane & 15, q = lane >> 4; const int b = set * 16 + bq;
    bf16x4 bbt[8];
#pragma unroll
    for (int j = 0; j < 8; ++j) bbt[j] = *(const bf16x4*)(sc.bbt + ((size_t)(g * 128 + 16 * j + bq)) * 16 + 4 * q);
    float ar[16], ai[16], sr[16], si[16];
#pragma unroll
    for (int m = 0; m < 16; ++m) { const f32x2 a = *(const f32x2*)(sc.abar + ((size_t)(g * 64 + 16 * q + m)) * 2); ar[m] = a.x; ai[m] = a.y; sr[m] = 0.f; si[m] = 0.f; }
    bf16x8 cmt[4]; f32x4 dv = {0.f, 0.f, 0.f, 0.f};
    if (MODE != 0) {
#pragma unroll
        for (int j = 0; j < 4; ++j) cmt[j] = *(const bf16x8*)(sc.cmt + ((size_t)(g * 16 + bq)) * 128 + 32 * j + 8 * q);
        dv = *(const f32x4*)(dvec + 16 * g + 4 * q);
    }
    size_t row0; int nstep;
    if (MODE == 2) { row0 = (size_t)TP + 4 * b; nstep = DT;
#pragma unroll
        for (int m = 0; m < 16; ++m) { sr[m] = s0re[((size_t)b * SG + g) * SN + 16 * q + m]; si[m] = s0im[((size_t)b * SG + g) * SN + 16 * q + m]; } }
    else { row0 = (size_t)b * SEQ + (size_t)chunk * SSM_L; nstep = SSM_L;
        if (MODE == 1) {
#pragma unroll
            for (int m = 0; m < 16; ++m) { const f32x2 s = SIN[(((size_t)b * SSM_NCH + chunk) * SG + g) * SN + 16 * q + m]; sr[m] = s.x; si[m] = s.y; } } }
    const bf16_t* up = proj + row0 * INWP + C_U + 16 * g + 4 * q;
    constexpr int UB = 4;
    bf16x4 ub[UB], un[UB];
#pragma unroll
    for (int i = 0; i < UB; ++i) ub[i] = *(const bf16x4*)(up + (size_t)i * INWP);
#pragma unroll 1
    for (int t0 = 0; t0 < nstep; t0 += UB) {
        if (t0 + UB < nstep) {
#pragma unroll
            for (int i = 0; i < UB; ++i) un[i] = *(const bf16x4*)(up + (size_t)(t0 + UB + i) * INWP); }
#pragma unroll
        for (int i = 0; i < UB; ++i) {
            const bf16x4 ucur = ub[i]; const int t = t0 + i;
            f32x4 y = {0.f, 0.f, 0.f, 0.f};
#pragma unroll
            for (int jh = 0; jh < 4; ++jh) {
                const f32x4 bur = __builtin_amdgcn_mfma_f32_16x16x16bf16_1k(bbt[2 * jh], ucur, (f32x4){0.f, 0.f, 0.f, 0.f}, 0, 0, 0);
                const f32x4 bui = __builtin_amdgcn_mfma_f32_16x16x16bf16_1k(bbt[2 * jh + 1], ucur, (f32x4){0.f, 0.f, 0.f, 0.f}, 0, 0, 0);
#pragma unroll
                for (int ii = 0; ii < 4; ++ii) { const int m = 4 * jh + ii; const float nr = ar[m] * sr[m] - ai[m] * si[m] + bur[ii], ni = ar[m] * si[m] + ai[m] * sr[m] + bui[ii]; sr[m] = nr; si[m] = ni; }
                if (MODE != 0) { u32x4 w; w.x = cvt_pk_bf16(sr[4 * jh], sr[4 * jh + 1]); w.y = cvt_pk_bf16(sr[4 * jh + 2], sr[4 * jh + 3]); w.z = cvt_pk_bf16(si[4 * jh], si[4 * jh + 1]); w.w = cvt_pk_bf16(si[4 * jh + 2], si[4 * jh + 3]);
                    y = __builtin_amdgcn_mfma_f32_16x16x32_bf16(cmt[jh], as_bf16x8(w), y, 0, 0, 0); }
            }
            if (MODE != 0) {
                const u32x2 uw = __builtin_bit_cast(u32x2, ucur);
                const f32x4 uf = (f32x4){bf_lo(uw.x), bf_hi(uw.x), bf_lo(uw.y), bf_hi(uw.y)};
                y += dv * uf;
                u32x2 zo; zo.x = cvt_pk_bf16(gelu_tanh(y[0]), gelu_tanh(y[1])); zo.y = cvt_pk_bf16(gelu_tanh(y[2]), gelu_tanh(y[3]));
                *(u32x2*)(zb + (row0 + t) * SSMW + 16 * g + 4 * q) = zo;
            }
            __builtin_amdgcn_sched_barrier(0);
        }
#pragma unroll
        for (int i = 0; i < UB; ++i) ub[i] = un[i];
    }
    if (MODE == 0) {
        f32x2* e = SE + (((size_t)b * SSM_NCH + chunk) * SG + g) * SN + 16 * q;
#pragma unroll
        for (int m = 0; m < 16; ++m) e[m] = (f32x2){sr[m], si[m]};
    }
    if (MODE == 2) {
#pragma unroll
        for (int m = 0; m < 16; ++m) { ore[((size_t)b * SG + g) * SN + 16 * q + m] = sr[m]; oim[((size_t)b * SG + g) * SN + 16 * q + m] = si[m]; }
    }
}
__device__ __forceinline__ void ssm_carry(int idx  , const float* __restrict__ a32, const f32x2* __restrict__ SE, f32x2* __restrict__ SIN, float* __restrict__ ore, float* __restrict__ oim) {
    const int b = idx >> 11, gn = idx & 2047;
    const f32x2 a = *(const f32x2*)(a32 + (size_t)gn * 2);
    float sr = 0.f, si = 0.f;
#pragma unroll 1
    for (int jb = 0; jb < SSM_NCH; jb += 16) {
        f32x2 e[16];
#pragma unroll
        for (int i = 0; i < 16; ++i) e[i] = SE[((size_t)b * SSM_NCH + jb + i) * (SG * SN) + gn];
#pragma unroll
        for (int i = 0; i < 16; ++i) { SIN[((size_t)b * SSM_NCH + jb + i) * (SG * SN) + gn] = (f32x2){sr, si}; const float nr = a.x * sr - a.y * si + e[i].x, ni = a.x * si + a.y * sr + e[i].y; sr = nr; si = ni; }
    }
    ore[(size_t)b * (SG * SN) + gn] = sr; oim[(size_t)b * (SG * SN) + gn] = si;
}
__device__ __forceinline__ void ssm_constants(int e, const float* __restrict__ a_re, const float* __restrict__ a_im, const float* __restrict__ log_dt, const float* __restrict__ b_re, const float* __restrict__ b_im,
                                              const float* __restrict__ c_re, const float* __restrict__ c_im, unsigned char* __restrict__ ssc) {
    const int gn = e >> 5, ri = (e >> 4) & 1, c = e & 15;
    const int g = gn >> 6, n = gn & 63;
    double dt, dum; cexp_d((double)log_dt[g], 0.0, 10, dt, dum);
    const double lr = (double)a_re[gn], li = (double)a_im[gn];
    double abr, abi; cexp_d(lr * dt, li * dt, 10, abr, abi);
    const double den = lr * lr + li * li;
    const double fr = ((abr - 1.0) * lr + abi * li) / den, fi = (abi * lr - (abr - 1.0) * li) / den;
    if ((e & 31) == 0) {
        double p32r = abr, p32i = abi;
#pragma unroll 1
        for (int i = 0; i < 5; ++i) { const double nr = p32r * p32r - p32i * p32i, ni = 2.0 * p32r * p32i; p32r = nr; p32i = ni; }
        float* ab = (float*)(ssc + SSC_ABAR) + (size_t)gn * 2; ab[0] = (float)abr; ab[1] = (float)abi;
        float* a3 = (float*)(ssc + SSC_A32) + (size_t)gn * 2; a3[0] = (float)p32r; a3[1] = (float)p32i;
    }
    bf16_t* bbt = (bf16_t*)(ssc + SSC_BBT); bf16_t* cmt = (bf16_t*)(ssc + SSC_CMT);
    const int qq = n >> 4, jh = (n >> 2) & 3, i = n & 3;
    const int rowl = 16 * (2 * jh + ri) + 4 * qq + i;
    const int kap = 32 * jh + 8 * qq + 4 * ri + i;
    const double br = (double)b_re[(size_t)gn * 16 + c], bi = (double)b_im[(size_t)gn * 16 + c];
    const double v = ri == 0 ? (fr * br - fi * bi) : (fr * bi + fi * br);
    bbt[((size_t)g * 128 + rowl) * 16 + c] = (bf16_t)(cvt_pk_bf16((float)v, 0.f) & 0xffffu);
    const float cv = ri == 0 ? c_re[((size_t)g * 16 + c) * 64 + n] : -c_im[((size_t)g * 16 + c) * 64 + n];
    cmt[((size_t)g * 16 + c) * 128 + kap] = (bf16_t)(cvt_pk_bf16(cv, 0.f) & 0xffffu);
}
namespace att {
constexpr int D = 128, NW = 8, QBLK = 32, KVBLK = 64, QB = NW * QBLK;
constexpr int SHM_V = KVBLK * D * 2, SHM_K = KVBLK * D * 2;
constexpr int LDS_BYTES_ATT = 2 * SHM_V + 2 * SHM_K + NW * 64 * 4;
constexpr int QS = 1024, KS = 256, VS = INWP;
constexpr float SCALE = 0.08838834764831845f, THR = 8.f;
#define KSWZ(row, colB) ((row) * 256 + ((colB) ^ (((row) & 7) << 4)))
#define SBAR() __builtin_amdgcn_sched_barrier(0)
__device__ __forceinline__ int v_st(int k, int c) { const int kk = (k & ~0xC) | ((k & 4) << 1) | ((k & 8) >> 1); return ((kk >> 3) * 4 + (c >> 5)) * 512 + ((kk & 7) * 32 + (c & 31)) * 2; }
__device__ __forceinline__ int v_rd_base(int lane) { return ((lane & 3) << 3) | (((lane >> 2) & 3) << 6) | (((lane >> 4) & 1) << 5) | (((lane >> 5) & 1) << 8); }
constexpr int v_rd_off(int d0, int ks, int half) { return d0 * 512 + ks * 4096 + half * 2048; }
__device__ __forceinline__ int crow(int r, int hi) { return (r & 3) + 8 * (r >> 2) + 4 * hi; }
__device__ __forceinline__ bf16x8 load8(const bf16_t* p) { return *reinterpret_cast<const bf16x8*>(p); }
__device__ __forceinline__ void mask_bits(f32x16& p0, f32x16& p1, u64 w, int hi) {
    const float NEG = -__builtin_inff();
    const unsigned lo = (unsigned)w >> (4 * hi), hh = (unsigned)(w >> 32) >> (4 * hi);
#pragma unroll
    for (int r = 0; r < 16; ++r) {
        const int c = (r & 3) + 8 * (r >> 2);
        if (!((lo >> c) & 1u)) p0[r] = NEG;
        if (!((hh >> c) & 1u)) p1[r] = NEG;
    }
}
__device__ __forceinline__ void partialSM(f32x16& p0, f32x16& p1, float& m_reg, float& mn, float& alpha) {
    float pmax = p0[0]; for (int r = 1; r < 16; ++r) pmax = fmaxf(pmax, p0[r]); for (int r = 0; r < 16; ++r) pmax = fmaxf(pmax, p1[r]);
    { auto rr = __builtin_amdgcn_permlane32_swap(__float_as_uint(pmax), __float_as_uint(pmax), false, false);
      pmax = fmaxf(__uint_as_float(rr[0]), __uint_as_float(rr[1])); }
    constexpr float C2 = 1.4426950408889634f * SCALE;
    if (__builtin_expect(__all((pmax - m_reg) * SCALE <= THR), 1)) { mn = m_reg; alpha = 1.f; }
    else { mn = fmaxf(m_reg, pmax); alpha = __builtin_amdgcn_exp2f((m_reg - mn) * C2); m_reg = mn; }
    const float mnL = -mn * C2;
    for (int r = 0; r < 16; ++r) p0[r] = fmaf(p0[r], C2, mnL); for (int r = 0; r < 16; ++r) p1[r] = fmaf(p1[r], C2, mnL);
    for (int r = 0; r < 16; ++r) p0[r] = __builtin_amdgcn_exp2f(p0[r]);
}
__device__ __forceinline__ void finishSM(f32x16& p0, f32x16& p1, float alpha, float& l_reg, bf16x8& pa0, bf16x8& pa1, bf16x8& pa2, bf16x8& pa3) {
    for (int r = 0; r < 16; ++r) p1[r] = __builtin_amdgcn_exp2f(p1[r]);
    float ps = 0; for (int r = 0; r < 16; ++r) ps += p0[r]; for (int r = 0; r < 16; ++r) ps += p1[r];
    { auto rr = __builtin_amdgcn_permlane32_swap(__float_as_uint(ps), __float_as_uint(ps), false, false);
      ps = __uint_as_float(rr[0]) + __uint_as_float(rr[1]); }
    l_reg = l_reg * alpha + ps;
#define PK4(P, B_, OUT) do { unsigned a0 = cvt_pk_bf16(P[B_+0], P[B_+1]), a1 = cvt_pk_bf16(P[B_+2], P[B_+3]);                          \
        unsigned b0 = cvt_pk_bf16(P[B_+4], P[B_+5]), b1 = cvt_pk_bf16(P[B_+6], P[B_+7]);                                             \
        auto r0 = __builtin_amdgcn_permlane32_swap(a0, b0, false, false); auto r1 = __builtin_amdgcn_permlane32_swap(a1, b1, false, false); \
        u32x4 w = {r0[0], r1[0], r0[1], r1[1]}; OUT = *reinterpret_cast<bf16x8*>(&w); } while (0)
    PK4(p0, 0, pa0); PK4(p0, 8, pa1); PK4(p1, 0, pa2); PK4(p1, 8, pa3);
#undef PK4
}
template <int KB>
__device__ __forceinline__ void qkt(f32x16& p0, f32x16& p1, const char* K_lds, int r32, int hi, const bf16x8* qr) {
    p0 = f32x16{}; p1 = f32x16{};
    const char* kb[4];
#pragma unroll
    for (int dd = 0; dd < 4; ++dd) kb[dd] = K_lds + KB * SHM_K + KSWZ(r32, (dd * 16 + hi * 8) * 2);
#pragma unroll
    for (int d0 = 0; d0 < 8; ++d0) { const char* a = kb[d0 & 3] + (d0 >> 2) * 128;
        bf16x8 b0 = *reinterpret_cast<const bf16x8*>(a);
        bf16x8 b1 = *reinterpret_cast<const bf16x8*>(a + 32 * 256);
        p0 = __builtin_amdgcn_mfma_f32_32x32x16_bf16(b0, qr[d0], p0, 0, 0, 0);
        p1 = __builtin_amdgcn_mfma_f32_32x32x16_bf16(b1, qr[d0], p1, 0, 0, 0); }
}
typedef short s16x4 __attribute__((ext_vector_type(4)));
template <int VB>
__device__ __forceinline__ void pv_tile(f32x16* o, int vb0, bf16x8 pa0, bf16x8 pa1, bf16x8 pa2, bf16x8 pa3) {
#define TRRD(dst, off) asm volatile("ds_read_b64_tr_b16 %0, %1 offset:%2" : "=&v"(dst) : "v"(vb0), "i"(off) : "memory")
#define PV_D0(d0) do { s16x4 l0, l1, l2, l3, h0, h1, h2, h3; constexpr int b_ = VB * SHM_V + v_rd_off(d0, 0, 0); \
        TRRD(l0, b_); TRRD(h0, b_ + 2048); TRRD(l1, b_ + 4096); TRRD(h1, b_ + 6144); TRRD(l2, b_ + 8192); TRRD(h2, b_ + 10240); TRRD(l3, b_ + 12288); TRRD(h3, b_ + 14336); \
        asm volatile("s_waitcnt lgkmcnt(0)" ::: "memory"); SBAR();   \
        o[d0] = __builtin_amdgcn_mfma_f32_32x32x16_bf16(pa0, (bf16x8){l0[0], l0[1], l0[2], l0[3], h0[0], h0[1], h0[2], h0[3]}, o[d0], 0, 0, 0);   \
        o[d0] = __builtin_amdgcn_mfma_f32_32x32x16_bf16(pa1, (bf16x8){l1[0], l1[1], l1[2], l1[3], h1[0], h1[1], h1[2], h1[3]}, o[d0], 0, 0, 0);   \
        o[d0] = __builtin_amdgcn_mfma_f32_32x32x16_bf16(pa2, (bf16x8){l2[0], l2[1], l2[2], l2[3], h2[0], h2[1], h2[2], h2[3]}, o[d0], 0, 0, 0);   \
        o[d0] = __builtin_amdgcn_mfma_f32_32x32x16_bf16(pa3, (bf16x8){l3[0], l3[1], l3[2], l3[3], h3[0], h3[1], h3[2], h3[3]}, o[d0], 0, 0, 0); } while (0)
    PV_D0(0); PV_D0(1); PV_D0(2); PV_D0(3);
#undef PV_D0
#undef TRRD
}
struct BlockRef { const bf16_t* Q; const bf16_t* K; const bf16_t* V; bf16_t* O; const u64* MB; int P0; };
struct Seam { bf16x8 qr[8]; bf16x8 st_v0, st_v1, st_k0, st_k1; };
#define ROWK(p, k0, rr) ((p) + (size_t)((k0) + (rr)) * KS + sc)
#define ROWV(p, k0, rr) ((p) + (size_t)((k0) + (rr)) * VS + sc)
#define VMW() asm volatile("s_waitcnt vmcnt(0)" ::: "memory")
#define VMWN(n) asm volatile("s_waitcnt vmcnt(%0)" :: "i"(n) : "memory")
#define SLOAD_H(Kp, Vp, k0) do { S.st_v0 = load8(ROWV(Vp, k0, sr)); S.st_v1 = load8(ROWV(Vp, k0, 32 + sr));              \
                         S.st_k0 = load8(ROWK(Kp, k0, sr)); S.st_k1 = load8(ROWK(Kp, k0, 32 + sr)); } while (0)
#define SWRITE_HK(bf) do { *(bf16x8*)(K_lds + (bf) * SHM_K + kws) = S.st_k0; *(bf16x8*)(K_lds + (bf) * SHM_K + kws + 32 * 256) = S.st_k1; } while (0)
#define SWRITE_HV(bf) do { *(bf16x8*)(V_lds + (bf) * SHM_V + vst0) = S.st_v0; *(bf16x8*)(V_lds + (bf) * SHM_V + vst1) = S.st_v1; } while (0)
#define SWRITE_H(bf) do { SWRITE_HV(bf); SWRITE_HK(bf); } while (0)
__device__ __forceinline__ void attn_prime(const BlockRef& cur, char* lds, Seam& S, int wid) {
    const int lane = lane_id_(), tid = wid * 64 + lane, r32 = lane & 31, hi = lane >> 5;
    const int sr = tid >> 4, sc = (tid & 15) * 8, kws = KSWZ(sr, sc * 2); char* K_lds = lds + 2 * SHM_V;
    for (int d0 = 0; d0 < 8; ++d0) S.qr[d0] = load8(cur.Q + (size_t)(wid * QBLK + r32) * QS + d0 * 16 + hi * 8);
    SLOAD_H(cur.K, cur.V, 0); VMW(); SWRITE_HK(0);
    __syncthreads();
}
__device__ __forceinline__ void attn_block(const BlockRef& cur, const BlockRef& nxt, char* lds, Seam& S, int wid) {
    const int lane = lane_id_(), tid = wid * 64 + lane, r32 = lane & 31, hi = lane >> 5;
    const int NT = cur.P0 / KVBLK + QB / KVBLK;
    char* V_lds = lds; char* K_lds = lds + 2 * SHM_V;
    float* ws = (float*)(lds + 2 * SHM_V + 2 * SHM_K) + wid * 64; float* li_l = ws, * al_l = ws + 32;
    float m_reg = -1e30f, l_reg = 0; f32x16 o[4] = {};
    const int sr = tid >> 4, sc = (tid & 15) * 8, vst0 = v_st(sr, sc), vst1 = v_st(32 + sr, sc), kws = KSWZ(sr, sc * 2);
    const int vb0 = (int)(uintptr_t)V_lds + v_rd_base(lane);
    const bf16_t* Kh = cur.K; const bf16_t* Vh = cur.V;
    const u64* mrow = cur.MB + (size_t)(wid * QBLK + r32) * 32;
    u64 mw;
#define RESC(a) do { if (__any((a) < 1.f)) { if (hi == 0) al_l[r32] = (a); asm volatile("s_waitcnt lgkmcnt(0)" ::: "memory");              \
                     for (int d_ = 0; d_ < 4; ++d_) for (int r = 0; r < 16; ++r) o[d_][r] *= al_l[crow(r, hi)]; } } while (0)
#define KBASE(t) ((t) * KVBLK)
    constexpr int NQL = 8;
#define SEAM_K0() do { VMWN(NQL); SWRITE_HK(0); SBAR(); } while (0)
    f32x16 pA0, pA1, pB0, pB1; float mnA, mnB, alA, alB; bf16x8 pa0, pa1, pa2, pa3;
    SWRITE_HV(0); SBAR();
    if (NT > 1) { SLOAD_H(Kh, Vh, KBASE(1)); }
    mw = mrow[0];
    SBAR(); qkt<0>(pA0, pA1, K_lds, r32, hi, S.qr);
    mask_bits(pA0, pA1, mw, hi); partialSM(pA0, pA1, m_reg, mnA, alA);
    if (NT > 1) { VMW(); SWRITE_H(1); }
    __syncthreads();
#define HALF_STEP(PX0, PX1, mnX, alX, PY0, PY1, alY, t, KB, VB, SB) do {                                                      \
        SBAR(); mw = mrow[(t)]; qkt<KB>(PX0, PX1, K_lds, r32, hi, S.qr);                                             \
        finishSM(PY0, PY1, alY, l_reg, pa0, pa1, pa2, pa3); SBAR();                                                           \
        if ((t) + 1 < NT) { SLOAD_H(Kh, Vh, KBASE((t) + 1)); SBAR(); }                                               \
        pv_tile<VB>(o, vb0, pa0, pa1, pa2, pa3); mask_bits(PX0, PX1, mw, hi); partialSM(PX0, PX1, m_reg, mnX, alX);                                        \
        __syncthreads();                                                                                                      \
        if ((t) + 1 < NT) { VMW(); SWRITE_H(SB); }                                                                          \
        RESC(alX); __syncthreads(); } while (0)
    for (int t = 1; t + 1 < NT; t += 2) {
        HALF_STEP(pB0, pB1, mnB, alB, pA0, pA1, alA, t, 1, 0, 0);
        HALF_STEP(pA0, pA1, mnA, alA, pB0, pB1, alB, t + 1, 0, 1, 1);
    }
    SBAR(); mw = mrow[NT - 1]; qkt<1>(pB0, pB1, K_lds, r32, hi, S.qr); SBAR();
    SLOAD_H(nxt.K, nxt.V, 0); SBAR();
#pragma unroll
    for (int d0 = 0; d0 < 8; ++d0) S.qr[d0] = load8(nxt.Q + (size_t)(wid * QBLK + r32) * QS + d0 * 16 + hi * 8);
    SBAR();
    finishSM(pA0, pA1, alA, l_reg, pa0, pa1, pa2, pa3); SBAR();
    pv_tile<0>(o, vb0, pa0, pa1, pa2, pa3);
    mask_bits(pB0, pB1, mw, hi); partialSM(pB0, pB1, m_reg, mnB, alB); __syncthreads(); RESC(alB);
    finishSM(pB0, pB1, alB, l_reg, pa0, pa1, pa2, pa3); SBAR(); pv_tile<1>(o, vb0, pa0, pa1, pa2, pa3);
    SBAR(); SEAM_K0();
    if (hi == 0) li_l[r32] = l_reg; asm volatile("s_waitcnt lgkmcnt(0)" ::: "memory");
    float rli[16];
#pragma unroll
    for (int r = 0; r < 16; ++r) rli[r] = __builtin_amdgcn_rcpf(li_l[crow(r, hi)]);
    bf16_t* Ow = cur.O + (size_t)(wid * QBLK) * QS;
#pragma unroll
    for (int r = 0; r < 16; ++r) { const int orow = crow(r, hi);
#pragma unroll
        for (int d0 = 0; d0 < 4; ++d0) { const float v = o[d0][r] * rli[r];
            const float vn = __shfl_xor(v, 1);
            if ((r32 & 1) == 0) *(unsigned*)(Ow + (size_t)orow * QS + d0 * 32 + r32) = cvt_pk_bf16(v, vn); } }
    __syncthreads();
#undef RESC
#undef KBASE
#undef SEAM_K0
#undef HALF_STEP
}
#undef ROWK
#undef ROWV
#undef VMW
#undef VMWN
#undef SLOAD_H
#undef SWRITE_HK
#undef SWRITE_HV
#undef SWRITE_H
#undef KSWZ
}
__device__ __forceinline__ void sample_attn_unit(int u, int tid, int lane, int wave, LAS unsigned char* lds, const bf16_t* __restrict__ qn, const int* __restrict__ sidx, const int* __restrict__ pt,
                                                 const float* __restrict__ ck, const float* __restrict__ cv, const float* __restrict__ out, bf16_t* __restrict__ oatt) {
    const int b = u >> 3, t = (u >> 1) & 3, kvh = u & 1; const size_t row = (size_t)TP + 4 * b + t;
    LAS unsigned char* kv = lds; LAS int* lidx = (LAS int*)(lds + 69632); LAS float* lq = (LAS float*)(lds + 70656); LAS float* lp = (LAS float*)(lds + 72704);
    LAS float* lred = (LAS float*)(lds + 76800); LAS float* lo2 = (LAS float*)(lds + 77056);
    if (tid < 256) { const int idx = sidx[(b * 4 + t) * 256 + tid]; lidx[tid] = idx < PAST ? pt[b * NPG + (idx >> 7)] * PAGE + (idx & 127) : -(1 + idx - PAST); }
    lq[tid] = bf2f(qn[row * 1024 + kvh * 512 + tid]);
    __syncthreads();
    { f32x2 kvv[32];
#pragma unroll
      for (int kk = 0; kk < 32; ++kk) { const int pr = lidx[wave * 32 + kk];
          const float* src = pr >= 0 ? ck + ((size_t)pr * 2 + kvh) * 128 : out + O_KS + ((size_t)(b * 4 - 1 - pr) * 2 + kvh) * 128;
          kvv[kk] = *(const f32x2*)(src + 2 * lane); }
#pragma unroll
      for (int kk = 0; kk < 32; ++kk) *(LAS unsigned*)(kv + (wave * 32 + kk) * 272 + 4 * lane) = cvt_pk_bf16(kvv[kk].x, kvv[kk].y); }
    __syncthreads();
    const int key = tid & 255, hp = tid >> 8;
    float s0 = 0.f, s1 = 0.f;
    { const LAS unsigned char* kr = kv + key * 272; const LAS float* q0 = lq + (2 * hp) * 128; const LAS float* q1 = q0 + 128;
#pragma unroll
      for (int c = 0; c < 16; ++c) { const u32x4 w = *(const LAS u32x4*)(kr + 16 * c); f32x4 a, bb; unpack8(w, a, bb);
          const f32x4 qa = *(const LAS f32x4*)(q0 + 8 * c), qb = *(const LAS f32x4*)(q0 + 8 * c + 4), ra = *(const LAS f32x4*)(q1 + 8 * c), rb = *(const LAS f32x4*)(q1 + 8 * c + 4);
          s0 += (a[0] * qa[0] + a[1] * qa[1]) + (a[2] * qa[2] + a[3] * qa[3]) + (bb[0] * qb[0] + bb[1] * qb[1]) + (bb[2] * qb[2] + bb[3] * qb[3]);
          s1 += (a[0] * ra[0] + a[1] * ra[1]) + (a[2] * ra[2] + a[3] * ra[3]) + (bb[0] * rb[0] + bb[1] * rb[1]) + (bb[2] * rb[2] + bb[3] * rb[3]); } }
    s0 *= 0.08838834764831845f; s1 *= 0.08838834764831845f;
    float m0 = s0, m1 = s1;
#pragma unroll
    for (int o = 1; o < 64; o <<= 1) { m0 = fmaxf(m0, __shfl_xor(m0, o)); m1 = fmaxf(m1, __shfl_xor(m1, o)); }
    if (lane == 0) { lred[wave * 2] = m0; lred[wave * 2 + 1] = m1; }
    __syncthreads();
    { const int w0 = hp * 4; m0 = fmaxf(fmaxf(lred[w0 * 2], lred[w0 * 2 + 2]), fmaxf(lred[w0 * 2 + 4], lred[w0 * 2 + 6])); m1 = fmaxf(fmaxf(lred[w0 * 2 + 1], lred[w0 * 2 + 3]), fmaxf(lred[w0 * 2 + 5], lred[w0 * 2 + 7])); }
    const float p0 = __expf(s0 - m0), p1 = __expf(s1 - m1);
    lp[(2 * hp) * 256 + key] = p0; lp[(2 * hp + 1) * 256 + key] = p1;
    const float t0 = wave_sum(p0), t1 = wave_sum(p1);
    if (lane == 0) { lred[16 + wave * 2] = t0; lred[16 + wave * 2 + 1] = t1; }
    __syncthreads();
    { f32x2 kvv[32];
#pragma unroll
      for (int kk = 0; kk < 32; ++kk) { const int pr = lidx[wave * 32 + kk];
          const float* src = pr >= 0 ? cv + ((size_t)pr * 2 + kvh) * 128 : out + O_VS + ((size_t)(b * 4 - 1 - pr) * 2 + kvh) * 128;
          kvv[kk] = *(const f32x2*)(src + 2 * lane); }
#pragma unroll
      for (int kk = 0; kk < 32; ++kk) *(LAS unsigned*)(kv + (wave * 32 + kk) * 256 + 4 * lane) = cvt_pk_bf16(kvv[kk].x, kvv[kk].y); }
    __syncthreads();
    const int dp = lane, head = wave & 3, kh = wave >> 2;
    float o0 = 0.f, o1 = 0.f;
#pragma unroll 8
    for (int k = kh * 128; k < kh * 128 + 128; ++k) { const unsigned w = *(const LAS unsigned*)(kv + k * 256 + 4 * dp); const float p = lp[head * 256 + k]; o0 += p * bf_lo(w); o1 += p * bf_hi(w); }
    if (kh == 1) { lo2[head * 128 + 2 * dp] = o0; lo2[head * 128 + 2 * dp + 1] = o1; }
    __syncthreads();
    if (kh == 0) { const int hq = head >> 1, hb = head & 1; const int w0 = hq * 4;
        const float sum = (lred[16 + w0 * 2 + hb] + lred[16 + w0 * 2 + 2 + hb]) + (lred[16 + w0 * 2 + 4 + hb] + lred[16 + w0 * 2 + 6 + hb]);
        const float inv = 1.0f / sum; o0 = (o0 + lo2[head * 128 + 2 * dp]) * inv; o1 = (o1 + lo2[head * 128 + 2 * dp + 1]) * inv;
        *(unsigned*)(oatt + row * 1024 + (kvh * 4 + head) * 128 + 2 * dp) = cvt_pk_bf16(o0, o1); }
    __syncthreads();
}
__device__ __forceinline__ void ld8bf(const bf16_t* p, float (&v)[8]) { const u32x4 a = __builtin_nontemporal_load((const u32x4*)p); v[0] = bf_lo(a.x); v[1] = bf_hi(a.x); v[2] = bf_lo(a.y); v[3] = bf_hi(a.y); v[4] = bf_lo(a.z); v[5] = bf_hi(a.z); v[6] = bf_lo(a.w); v[7] = bf_hi(a.w); }
__device__ __forceinline__ void ld8f(const float* p, float (&v)[8]) { const f32x4 a = *(const f32x4*)p, b = *(const f32x4*)(p + 4); v[0] = a.x; v[1] = a.y; v[2] = a.z; v[3] = a.w; v[4] = b.x; v[5] = b.y; v[6] = b.z; v[7] = b.w; }
__device__ __forceinline__ void st8f(float* p, const float (&v)[8]) { *(f32x4*)p = (f32x4){v[0], v[1], v[2], v[3]}; *(f32x4*)(p + 4) = (f32x4){v[4], v[5], v[6], v[7]}; }
__device__ __forceinline__ void conv_item(int rblk, int cg, int lane, const bf16_t* __restrict__ up, bf16_t* __restrict__ act, const float* __restrict__ cw, const float* __restrict__ cb,
                                          const float* __restrict__ sconv, float* __restrict__ out) {
    const int col = 512 * cg + 8 * lane; if (col >= DFF) return;
    float wg[3][8], wv[3][8], bg[8], bv[8], g2[8], g1[8], v2[8], v1[8];
#pragma unroll
    for (int j = 0; j < 3; ++j) { ld8f(cw + (size_t)j * DFF2 + col, wg[j]); ld8f(cw + (size_t)j * DFF2 + DFF + col, wv[j]); }
    ld8f(cb + col, bg); ld8f(cb + DFF + col, bv);
    size_t row0; int nrows; int tbase; int b; const bool samp = rblk >= 512;
    if (!samp) { b = rblk >> 5; tbase = (rblk & 31) * 64; row0 = (size_t)b * SEQ + tbase; nrows = 64;
        if (tbase == 0) {
#pragma unroll
            for (int e = 0; e < 8; ++e) { g2[e] = 0.f; g1[e] = 0.f; v2[e] = 0.f; v1[e] = 0.f; } }
        else { ld8bf(up + (row0 - 2) * DFF2 + col, g2); ld8bf(up + (row0 - 1) * DFF2 + col, g1); ld8bf(up + (row0 - 2) * DFF2 + DFF + col, v2); ld8bf(up + (row0 - 1) * DFF2 + DFF + col, v1); } }
    else { b = rblk - 512; tbase = 0; row0 = (size_t)TP + 4 * b; nrows = 4;
        ld8f(sconv + ((size_t)b * 2 + 0) * DFF2 + col, g2); ld8f(sconv + ((size_t)b * 2 + 1) * DFF2 + col, g1); ld8f(sconv + ((size_t)b * 2 + 0) * DFF2 + DFF + col, v2); ld8f(sconv + ((size_t)b * 2 + 1) * DFF2 + DFF + col, v1); }
#pragma unroll 2
    for (int r = 0; r < nrows; ++r) {
        float gc[8], vc[8], a[8];
        ld8bf(up + (row0 + r) * DFF2 + col, gc); ld8bf(up + (row0 + r) * DFF2 + DFF + col, vc);
#pragma unroll
        for (int e = 0; e < 8; ++e) { const float cgt = wg[0][e] * g2[e] + wg[1][e] * g1[e] + wg[2][e] * gc[e] + bg[e]; const float cvl = wv[0][e] * v2[e] + wv[1][e] * v1[e] + wv[2][e] * vc[e] + bv[e]; a[e] = gelu_tanh(cgt) * cvl; }
        u32x4 w; w.x = cvt_pk_bf16(a[0], a[1]); w.y = cvt_pk_bf16(a[2], a[3]); w.z = cvt_pk_bf16(a[4], a[5]); w.w = cvt_pk_bf16(a[6], a[7]);
        __builtin_nontemporal_store(w, (u32x4*)(act + (row0 + r) * DFF + col));
        const int t = tbase + r;
        if (!samp && t >= SEQ - 2) { float* o = out + O_CVP + ((size_t)b * 2 + (t - (SEQ - 2))) * DFF2; st8f(o + col, gc); st8f(o + DFF + col, vc); }
        if (samp && t >= DT - 2) { float* o = out + O_CVS + ((size_t)b * 2 + (t - (DT - 2))) * DFF2; st8f(o + col, gc); st8f(o + DFF + col, vc); }
#pragma unroll
        for (int e = 0; e < 8; ++e) { g2[e] = g1[e]; g1[e] = gc[e]; v2[e] = v1[e]; v1[e] = vc[e]; }
    }
}
constexpr int NPH = 13;
#ifndef MK_REP
#define MK_REP {1,1,1,1,1,1,1,1,1,1,1,1,1}
#endif
__device__ constexpr int kRep[NPH] = MK_REP;
#ifndef MK_N_LAUNCHES
#define MK_N_LAUNCHES 1
#endif
#ifndef MUL_TA
#define MUL_TA 1
#endif
#ifndef MUL_SSMA
#define MUL_SSMA 1
#endif
#ifndef MUL_SEL
#define MUL_SEL 1
#endif
#ifndef MUL_SSMC
#define MUL_SSMC 1
#endif
#ifndef MUL_ATT
#define MUL_ATT 1
#endif
#ifndef MUL_SATT
#define MUL_SATT 1
#endif
#ifndef MUL_CONV
#define MUL_CONV 1
#endif
#ifndef MUL_IDXP
#define MUL_IDXP 1
#endif
#ifndef MUL_IDXS
#define MUL_IDXS 1
#endif
#ifndef MUL_CARRY
#define MUL_CARRY 1
#endif
#define WS_PTRS const int lane = lane_id_(); const int tid = wave * 64 + lane; (void)tid; GAS unsigned char* wsg_ = (GAS unsigned char*)ws; asm volatile("" : "+s"(wsg_)); unsigned char* wsl_ = (unsigned char*)wsg_;     float* RT = (float*)(wsl_ + WS_RT); unsigned char* SSC = ws + WS_SSC; bf16_t* WIN = (bf16_t*)(wsl_ + WS_WIN); bf16_t* WGLU = (bf16_t*)(wsl_ + WS_WGLU); bf16_t* WATT = (bf16_t*)(wsl_ + WS_WATT); bf16_t* WSSM = (bf16_t*)(wsl_ + WS_WSSM); bf16_t* WO = (bf16_t*)(wsl_ + WS_WO); bf16_t* WUP = (bf16_t*)(wsl_ + WS_WUP); bf16_t* WDN = (bf16_t*)(wsl_ + WS_WDN); bf16_t* WPLE = (bf16_t*)(wsl_ + WS_WPLE); bf16_t* WPG = (bf16_t*)(wsl_ + WS_WPG); bf16_t* H = (bf16_t*)(wsl_ + WS_H); bf16_t* PBF = (bf16_t*)(wsl_ + WS_PBF); bf16_t* PLER = (bf16_t*)(wsl_ + WS_PLER); float* RS0 = (float*)(wsl_ + WS_RSP); float* SSQ1 = (float*)(wsl_ + WS_RSP + 262144); float* SSQ2 = (float*)(wsl_ + WS_RSP + 524288); float* SSQP = (float*)(wsl_ + WS_RSP + 786432); bf16_t* PROJ = (bf16_t*)(wsl_ + WS_PROJ); bf16_t* QN = (bf16_t*)(wsl_ + WS_QN); bf16_t* KN = (bf16_t*)(wsl_ + WS_KN); bf16_t* VB = (bf16_t*)(wsl_ + WS_VB); bf16_t* IQ = (bf16_t*)(wsl_ + WS_IQ); bf16_t* IKR = (bf16_t*)(wsl_ + WS_IKR); float* IW = (float*)(wsl_ + WS_IW); float* SC = (float*)(wsl_ + WS_SC); float* SSC2 = (float*)(wsl_ + WS_SSC2); u64* BMK = (u64*)(wsl_ + WS_BM); int* SIDX = (int*)(wsl_ + WS_SIDX); bf16_t* OATT = (bf16_t*)(wsl_ + WS_OATT); bf16_t* Z = (bf16_t*)(wsl_ + WS_Z); bf16_t* Z2 = (bf16_t*)(wsl_ + WS_Z2); f32x2* SE = (f32x2*)(wsl_ + WS_SE); f32x2* SIN = (f32x2*)(wsl_ + WS_SIN); bf16_t* MRG = (bf16_t*)(wsl_ + WS_MRG); unsigned char* G8 = wsl_ + WS_G8; unsigned char* T8 = wsl_ + WS_T8; bf16_t* UP = (bf16_t*)(wsl_ + WS_UP); bf16_t* ACT = (bf16_t*)(wsl_ + WS_ACT); const SsmConst sscn{(const float*)(SSC + SSC_ABAR), (const float*)(SSC + SSC_A32), (const bf16_t*)(SSC + SSC_BBT), (const bf16_t*)(SSC + SSC_CMT)};
#ifndef WGM_IN
#define WGM_IN 3
#endif
#ifndef WGM_UP
#define WGM_UP 3
#endif
#ifndef WGM_DN
#define WGM_DN 3
#endif
#ifndef WGM_PG
#define WGM_PG 3
#endif
struct Args { const void* in[36]; float* out; unsigned char* ws; int ph_lo, ph_hi, bar_region, pad; };

__global__ void __launch_bounds__(NWAVES * 64, 2) fwd(Args args) {
    extern __shared__ __attribute__((aligned(16))) unsigned char lds_raw[];
    LAS unsigned char* lds = (LAS unsigned char*)lds_raw;
    const int wave = __builtin_amdgcn_readfirstlane((int)threadIdx.x >> 6);
    const int G = gridDim.x; const int bx = blockIdx.x; const int vcu = (G % 8 == 0) ? (bx % 8) * (G / 8) + bx / 8 : bx;
    const int gw = vcu * NWAVES + wave, NGW = G * NWAVES;
    unsigned char* ws = args.ws; float* out = args.out;
    const float* x_p = (const float*)args.in[0]; const float* x_s = (const float*)args.in[1];
    const float* cache_k = (const float*)args.in[2]; const float* cache_v = (const float*)args.in[3]; const float* cache_ik = (const float*)args.in[4];
    const float* st_re = (const float*)args.in[5]; const float* st_im = (const float*)args.in[6]; const float* st_conv = (const float*)args.in[7];
    const int* ptab = (const int*)args.in[8]; const float* p_p = (const float*)args.in[9]; const float* p_s = (const float*)args.in[10];
    const float* g_mix = (const float*)args.in[11]; const float* w_in = (const float*)args.in[12]; const float* g_q = (const float*)args.in[13]; const float* g_k = (const float*)args.in[14];
    const float* a_re = (const float*)args.in[15]; const float* a_im = (const float*)args.in[16]; const float* log_dt = (const float*)args.in[17];
    const float* sb_re = (const float*)args.in[18]; const float* sb_im = (const float*)args.in[19]; const float* sc_re = (const float*)args.in[20]; const float* sc_im = (const float*)args.in[21];
    const float* ssm_d = (const float*)args.in[22]; const float* w_glu = (const float*)args.in[23]; const float* w_att = (const float*)args.in[24]; const float* w_ssm = (const float*)args.in[25];
    const float* w_o = (const float*)args.in[26]; const float* g_ffn = (const float*)args.in[27]; const float* w_up = (const float*)args.in[28]; const float* conv_w = (const float*)args.in[29];
    const float* conv_b = (const float*)args.in[30]; const float* w_down = (const float*)args.in[31]; const float* w_ple = (const float*)args.in[32]; const float* g_ple = (const float*)args.in[33];
    const float* g_pg = (const float*)args.in[34]; const float* w_pg = (const float*)args.in[35];
    for (int u = wave * 64 + lane_id_(); u < (LDS_BYTES - LDSCTL_OFF) / 4; u += NWAVES * 64) ((LAS unsigned*)(lds + LDSCTL_OFF))[u] = 0u;
    __syncthreads();
    const int lo = args.ph_lo, hi = args.ph_hi;
    XcdBarrier bar; bar.bar = (unsigned*)(ws + WS_CTL) + CW_BAR + args.bar_region * XCD_BAR_WORDS; bar.x = 0; bar.st = nullptr; bar.w0 = 0;
    if (hi - lo > 1) bar = xcd_barrier_post((unsigned*)(ws + WS_CTL) + CW_BAR + args.bar_region * XCD_BAR_WORDS, (volatile LAS unsigned*)(lds + MISC_OFF) + 8);
#define IN(k) (lo <= (k) && (k) < hi)
#ifdef PROBE_PHASE
    unsigned long long pp_t0 = 0, pp_dur = 0;
#define PP_BEGIN(k) do { if ((k) == PROBE_PHASE) pp_t0 = __builtin_amdgcn_s_memrealtime(); } while (0)
#define PP_END(k) do { if ((k) == PROBE_PHASE) pp_dur = __builtin_amdgcn_s_memrealtime() - pp_t0; } while (0)
#else
#define PP_BEGIN(k)
#define PP_END(k)
#endif
#ifdef PROBE_PHASE
#define PS_BEGIN(k) do { if ((k) == PROBE_PHASE) pp_t0 = __builtin_amdgcn_s_memrealtime(); } while (0)
#define PS_END(k) do { if ((k) == PROBE_PHASE) pp_dur += __builtin_amdgcn_s_memrealtime() - pp_t0; } while (0)
#else
#define PS_BEGIN(k)
#define PS_END(k)
#endif
#define SEAM(k) do { if (IN(k) && IN((k) + 1)) xcd_barrier(bar); } while (0)
#define XROW(m) ((m) < TP ? x_p + (size_t)(m) * DM : x_s + (size_t)((m) - TP) * DM)

    PP_BEGIN(0);
    if (IN(0)) for (int rep_ = 0; rep_ < kRep[0]; ++rep_) { WS_PTRS (void)RT; (void)SSC; (void)WIN; (void)WGLU; (void)WATT; (void)WSSM; (void)WO; (void)WUP; (void)WDN; (void)WPLE; (void)WPG; (void)H; (void)PBF; (void)PLER; (void)RS0; (void)SSQ1; (void)SSQ2; (void)SSQP; (void)PROJ; (void)QN; (void)KN; (void)VB; (void)IQ; (void)IKR; (void)IW; (void)SC; (void)SSC2; (void)BMK; (void)SIDX; (void)OATT; (void)Z; (void)Z2; (void)SE; (void)SIN; (void)MRG; (void)G8; (void)T8; (void)UP; (void)ACT; (void)sscn;
        LAS float* scr = (LAS float*)(lds + wave * 16384);
        constexpr int I0 = (DM / 64) * (INWP / 32), I1 = (512 / 64) * (512 / 32), I2 = (1024 / 64) * (DM / 32), I3 = (512 / 64) * (DM / 32), I4 = (DM / 64) * (DM / 32),
                      I5 = (DM / 64) * (DFF2 / 32), I6 = (DFF / 64) * (DM / 32), I7 = (PLE / 64) * (DM / 32), I8 = (DM / 64) * (DM / 32);
        auto mkitem0 = [&](int it) { TrItem T; int r = it;
            if (r < I0) { T = TrItem{w_in, WIN, g_mix, DM, INW, INWP / 32, r}; return T; } r -= I0;
            T = TrItem{w_ple, WPLE, nullptr, PLE, DM, DM / 32, r}; return T; };
        constexpr int NITEMS0 = I0 + I7;
        PS_BEGIN(110);
        { float wa[32], wb[32]; TrItem Ta, Tb; int it = gw;
          if (it < NITEMS0) { Ta = mkitem0(it); transpose_load(Ta, lane, wa); }
          for (; it < NITEMS0; it += NGW) { const int nx = it + NGW; if (nx < NITEMS0) { Tb = mkitem0(nx); transpose_load(Tb, lane, wb); }
              transpose_store(Ta, lane, wa, scr); Ta = Tb;
#pragma unroll
              for (int i = 0; i < 32; ++i) wa[i] = wb[i]; } }
        PS_END(110);
        PS_BEGIN(111);
        for (int m = gw; m < MR; m += NGW) {
            row_to_bf16_rstd(XROW(m), H + (size_t)m * DM, RS0 + m, lane);
            const float* pr = m < TP ? p_p + (size_t)m * PLE : p_s + (size_t)(m - TP) * PLE;
            const f32x4 v = *((const f32x4*)pr + lane); u32x2 w; w.x = cvt_pk_bf16(v.x, v.y); w.y = cvt_pk_bf16(v.z, v.w); *((u32x2*)(PBF + (size_t)m * PLE) + lane) = w;
        }
        PS_END(111);
        PS_BEGIN(112);
        for (int e = gw * 64 + lane; e < (SEQ + DT) * 24; e += NGW * 64) {
            const int pi = e / 24, i = e % 24; const double pos = pi < SEQ ? (double)pi : (double)(PAST + pi - SEQ);
            const double ex = i < 16 ? (double)i / 16.0 : (double)(i - 16) / 8.0; double inv, dum; cexp_d(-ex * 13.122363377404328, 0.0, 10, inv, dum);
            double c, s; cexp_d(0.0, pos * inv, 20, c, s);
            if (i < 16) { RT[pi * 48 + i] = (float)c; RT[pi * 48 + 16 + i] = (float)s; } else { RT[pi * 48 + 32 + (i - 16)] = (float)c; RT[pi * 48 + 40 + (i - 16)] = (float)s; }
        }
        for (int m = gw * 64 + lane; m < MP; m += NGW * 64) { SSQ1[m] = 0.f; SSQ2[m] = 0.f; SSQP[m] = 0.f; }
        for (int gn = gw * 64 + lane; gn < SG * SN * 32; gn += NGW * 64) ssm_constants(gn, a_re, a_im, log_dt, sb_re, sb_im, sc_re, sc_im, SSC);
        PS_END(112);
    }
    SEAM(0);
    PP_END(0);
    PP_BEGIN(1);
    if (IN(1)) for (int rep_ = 0; rep_ < kRep[1]; ++rep_) { WS_PTRS (void)RT; (void)SSC; (void)WIN; (void)WGLU; (void)WATT; (void)WSSM; (void)WO; (void)WUP; (void)WDN; (void)WPLE; (void)WPG; (void)H; (void)PBF; (void)PLER; (void)RS0; (void)SSQ1; (void)SSQ2; (void)SSQP; (void)PROJ; (void)QN; (void)KN; (void)VB; (void)IQ; (void)IKR; (void)IW; (void)SC; (void)SSC2; (void)BMK; (void)SIDX; (void)OATT; (void)Z; (void)Z2; (void)SE; (void)SIN; (void)MRG; (void)G8; (void)T8; (void)UP; (void)ACT; (void)sscn;
        { pg8::Gemm g{H, WIN, MP, INWP, DM, DM, 1}; pg8::StaticOrder S; S.init(MP, INWP, G, bx, WGM_IN); EpiProj E{PROJ, RS0, G8};
          pg8::gemm_phase<EpiProj, pg8::StaticOrder, true, true>(lds, g, S, E, wave); }
        { { SkStore Es{PLER, SSQP}; skinny_gemm(lds, PBF, PLE, WPLE, PLE, DM, Es, vcu, G, wave, lane); }
          pg8::Gemm g{PBF, WPLE, TP, DM, PLE, PLE, 2}; pg8::StaticOrder S; S.init(TP, DM, G, bx); EpiStoreBf16<0, true> E{PLER, DM, nullptr, SSQP};
          pg8::gemm_phase<EpiStoreBf16<0, true>, pg8::StaticOrder, true, true>(lds, g, S, E, wave); }
    }
    SEAM(1);
    PP_END(1);
    PP_BEGIN(2);
    if (IN(2)) for (int rep_ = 0; rep_ < kRep[2]; ++rep_) { WS_PTRS (void)RT; (void)SSC; (void)WIN; (void)WGLU; (void)WATT; (void)WSSM; (void)WO; (void)WUP; (void)WDN; (void)WPLE; (void)WPG; (void)H; (void)PBF; (void)PLER; (void)RS0; (void)SSQ1; (void)SSQ2; (void)SSQP; (void)PROJ; (void)QN; (void)KN; (void)VB; (void)IQ; (void)IKR; (void)IW; (void)SC; (void)SSC2; (void)BMK; (void)SIDX; (void)OATT; (void)Z; (void)Z2; (void)SE; (void)SIN; (void)MRG; (void)G8; (void)T8; (void)UP; (void)ACT; (void)sscn;
        for (int task_ = gw; task_ < MUL_SSMA * SSM_NCH * SG; task_ += NGW) { const int task = task_ % (SSM_NCH * SG); ssm_task<0>(0, task & 31, task >> 5, lane, sscn, PROJ, ssm_d, SE, SIN, nullptr, nullptr, Z, nullptr, nullptr); }
        { TaRaw Ra, Rb, Rc;
          if (gw < MUL_TA * MR) ta_load(gw % MR, lane, PROJ, Ra);
          if (gw + NGW < MUL_TA * MR) ta_load((gw + NGW) % MR, lane, PROJ, Rb);
          for (int row_ = gw; row_ < MUL_TA * MR; row_ += NGW) { const int row = row_ % MR; const int nx = row_ + 2 * NGW; if (nx < MUL_TA * MR) ta_load(nx % MR, lane, PROJ, Rc);
              ta_compute(row, lane, Ra, RT, g_q, g_k, QN, KN, VB, IQ, IKR, IW, out); Ra = Rb; Rb = Rc; } }
    }
    SEAM(2);
    PP_END(2);
    PP_BEGIN(3);
    if (IN(3)) for (int rep_ = 0; rep_ < kRep[3]; ++rep_) { WS_PTRS (void)RT; (void)SSC; (void)WIN; (void)WGLU; (void)WATT; (void)WSSM; (void)WO; (void)WUP; (void)WDN; (void)WPLE; (void)WPG; (void)H; (void)PBF; (void)PLER; (void)RS0; (void)SSQ1; (void)SSQ2; (void)SSQP; (void)PROJ; (void)QN; (void)KN; (void)VB; (void)IQ; (void)IKR; (void)IW; (void)SC; (void)SSC2; (void)BMK; (void)SIDX; (void)OATT; (void)Z; (void)Z2; (void)SE; (void)SIN; (void)MRG; (void)G8; (void)T8; (void)UP; (void)ACT; (void)sscn;
        for (int u_ = vcu; u_ < MUL_IDXP * 256; u_ += G) { const int u = u_ & 255; const int b = u >> 4, y = u & 15; idx_prompt_block(b, y, wave, lane, PROJ, RT, IKR, IW, SC); idx_prompt_block(b, 31 - y, wave, lane, PROJ, RT, IKR, IW, SC); }
        for (int u_ = vcu; u_ < MUL_IDXS * 512; u_ += G) { const int u = u_ & 511; idx_sample_unit(u >> 4, u & 15, wave, lane, PROJ, RT, IKR, IW, cache_ik, ptab, SSC2); }
        if (lane < 16) for (int idx_ = gw * 16 + lane; idx_ < MUL_CARRY * NB * SG * SN; idx_ += NGW * 16) { const int idx = idx_ % (NB * SG * SN); ssm_carry(idx, sscn.a32, SE, SIN, out + O_SRP, out + O_SIP); }
    }
    SEAM(3);
    PP_END(3);
    PP_BEGIN(4);
    if (IN(4)) for (int rep_ = 0; rep_ < kRep[4]; ++rep_) { WS_PTRS (void)RT; (void)SSC; (void)WIN; (void)WGLU; (void)WATT; (void)WSSM; (void)WO; (void)WUP; (void)WDN; (void)WPLE; (void)WPG; (void)H; (void)PBF; (void)PLER; (void)RS0; (void)SSQ1; (void)SSQ2; (void)SSQP; (void)PROJ; (void)QN; (void)KN; (void)VB; (void)IQ; (void)IKR; (void)IW; (void)SC; (void)SSC2; (void)BMK; (void)SIDX; (void)OATT; (void)Z; (void)Z2; (void)SE; (void)SIN; (void)MRG; (void)G8; (void)T8; (void)UP; (void)ACT; (void)sscn;
        for (int r = vcu; r < TS; r += G) select_sample_row(r, tid, lane, wave, SSC2, SIDX, (LAS unsigned*)lds);
        {
            constexpr int J1 = (512 / 64) * (512 / 32), J2 = (1024 / 64) * (DM / 32), J3 = (512 / 64) * (DM / 32), J4 = (DM / 64) * (DM / 32), J5 = (DM / 64) * (DFF2 / 32), J6 = (DFF / 64) * (DM / 32), J8 = (DM / 64) * (DM / 32);
            constexpr int NLATE = J1 + J2 + J3 + J4 + J5 + J6 + J8;
            auto mkitem1 = [&](int it) { TrItem T; int r = it;
                if (r < J1) { T = TrItem{w_glu, WGLU, nullptr, 512, 512, 512 / 32, r}; return T; } r -= J1;
                if (r < J2) { T = TrItem{w_att, WATT, nullptr, 1024, DM, DM / 32, r}; return T; } r -= J2;
                if (r < J3) { T = TrItem{w_ssm, WSSM, nullptr, 512, DM, DM / 32, r}; return T; } r -= J3;
                if (r < J4) { T = TrItem{w_o, WO, nullptr, DM, DM, DM / 32, r}; return T; } r -= J4;
                if (r < J5) { T = TrItem{w_up, WUP, g_ffn, DM, DFF2, DFF2 / 32, r}; return T; } r -= J5;
                if (r < J6) { T = TrItem{w_down, WDN, nullptr, DFF, DM, DM / 32, r}; return T; } r -= J6;
                T = TrItem{w_pg, WPG, g_pg, DM, DM, DM / 32, r}; return T; };
            LAS float* scr = (LAS float*)(lds + 36864 + wave * 8448);
            int it = gw;
            for (int k_ = gw; k_ < MUL_SEL * TP || it < NLATE; k_ += NGW) {
                const bool hrow = k_ < MUL_SEL * TP, hit = it < NLATE;
                float v[32], wt[32]; TrItem Tt; int row = 0;
                if (hrow) { const int k = k_ % TP; const int b = k >> 11, t0 = k & (SEQ - 1); const int t = (b & 1) ? (SEQ - 1 - t0) : t0; row = __builtin_amdgcn_readfirstlane(b * SEQ + t); select_prompt_load(row, lane, SC, v); }
                if (hit) { Tt = mkitem1(it); transpose_load(Tt, lane, wt); }
                if (hrow) select_prompt_compute(row, lane, v, BMK, (LAS unsigned*)(lds + wave * 4608));
                if (hit) { transpose_store(Tt, lane, wt, scr); it += NGW; }
            }
        }
        for (int task_ = gw; task_ < MUL_SSMC * (SSM_NCH * SG + 2 * SG); task_ += NGW) { const int task = task_ % (SSM_NCH * SG + 2 * SG);
            if (task < SSM_NCH * SG) ssm_task<1>(0, task & 31, task >> 5, lane, sscn, PROJ, ssm_d, SE, SIN, nullptr, nullptr, Z, nullptr, nullptr);
            else { const int k = task - SSM_NCH * SG; ssm_task<2>(k >> 5, k & 31, 0, lane, sscn, PROJ, ssm_d, SE, SIN, st_re, st_im, Z, out + O_SRS, out + O_SIS); }
        }
    }
    SEAM(4);
    PP_END(4);
    PP_BEGIN(5);
    if (IN(5)) for (int rep_ = 0; rep_ < kRep[5]; ++rep_) { WS_PTRS (void)RT; (void)SSC; (void)WIN; (void)WGLU; (void)WATT; (void)WSSM; (void)WO; (void)WUP; (void)WDN; (void)WPLE; (void)WPG; (void)H; (void)PBF; (void)PLER; (void)RS0; (void)SSQ1; (void)SSQ2; (void)SSQP; (void)PROJ; (void)QN; (void)KN; (void)VB; (void)IQ; (void)IKR; (void)IW; (void)SC; (void)SSC2; (void)BMK; (void)SIDX; (void)OATT; (void)Z; (void)Z2; (void)SE; (void)SIN; (void)MRG; (void)G8; (void)T8; (void)UP; (void)ACT; (void)sscn;
        {
            const int total = MUL_ATT * NB * NH * 4;
            auto mkref = [&](int L_, int pass) { const int L = L_ % (NB * NH * 4); const int gq = L & 3, y = (L >> 2) & 3, kvh = (L >> 4) & 1, b = L >> 5; const int h = kvh * 4 + gq, qb = pass ? 7 - y : y;
                att::BlockRef r; const size_t q0 = ((size_t)b * SEQ + (size_t)qb * 256) * 1024 + h * 128;
                r.Q = QN + q0; r.O = OATT + q0; r.K = KN + (size_t)b * SEQ * 256 + kvh * 128; r.V = PROJ + (size_t)b * SEQ * INWP + C_V + kvh * 128; r.MB = BMK + ((size_t)b * SEQ + (size_t)qb * 256) * 32; r.P0 = qb * 256; return r; };
            int L = vcu;
            if (L < total) {
                int pass = 0; att::BlockRef cur = mkref(L, 0); att::Seam S;
                att::attn_prime(cur, (char*)lds_raw, S, wave);
                for (;;) {
                    const bool more_pass = pass == 0, more_item = L + G < total, last = !more_pass && !more_item;
                    int passn = pass + 1, Ln = L; if (!more_pass) { passn = 0; Ln = more_item ? L + G : L; }
                    const att::BlockRef nxt = last ? cur : mkref(Ln, passn);
                    att::attn_block(cur, nxt, (char*)lds_raw, S, wave);
                    if (last) break;
                    cur = nxt; pass = passn; L = Ln;
                }
            }
            VM_WAIT(); __syncthreads();
        }
        for (int u_ = vcu; u_ < MUL_SATT * 256; u_ += G) { const int u = u_ & 255; sample_attn_unit(u, tid, lane, wave, lds, QN, SIDX, ptab, cache_k, cache_v, out, OATT); }
        { SkGlu Es{Z, Z2}; skinny_gemm(lds, Z, 512, WGLU, 512, 512, Es, vcu, G, wave, lane); }
        { pg8::Gemm g{Z, WGLU, TP, 512, 512, 512, 3}; pg8::StaticOrder S; S.init(TP, 512, G, bx); EpiGlu E{Z, Z2, 512};
          pg8::gemm_phase<EpiGlu, pg8::StaticOrder, true, true>(lds, g, S, E, wave); }
    }
    SEAM(5);
    PP_END(5);
    PP_BEGIN(6);
    if (IN(6)) for (int rep_ = 0; rep_ < kRep[6]; ++rep_) { WS_PTRS (void)RT; (void)SSC; (void)WIN; (void)WGLU; (void)WATT; (void)WSSM; (void)WO; (void)WUP; (void)WDN; (void)WPLE; (void)WPG; (void)H; (void)PBF; (void)PLER; (void)RS0; (void)SSQ1; (void)SSQ2; (void)SSQP; (void)PROJ; (void)QN; (void)KN; (void)VB; (void)IQ; (void)IKR; (void)IW; (void)SC; (void)SSC2; (void)BMK; (void)SIDX; (void)OATT; (void)Z; (void)Z2; (void)SE; (void)SIN; (void)MRG; (void)G8; (void)T8; (void)UP; (void)ACT; (void)sscn; { SkGate<false> Es{G8, 4096, T8, MRG}; skinny_gemm(lds, OATT, 1024, WATT, 1024, DM, Es, vcu, G, wave, lane); }
        pg8::Gemm g{OATT, WATT, TP, DM, 1024, 1024, 4}; pg8::StaticOrder S; S.init(TP, DM, G, bx); EpiGate<false> E{G8, 4096, T8, MRG, DM};
        pg8::gemm_phase<EpiGate<false>, pg8::StaticOrder, true, true>(lds, g, S, E, wave); }
    if (IN(6) && IN(7)) { VM_WAIT(); __syncthreads(); }
    PP_END(6);
    PP_BEGIN(7);
    if (IN(7)) { WS_PTRS (void)RT; (void)SSC; (void)WIN; (void)WGLU; (void)WATT; (void)WSSM; (void)WO; (void)WUP; (void)WDN; (void)WPLE; (void)WPG; (void)H; (void)PBF; (void)PLER; (void)RS0; (void)SSQ1; (void)SSQ2; (void)SSQP; (void)PROJ; (void)QN; (void)KN; (void)VB; (void)IQ; (void)IKR; (void)IW; (void)SC; (void)SSC2; (void)BMK; (void)SIDX; (void)OATT; (void)Z; (void)Z2; (void)SE; (void)SIN; (void)MRG; (void)G8; (void)T8; (void)UP; (void)ACT; (void)sscn; { SkGate<true> Es{G8 + 2048, 4096, T8, MRG}; skinny_gemm(lds, Z2, 512, WSSM, 512, DM, Es, vcu, G, wave, lane); }
        pg8::Gemm g{Z2, WSSM, TP, DM, 512, 512, 5}; pg8::StaticOrder S; S.init(TP, DM, G, bx); EpiGate<true> E{G8 + 2048, 4096, T8, MRG, DM};
        pg8::gemm_phase<EpiGate<true>, pg8::StaticOrder, true, true>(lds, g, S, E, wave); }
    SEAM(7);
    PP_END(7);
    PP_BEGIN(8);
    if (IN(8)) for (int rep_ = 0; rep_ < kRep[8]; ++rep_) { WS_PTRS (void)RT; (void)SSC; (void)WIN; (void)WGLU; (void)WATT; (void)WSSM; (void)WO; (void)WUP; (void)WDN; (void)WPLE; (void)WPG; (void)H; (void)PBF; (void)PLER; (void)RS0; (void)SSQ1; (void)SSQ2; (void)SSQP; (void)PROJ; (void)QN; (void)KN; (void)VB; (void)IQ; (void)IKR; (void)IW; (void)SC; (void)SSC2; (void)BMK; (void)SIDX; (void)OATT; (void)Z; (void)Z2; (void)SE; (void)SIN; (void)MRG; (void)G8; (void)T8; (void)UP; (void)ACT; (void)sscn; { SkResid Es{H, SSQ1}; skinny_gemm(lds, MRG, DM, WO, DM, DM, Es, vcu, G, wave, lane); }
        pg8::Gemm g{MRG, WO, TP, DM, DM, DM, 6}; pg8::StaticOrder S; S.init(TP, DM, G, bx); EpiResidBf E{H, SSQ1};
        pg8::gemm_phase<EpiResidBf, pg8::StaticOrder, true, true>(lds, g, S, E, wave); }
    SEAM(8);
    PP_END(8);
    PP_BEGIN(9);
    if (IN(9)) for (int rep_ = 0; rep_ < kRep[9]; ++rep_) { WS_PTRS (void)RT; (void)SSC; (void)WIN; (void)WGLU; (void)WATT; (void)WSSM; (void)WO; (void)WUP; (void)WDN; (void)WPLE; (void)WPG; (void)H; (void)PBF; (void)PLER; (void)RS0; (void)SSQ1; (void)SSQ2; (void)SSQP; (void)PROJ; (void)QN; (void)KN; (void)VB; (void)IQ; (void)IKR; (void)IW; (void)SC; (void)SSC2; (void)BMK; (void)SIDX; (void)OATT; (void)Z; (void)Z2; (void)SE; (void)SIN; (void)MRG; (void)G8; (void)T8; (void)UP; (void)ACT; (void)sscn;
        pg8::Gemm g{H, WUP, MP, DFF2, DM, DM, 7}; pg8::StaticOrder S; S.init(MP, DFF2, G, bx, WGM_UP); EpiStoreBf16<2, false> E{UP, DFF2, SSQ1, nullptr};
        pg8::gemm_phase<EpiStoreBf16<2, false>, pg8::StaticOrder, true, true>(lds, g, S, E, wave); }
    SEAM(9);
    PP_END(9);
    PP_BEGIN(10);
    if (IN(10)) for (int rep_ = 0; rep_ < kRep[10]; ++rep_) { WS_PTRS (void)RT; (void)SSC; (void)WIN; (void)WGLU; (void)WATT; (void)WSSM; (void)WO; (void)WUP; (void)WDN; (void)WPLE; (void)WPG; (void)H; (void)PBF; (void)PLER; (void)RS0; (void)SSQ1; (void)SSQ2; (void)SSQP; (void)PROJ; (void)QN; (void)KN; (void)VB; (void)IQ; (void)IKR; (void)IW; (void)SC; (void)SSC2; (void)BMK; (void)SIDX; (void)OATT; (void)Z; (void)Z2; (void)SE; (void)SIN; (void)MRG; (void)G8; (void)T8; (void)UP; (void)ACT; (void)sscn; for (int it_ = gw; it_ < MUL_CONV * (512 + DB) * 11; it_ += NGW) { const int it = it_ % ((512 + DB) * 11); conv_item(it / 11, it % 11, lane, UP, ACT, conv_w, conv_b, st_conv, out); } }
    SEAM(10);
    PP_END(10);
    PP_BEGIN(11);
    if (IN(11)) { WS_PTRS (void)RT; (void)SSC; (void)WIN; (void)WGLU; (void)WATT; (void)WSSM; (void)WO; (void)WUP; (void)WDN; (void)WPLE; (void)WPG; (void)H; (void)PBF; (void)PLER; (void)RS0; (void)SSQ1; (void)SSQ2; (void)SSQP; (void)PROJ; (void)QN; (void)KN; (void)VB; (void)IQ; (void)IKR; (void)IW; (void)SC; (void)SSC2; (void)BMK; (void)SIDX; (void)OATT; (void)Z; (void)Z2; (void)SE; (void)SIN; (void)MRG; (void)G8; (void)T8; (void)UP; (void)ACT; (void)sscn; { PS_BEGIN(101); SkResid Es{H, SSQ2}; skinny_gemm(lds, ACT, DFF, WDN, DFF, DM, Es, vcu, G, wave, lane); PS_END(101); }
        pg8::Gemm g{ACT, WDN, TP, DM, DFF, DFF, 8}; pg8::StaticOrder S; S.init(TP, DM, G, bx, WGM_DN); EpiResidBf E{H, SSQ2};
        pg8::gemm_phase<EpiResidBf, pg8::StaticOrder, true, true>(lds, g, S, E, wave); }
    SEAM(11);
    PP_END(11);
    PP_BEGIN(12);
    if (IN(12)) { WS_PTRS (void)RT; (void)SSC; (void)WIN; (void)WGLU; (void)WATT; (void)WSSM; (void)WO; (void)WUP; (void)WDN; (void)WPLE; (void)WPG; (void)H; (void)PBF; (void)PLER; (void)RS0; (void)SSQ1; (void)SSQ2; (void)SSQP; (void)PROJ; (void)QN; (void)KN; (void)VB; (void)IQ; (void)IKR; (void)IW; (void)SC; (void)SSC2; (void)BMK; (void)SIDX; (void)OATT; (void)Z; (void)Z2; (void)SE; (void)SIN; (void)MRG; (void)G8; (void)T8; (void)UP; (void)ACT; (void)sscn; { PS_BEGIN(102); SkPg Es{out + O_Y, H, PLER, SSQ2, SSQP, g_ple}; skinny_gemm(lds, H, DM, WPG, DM, DM, Es, vcu, G, wave, lane); PS_END(102); }
#ifdef STAG12
        { if (tid == 0) { const unsigned long long t0_ = __builtin_amdgcn_s_memrealtime(); const unsigned long long d_ = (unsigned long long)((bx >> 3) & 7) * STAG12; while (__builtin_amdgcn_s_memrealtime() - t0_ < d_) __builtin_amdgcn_s_sleep(16); } __syncthreads(); }
#endif
        pg8::Gemm g{H, WPG, TP, DM, DM, DM, 9}; pg8::StaticOrder S; S.init(TP, DM, G, bx, WGM_PG); EpiPg E{out + O_Y, H, PLER, SSQ2, SSQP, g_ple};
        PS_BEGIN(103); pg8::gemm_phase<EpiPg, pg8::StaticOrder, true, true>(lds, g, S, E, wave); PS_END(103); }
    PP_END(12);
#ifdef PROBE_PHASE
    if (blockIdx.x == 0 && wave == 0 && lane_id_() == 0) { const unsigned long long t0 = __builtin_amdgcn_s_memrealtime(); while (__builtin_amdgcn_s_memrealtime() - t0 < pp_dur) __builtin_amdgcn_s_sleep(8); }
#endif
#if defined(PROBE_KLOOP) || defined(PROBE_EPI)
    if (blockIdx.x == 0 && wave == 0 && lane_id_() == 0) { const unsigned dur = *(LAS unsigned*)(lds + MISC_OFF + 64); const unsigned long long t0 = __builtin_amdgcn_s_memrealtime(); while (__builtin_amdgcn_s_memrealtime() - t0 < (unsigned long long)dur) __builtin_amdgcn_s_sleep(8); }
#endif
#undef IN
#undef SEAM
#undef XROW
}

extern "C" void kernel_launch(void* const* d_in, const int* in_sizes, int n_in, void* d_out, int out_size, void* d_ws, size_t ws_size, hipStream_t stream) {
    static int grid = 0;
    if (grid == 0) {
        if (n_in != 36 || out_size != (int)O_END || ws_size < WS_END) { fprintf(stderr, "kernel_launch: unexpected shapes (n_in %d, out %d, ws %zu; want 36, %zu, >= %zu)\n", n_in, out_size, ws_size, (size_t)O_END, (size_t)WS_END); grid = -1; return; }
        int dev = 0, cus = 0, per_cu = 0;
        if (hipGetDevice(&dev) != hipSuccess || hipDeviceGetAttribute(&cus, hipDeviceAttributeMultiprocessorCount, dev) != hipSuccess) { grid = -1; return; }
        if (hipFuncSetAttribute((const void*)fwd, hipFuncAttributeMaxDynamicSharedMemorySize, LDS_BYTES) != hipSuccess) { fprintf(stderr, "kernel_launch: hipFuncSetAttribute failed\n"); grid = -1; return; }
        if (hipOccupancyMaxActiveBlocksPerMultiprocessor(&per_cu, (const void*)fwd, NWAVES * 64, LDS_BYTES) != hipSuccess || per_cu < 1) fprintf(stderr, "kernel_launch: occupancy query reports %d\n", per_cu);
        (void)hipGetLastError();
        grid = cus;
    }
    if (grid < 0) return;
    if (hipMemsetAsync((char*)d_ws + WS_CTL, 0, CTL_ZERO_BYTES, stream) != hipSuccess) return;
    Args a{};
    for (int i = 0; i < 36; ++i) a.in[i] = d_in[i];
    a.out = (float*)d_out; a.ws = (unsigned char*)d_ws;
    const int nl = MK_N_LAUNCHES;
    for (int li = 0; li < nl; ++li) {
        a.ph_lo = (NPH * li) / nl; a.ph_hi = (NPH * (li + 1)) / nl; a.bar_region = li; a.pad = 0;
        hipLaunchKernelGGL(fwd, dim3(grid), dim3(NWAVES * 64), LDS_BYTES, stream, a);
    }
}
```
